# Optimizing an MI355X kernel written in HIP

```python
import jax, jax.numpy as jnp
from jax import lax
import numpy as np

D_MODEL = 2048
BATCH = 1
SEQ = 8192
DEPTH = 1

EPS = 1e-6
MEM_LEN = 256

CHUNK = 128
A_GROUP_DIM = 128
A_GROUPS = D_MODEL // A_GROUP_DIM
A_WIDTH = A_GROUPS * A_GROUP_DIM

QK_NOPE = 128
QK_ROPE = 64
V_DIM = 128
MLA_HEADS = D_MODEL // V_DIM
Q_LORA = 512
KV_LORA = 512
MLA_WIDTH = MLA_HEADS * V_DIM
QK_DIM = QK_NOPE + QK_ROPE
ROPE_THETA = 10000.0
Q_BLOCK = 128

MEM_HEADS = 4
MEM_HEAD_DIM = D_MODEL // MEM_HEADS
MEM_WIDTH = MEM_HEADS * MEM_HEAD_DIM

N_BRANCH = 3
BRANCH_WIDTH = D_MODEL

IN_SIZES = (A_WIDTH, A_WIDTH, A_WIDTH,
            Q_LORA, KV_LORA, QK_ROPE, MLA_WIDTH,
            MEM_WIDTH, MEM_WIDTH)
IN_TOTAL = int(sum(IN_SIZES))
IN_SPLITS = [int(o) for o in np.cumsum(IN_SIZES)[:-1]]

kernel_name = "hybrid_gmlp_mla_memory_gated"


def rmsnorm(x, g):
    xf = x.astype(jnp.float32)
    xf = xf * lax.rsqrt(jnp.mean(xf * xf, axis=-1, keepdims=True) + EPS)
    return xf.astype(x.dtype) * g


def layernorm(x, g, b):
    xf = x.astype(jnp.float32)
    mu = jnp.mean(xf, axis=-1, keepdims=True)
    var = jnp.mean(jnp.square(xf - mu), axis=-1, keepdims=True)
    return ((xf - mu) * lax.rsqrt(var + EPS)).astype(x.dtype) * g + b


def rope_tables(positions):
    inv_freq = 1.0 / (ROPE_THETA ** (jnp.arange(0, QK_ROPE, 2, dtype=jnp.float32) / QK_ROPE))
    ang = positions.astype(jnp.float32)[..., None] * inv_freq
    return jnp.cos(ang), jnp.sin(ang)


def apply_rope(t, cos, sin):
    t1, t2 = jnp.split(t, 2, axis=-1)
    cos = cos.astype(t.dtype)
    sin = sin.astype(t.dtype)
    return jnp.concatenate([t1 * cos - t2 * sin, t2 * cos + t1 * sin], axis=-1)


def chunked_spatial_gating(u_raw, v_raw, ln_g, ln_b, w_s, b_s):
    B, S, _ = u_raw.shape
    u = jax.nn.gelu(u_raw)
    v = layernorm(jax.nn.gelu(v_raw), ln_g, ln_b)
    vc = v.reshape(B, S // CHUNK, CHUNK, A_GROUPS, A_GROUP_DIM)
    causal = jnp.tril(jnp.ones((CHUNK, CHUNK), dtype=w_s.dtype))
    ws = w_s * causal[None]
    sv = jnp.einsum('gts,bcsgd->bctgd', ws, vc) + b_s.T[None, None, :, :, None]
    return u * sv.reshape(B, S, A_WIDTH)


def latent_attention(c_q, c_kv, k_rope, cos, sin, q_norm_g, w_uq, kv_norm_g, w_ukv):
    B, S, _ = c_q.shape
    q = (rmsnorm(c_q, q_norm_g) @ w_uq).reshape(B, S, MLA_HEADS, QK_DIM)
    q_nope, q_pe = jnp.split(q, [QK_NOPE], axis=-1)
    q_pe = apply_rope(q_pe, cos[:, :, None, :], sin[:, :, None, :])
    q = jnp.concatenate([q_nope, q_pe], axis=-1)

    kv = (rmsnorm(c_kv, kv_norm_g) @ w_ukv).reshape(B, S, MLA_HEADS, QK_NOPE + V_DIM)
    k_nope, v = jnp.split(kv, [QK_NOPE], axis=-1)
    k_pe = apply_rope(k_rope, cos, sin)
    k_pe = jnp.broadcast_to(k_pe[:, :, None, :], (B, S, MLA_HEADS, QK_ROPE))
    k = jnp.concatenate([k_nope, k_pe], axis=-1)

    qh = q.transpose(0, 2, 1, 3)
    kh = k.transpose(0, 2, 1, 3)
    vh = v.transpose(0, 2, 1, 3)
    n_blk = S // Q_BLOCK
    q_blocks = qh.reshape(B, MLA_HEADS, n_blk, Q_BLOCK, QK_DIM).transpose(2, 0, 1, 3, 4)
    scale = QK_DIM ** -0.5
    key_pos = jnp.arange(S)

    def one_block(args):
        qi, bi = args
        s = jnp.einsum('bhqd,bhkd->bhqk', qi, kh).astype(jnp.float32) * scale
        q_pos = bi * Q_BLOCK + jnp.arange(Q_BLOCK)
        mask = key_pos[None, :] <= q_pos[:, None]
        s = jnp.where(mask[None, None], s, -1e30)
        p = jax.nn.softmax(s, axis=-1).astype(vh.dtype)
        return jnp.einsum('bhqk,bhkd->bhqd', p, vh)

    o = lax.map(one_block, (q_blocks, jnp.arange(n_blk)))
    return o.transpose(1, 0, 3, 2, 4).reshape(B, S, MLA_WIDTH)


def memory_attention(q_m, mem, mem_norm_g, w_mem_kv):
    B, S, _ = q_m.shape
    kv = rmsnorm(mem, mem_norm_g) @ w_mem_kv
    k_m, v_m = jnp.split(kv.reshape(B, MEM_LEN, 2, MEM_HEADS, MEM_HEAD_DIM), 2, axis=2)
    k_m, v_m = k_m[:, :, 0], v_m[:, :, 0]
    q = q_m.reshape(B, S, MEM_HEADS, MEM_HEAD_DIM)
    s = jnp.einsum('bshd,bmhd->bhsm', q, k_m).astype(jnp.float32) * (MEM_HEAD_DIM ** -0.5)
    p = jax.nn.softmax(s, axis=-1).astype(v_m.dtype)
    return jnp.einsum('bhsm,bmhd->bshd', p, v_m).reshape(B, S, MEM_WIDTH)


def hybrid_layer(x, mem, cos, sin, g_pre, w_in, a_ln_g, a_ln_b, a_w_s, a_b_s,
                 q_norm_g, w_uq, kv_norm_g, w_ukv, mem_norm_g, w_mem_kv,
                 w_gate, b_gate, w_branch, w_out, g_post):
    B, S, D = x.shape
    h = rmsnorm(x, g_pre)
    proj = h @ w_in
    u, v, z_a, c_q, c_kv, k_rope, z_b, q_m, z_m = jnp.split(proj, IN_SPLITS, axis=-1)

    y_a = chunked_spatial_gating(u, v, a_ln_g, a_ln_b, a_w_s, a_b_s) * jax.nn.silu(z_a)
    y_b = latent_attention(c_q, c_kv, k_rope, cos, sin, q_norm_g, w_uq, kv_norm_g, w_ukv) * jax.nn.silu(z_b)
    y_m = memory_attention(q_m, mem, mem_norm_g, w_mem_kv) * jax.nn.silu(z_m)

    y = jnp.stack([y_a, y_b, y_m], axis=2)
    p = jnp.einsum('bsnc,ncd->bsnd', y, w_branch)
    gates = jax.nn.sigmoid(h @ w_gate + b_gate).reshape(B, S, N_BRANCH, D)
    merged = jnp.sum(gates * p, axis=2)
    out = merged @ w_out
    return x + rmsnorm(out, g_post)


def setup_inputs(seed: int = 0) -> dict:
    key = jax.random.key(seed)
    ks = jax.random.split(key, 24)
    f32 = jnp.float32
    L, D = DEPTH, D_MODEL

    def w(k, shape, fan_in):
        return jax.random.normal(k, shape, f32) * (fan_in ** -0.5)

    def gain(k, shape):
        return 1.0 + 0.02 * jax.random.normal(k, shape, f32)

    def bias(k, shape):
        return 0.01 * jax.random.normal(k, shape, f32)

    return {
        "x": jax.random.normal(ks[0], (BATCH, SEQ, D), f32),
        "mem": jax.random.normal(ks[1], (BATCH, MEM_LEN, D), f32),
        "positions": jnp.broadcast_to(jnp.arange(SEQ, dtype=jnp.int32)[None], (BATCH, SEQ)),
        "g_pre": gain(ks[2], (L, D)),
        "w_in": w(ks[3], (L, D, IN_TOTAL), D),
        "a_ln_g": gain(ks[4], (L, A_WIDTH)),
        "a_ln_b": bias(ks[5], (L, A_WIDTH)),
        "a_w_s": w(ks[6], (L, A_GROUPS, CHUNK, CHUNK), CHUNK),
        "a_b_s": gain(ks[7], (L, A_GROUPS, CHUNK)),
        "q_norm_g": gain(ks[8], (L, Q_LORA)),
        "w_uq": w(ks[9], (L, Q_LORA, MLA_HEADS * QK_DIM), Q_LORA),
        "kv_norm_g": gain(ks[10], (L, KV_LORA)),
        "w_ukv": w(ks[11], (L, KV_LORA, MLA_HEADS * (QK_NOPE + V_DIM)), KV_LORA),
        "mem_norm_g": gain(ks[12], (L, D)),
        "w_mem_kv": w(ks[13], (L, D, 2 * MEM_WIDTH), D),
        "w_gate": w(ks[14], (L, D, N_BRANCH * D), D),
        "b_gate": bias(ks[15], (L, N_BRANCH * D)),
        "w_branch": w(ks[16], (L, N_BRANCH, BRANCH_WIDTH, D), BRANCH_WIDTH),
        "w_out": w(ks[17], (L, D, D), D),
        "g_post": gain(ks[18], (L, D)),
    }


def reference(x, mem, positions, g_pre, w_in, a_ln_g, a_ln_b, a_w_s, a_b_s,
              q_norm_g, w_uq, kv_norm_g, w_ukv, mem_norm_g, w_mem_kv,
              w_gate, b_gate, w_branch, w_out, g_post):
    cos, sin = rope_tables(positions)
    for l in range(DEPTH):
        x = hybrid_layer(x, mem, cos, sin, g_pre[l], w_in[l], a_ln_g[l], a_ln_b[l],
                         a_w_s[l], a_b_s[l], q_norm_g[l], w_uq[l], kv_norm_g[l], w_ukv[l],
                         mem_norm_g[l], w_mem_kv[l], w_gate[l], b_gate[l], w_branch[l],
                         w_out[l], g_post[l])
    return x
```

```cpp
#include <hip/hip_runtime.h>
#include <hip/hip_cooperative_groups.h>
#include <cstdio>
#include <cstdint>
namespace cg = cooperative_groups;

#ifndef EPI_TWICE
#define EPI_TWICE 0
#endif
#ifndef PROBE_PH
#define PROBE_PH 0
#endif
#ifndef PROBE_MULT
#define PROBE_MULT 4
#endif
#ifndef ATT_LEADMODE
#define ATT_LEADMODE 2
#endif
#ifndef ATT_PRIO
#define ATT_PRIO 0
#endif
#ifndef ATT_PROBE
#define ATT_PROBE 0
#endif
#ifndef ATTN_FN
#define ATTN_FN attn_block3
#endif
#ifndef ROT45
#define ROT45 0
#endif
#ifndef ROT1
#define ROT1 0
#endif
#ifndef MK_SINGLE
#define MK_SINGLE 1
#endif

#define LAS __attribute__((address_space(3)))
typedef unsigned short bf16_t;
typedef short bf16x8 __attribute__((ext_vector_type(8)));
typedef short s16x4 __attribute__((ext_vector_type(4)));
typedef float f32x4 __attribute__((ext_vector_type(4)));
typedef float f32x2 __attribute__((ext_vector_type(2)));
typedef float f32x16 __attribute__((ext_vector_type(16)));
typedef unsigned u32x4 __attribute__((ext_vector_type(4)));
typedef unsigned u32x2 __attribute__((ext_vector_type(2)));

constexpr int S = 8192, D = 2048, ML = 256, NH = 16, DQK = 192, DV = 128;
constexpr int IN_TOTAL = 13376, NT_IN = 77;
constexpr float EPS = 1e-6f, LOG2E = 1.4426950408889634f;
constexpr float QSCALE = 0.07216878364870322f * 1.4426950408889634f;
constexpr float MSCALE = 0.04419417382415922f * 1.4426950408889634f;
constexpr int NTHREADS = 512, NWAVES = 8;
constexpr int RING_BYTES = 131072, XCH_OFF = RING_BYTES, BARST_OFF = XCH_OFF + 8192, LDS_BYTES = 147456;
constexpr size_t CTL_ZERO_BYTES = 16384;

constexpr size_t MiB = 1u << 20;
constexpr size_t WS_CS = 1 * MiB;
constexpr size_t WS_VST = 3 * MiB;
constexpr size_t WS_CQST = 5 * MiB;
constexpr size_t WS_CKVST = 5 * MiB + 256 * 1024;
constexpr size_t WS_VMR = 5 * MiB + 512 * 1024;
constexpr size_t WS_OST = 6 * MiB;
constexpr size_t WS_WSM = 7 * MiB;
constexpr size_t WS_KR = 8 * MiB;
constexpr size_t WS_KMH = 9 * MiB;
constexpr size_t WS_VMT = 10 * MiB;
constexpr size_t WS_WUQ = 11 * MiB;
constexpr size_t WS_WUKV = 14 * MiB;
constexpr size_t WS_WIN = 18 * MiB;
constexpr size_t WS_WMEM = 95 * MiB;
constexpr size_t WS_H = 111 * MiB;
constexpr size_t WS_MEMN = 143 * MiB;
constexpr size_t WS_UG = 144 * MiB;
constexpr size_t WS_VG = 176 * MiB;
constexpr size_t WS_ZA = 208 * MiB;
constexpr size_t WS_CQ = 240 * MiB;
constexpr size_t WS_CKV = 248 * MiB;
constexpr size_t WS_QMH = 256 * MiB;
constexpr size_t WS_G = 288 * MiB;
constexpr size_t WS_VB = 384 * MiB;
constexpr size_t WS_QB = 18 * MiB;
constexpr size_t WS_KB = 66 * MiB;
constexpr size_t WS_P = 114 * MiB;
constexpr size_t WS_WBR = 240 * MiB;
constexpr size_t WS_WOUT = 264 * MiB;
constexpr size_t WS_MP = 18 * MiB;
constexpr size_t WS_MERGED = 82 * MiB;
constexpr size_t WS_END = 416 * MiB;

typedef __bf16 bf16x2_t __attribute__((ext_vector_type(2)));
__device__ __forceinline__ unsigned cvt_pk_bf16(float lo, float hi) { const f32x2 v = {lo, hi}; const bf16x2_t b = __builtin_convertvector(v, bf16x2_t); return __builtin_bit_cast(unsigned, b); }
__device__ __forceinline__ float bf_lo(unsigned w) { return __uint_as_float(w << 16); }
__device__ __forceinline__ float bf_hi(unsigned w) { return __uint_as_float(w & 0xffff0000u); }
__device__ __forceinline__ u32x4 pack8(const float* v) { u32x4 w; w.x = cvt_pk_bf16(v[0], v[1]); w.y = cvt_pk_bf16(v[2], v[3]); w.z = cvt_pk_bf16(v[4], v[5]); w.w = cvt_pk_bf16(v[6], v[7]); return w; }
__device__ __forceinline__ void unpack8(u32x4 w, float* v) { v[0] = bf_lo(w.x); v[1] = bf_hi(w.x); v[2] = bf_lo(w.y); v[3] = bf_hi(w.y); v[4] = bf_lo(w.z); v[5] = bf_hi(w.z); v[6] = bf_lo(w.w); v[7] = bf_hi(w.w); }
__device__ __forceinline__ float fast_rcp(float x) { return __builtin_amdgcn_rcpf(x); }
__device__ __forceinline__ float fast_exp2(float x) { return __builtin_amdgcn_exp2f(x); }
__device__ __forceinline__ float act_gelu(float x) { const float u = x * (1.f + 0.044715f * x * x); return x * fast_rcp(1.f + fast_exp2(-2.3022081983f * u)); }
__device__ __forceinline__ float act_silu(float x) { return x * fast_rcp(1.f + fast_exp2(-LOG2E * x)); }
__device__ __forceinline__ float act_sigmoid(float x) { return fast_rcp(1.f + fast_exp2(-LOG2E * x)); }
__device__ __forceinline__ float wave_sum(float v) {
#pragma unroll
    for (int o = 1; o < 64; o <<= 1) v += __shfl_xor(v, o);
    return v;
}

namespace pg8 {
constexpr int BM = 256, BK = 64, HALF = 128, HTB = HALF * BK * 2, STAGE_BYTES = 8 * HTB;
__host__ __device__ __forceinline__ int lds_byte(int r, int c) { const int st = (r >> 4) * 2 + (c >> 5), rr = r & 15, cc = c & 31, ob = rr * 64 + cc * 2; return st * 1024 + (ob ^ (((ob >> 9) & 1) << 5)); }
__host__ __device__ __forceinline__ void stage_rc(int b, int& R, int& C) { const int st = b / 1024, sb = b % 1024, swz = sb ^ (((sb >> 9) & 1) << 5); R = (st >> 1) * 16 + swz / 64; C = (st & 1) * 32 + (swz % 64) / 2; }
__host__ __device__ __forceinline__ int perm32(int rho) { const int n = rho >> 4, i = rho & 15; return 8 * (i >> 2) + 4 * n + (i & 3); }

struct Unit { const char* A; const char* B; int pm, pn, mode; };

template <int K, class Sched, class Epi>
__device__ __forceinline__ void gemm_phase(LAS unsigned char* lds, const Sched& S, const Epi& E, const int tid, const int rot = 0) {
    const int wid = __builtin_amdgcn_readfirstlane(tid >> 6), lane = tid & 63, wr = wid >> 2, wc = wid & 3, fr = lane & 15, fq = lane >> 4;
    constexpr int nt = K / BK;
    unsigned voffA[2], voffB[2];
#pragma unroll
    for (int i = 0; i < 2; ++i) { int R, C; stage_rc(tid * 16 + i * 8192, R, C); const int Rb = (R & ~31) + perm32(R & 31);
        voffA[i] = (unsigned)(R * K + C) * 2u; voffB[i] = (unsigned)(Rb * K + C) * 2u; }
    constexpr size_t kstep = (size_t)(BK * 2);
    constexpr size_t hstep = (size_t)HALF * K * 2;
    const unsigned ldsw = (unsigned)wid * 1024u;
    const int aoff = lds_byte(wr * 64 + fr, fq * 8), boff = lds_byte(wc * 32 + fr, fq * 8);
#define PG8_SA(b, h) (((b) * 2 + (h)) * HTB)
#define PG8_SB(b, h) ((4 + (b) * 2 + (h)) * HTB)
#define PG8_STAGE(bufoff, gbase, voff) do { _Pragma("unroll") for (int _i = 0; _i < 2; ++_i) \
        __builtin_amdgcn_global_load_lds((const unsigned*)((const char*)(gbase) + (voff)[_i]), (LAS unsigned*)(lds + (bufoff) + ldsw + _i * 8192), 16, 0, 0); } while (0)
#define PG8_LDA(dst, b, h) do { _Pragma("unroll") for (int m = 0; m < 4; ++m) _Pragma("unroll") for (int k = 0; k < 2; ++k) dst[m][k] = *(const LAS bf16x8*)(lds + PG8_SA(b, h) + aoff + m * 2048 + k * 1024); } while (0)
#define PG8_LDB(dst, b, h) do { _Pragma("unroll") for (int n = 0; n < 2; ++n) _Pragma("unroll") for (int k = 0; k < 2; ++k) dst[n][k] = *(const LAS bf16x8*)(lds + PG8_SB(b, h) + boff + n * 2048 + k * 1024); } while (0)
#define PG8_MMA(ai, bj, At, Bt) do { __builtin_amdgcn_s_setprio(1); _Pragma("unroll") for (int m = 0; m < 4; ++m) _Pragma("unroll") for (int n = 0; n < 2; ++n) _Pragma("unroll") for (int k = 0; k < 2; ++k) \
        acc[ai][bj][m][n] = __builtin_amdgcn_mfma_f32_16x16x32_bf16(Bt[n][k], At[m][k], acc[ai][bj][m][n], 0, 0, 0); __builtin_amdgcn_s_setprio(0); } while (0)
#define PG8_WAIT_V(n) asm volatile("s_waitcnt vmcnt(" #n ")" ::: "memory")
#define PG8_WAIT_L(n) asm volatile("s_waitcnt lgkmcnt(" #n ")" ::: "memory")
#define PG8_BAR __builtin_amdgcn_s_barrier()
#define PG8_SCHED __builtin_amdgcn_sched_barrier(0)
    Unit cur, nxt; int ui = 0;
#if PROBE_PH
    unsigned long long pacc_ = 0;
#endif
    if (!S.next(0, cur)) return;
    f32x4 acc[2][2][4][2];
#pragma unroll
    for (int a = 0; a < 2; ++a)
#pragma unroll
        for (int b = 0; b < 2; ++b)
#pragma unroll
            for (int m = 0; m < 4; ++m)
#pragma unroll
                for (int n = 0; n < 2; ++n) acc[a][b][m][n] = (f32x4){0.f, 0.f, 0.f, 0.f};
    bf16x8 At[4][2], B0[2][2], B1[2][2];
    const char* cA = cur.A; const char* cB = cur.B;
#define PG8_KT(t) ((size_t)(((t) + rot) & (nt - 1)) * kstep)
    PG8_STAGE(PG8_SB(0, 0), cB + PG8_KT(0), voffB); PG8_STAGE(PG8_SB(0, 1), cB + hstep + PG8_KT(0), voffB); PG8_STAGE(PG8_SA(0, 0), cA + PG8_KT(0), voffA); PG8_STAGE(PG8_SA(0, 1), cA + hstep + PG8_KT(0), voffA);
    if (wr == 1) PG8_BAR;
    PG8_WAIT_V(2); PG8_BAR;
    PG8_STAGE(PG8_SB(1, 0), cB + PG8_KT(1), voffB); PG8_STAGE(PG8_SA(1, 0), cA + PG8_KT(1), voffA); PG8_STAGE(PG8_SB(1, 1), cB + hstep + PG8_KT(1), voffB);
    PG8_WAIT_V(6); PG8_BAR;
    for (;;) {
        const bool has_next = S.next(ui + 1, nxt);
        const char* nA = has_next ? nxt.A : cA; const char* nB = has_next ? nxt.B : cB;
        for (int t = 0; t < nt; t += 2) {
            const bool last = (t == nt - 2);
            const char* a1 = cA + PG8_KT(t + 1);
            const char* a2 = (last ? nA : cA) + PG8_KT(t + 2); const char* b2 = (last ? nB : cB) + PG8_KT(t + 2);
            const char* a3 = (last ? nA : cA) + PG8_KT(t + 3); const char* b3 = (last ? nB : cB) + PG8_KT(t + 3);
            PG8_LDB(B0, 0, 0); PG8_LDB(B1, 0, 1); PG8_SCHED; PG8_LDA(At, 0, 0); PG8_STAGE(PG8_SA(1, 1), a1 + hstep, voffA);
            PG8_WAIT_V(8); PG8_WAIT_L(0); PG8_BAR; PG8_MMA(0, 0, At, B0); PG8_MMA(0, 1, At, B1); PG8_BAR; PG8_SCHED;
            PG8_LDA(At, 0, 1); PG8_STAGE(PG8_SB(0, 0), b2, voffB); PG8_STAGE(PG8_SB(0, 1), b2 + hstep, voffB); PG8_STAGE(PG8_SA(0, 0), a2, voffA);
            PG8_WAIT_V(8); PG8_WAIT_L(0); PG8_BAR; PG8_MMA(1, 0, At, B0); PG8_MMA(1, 1, At, B1); PG8_BAR; PG8_SCHED;
            PG8_LDB(B0, 1, 0); PG8_LDB(B1, 1, 1); PG8_SCHED; PG8_LDA(At, 1, 0); PG8_STAGE(PG8_SA(0, 1), a2 + hstep, voffA);
            PG8_WAIT_V(8); PG8_WAIT_L(0); PG8_BAR; PG8_MMA(0, 0, At, B0); PG8_MMA(0, 1, At, B1); PG8_BAR; PG8_SCHED;
            PG8_LDA(At, 1, 1); PG8_STAGE(PG8_SB(1, 0), b3, voffB); PG8_STAGE(PG8_SB(1, 1), b3 + hstep, voffB); PG8_STAGE(PG8_SA(1, 0), a3, voffA);
            PG8_WAIT_V(8); PG8_WAIT_L(0); PG8_BAR; PG8_MMA(1, 0, At, B0); PG8_MMA(1, 1, At, B1); PG8_BAR; PG8_SCHED;
        }
        if (wr == 0) PG8_BAR;
#if PROBE_PH
        unsigned long long pt0_ = __builtin_amdgcn_s_memrealtime();
#endif
        E(acc, cur, wr, wc, fr, fq);
#if PROBE_PH
        if (E.probe_id() == PROBE_PH) { asm volatile("s_waitcnt vmcnt(0)" ::: "memory"); pacc_ += __builtin_amdgcn_s_memrealtime() - pt0_; }
#endif
#if EPI_TWICE
        if (E.twice()) { asm volatile("" ::: "memory"); E(acc, cur, wr, wc, fr, fq); }
#endif
        if (!has_next) break;
        if (!E.keep_acc(cur)) {
#pragma unroll
        for (int a = 0; a < 2; ++a)
#pragma unroll
            for (int b = 0; b < 2; ++b)
#pragma unroll
                for (int m = 0; m < 4; ++m)
#pragma unroll
                    for (int n = 0; n < 2; ++n) acc[a][b][m][n] = (f32x4){0.f, 0.f, 0.f, 0.f};
        }
        cur = nxt; cA = nA; cB = nB; ++ui;
        if (wr == 1) PG8_BAR;
    }
    PG8_WAIT_V(0);
    PG8_BAR;
#if PROBE_PH
    if (E.probe_id() == PROBE_PH) { const unsigned long long t1_ = __builtin_amdgcn_s_memrealtime(); while (__builtin_amdgcn_s_memrealtime() - t1_ < (unsigned long long)PROBE_MULT * pacc_) __builtin_amdgcn_s_sleep(8); }
#endif
#undef PG8_KT
#undef PG8_SA
#undef PG8_SB
#undef PG8_STAGE
#undef PG8_LDA
#undef PG8_LDB
#undef PG8_MMA
#undef PG8_WAIT_V
#undef PG8_WAIT_L
#undef PG8_BAR
#undef PG8_SCHED
}
}
using pg8::Unit;

#define EPI_LOOP_BEGIN \
    _Pragma("unroll") for (int ai = 0; ai < 2; ++ai) _Pragma("unroll") for (int m = 0; m < 4; ++m) { const int rt = ai * 128 + wr * 64 + m * 16 + fr; \
    _Pragma("unroll") for (int bj = 0; bj < 2; ++bj) { const int ct = bj * 128 + wc * 32 + 8 * fq; \
        float v[8] = {acc[ai][bj][m][0][0], acc[ai][bj][m][0][1], acc[ai][bj][m][0][2], acc[ai][bj][m][0][3], acc[ai][bj][m][1][0], acc[ai][bj][m][1][1], acc[ai][bj][m][1][2], acc[ai][bj][m][1][3]};
#define EPI_LOOP_END } }

enum { M_GELU = 0, M_GELU_STAT, M_SILU, M_RAW_SS, M_KROPE, M_QM, M_GATE, M_MEMK, M_MEMV,
       M_QUP, M_KVUP, M_MEMS,
       M_MULZ, M_BR0, M_BR1, M_BR2, M_OUT };

struct Ptrs {
    const float* in[20]; float* out; unsigned char* ws; int ph_lo, ph_hi; int use_cg, pad;
};

struct EpiP1 {
    __device__ __forceinline__ int probe_id() const { return 1; }
    __device__ __forceinline__ bool twice() const { return EPI_TWICE == 1; }
    __device__ __forceinline__ bool keep_acc(const Unit&) const { return false; }
    unsigned char* ws; unsigned char* dout; const float* bgate;
    __device__ __forceinline__ void operator()(f32x4 (&acc)[2][2][4][2], const Unit& u, int wr, int wc, int fr, int fq) const {
        const int mode = u.mode, pn = u.pn, row0 = u.pm * 256;
        if (mode == M_KROPE) {
            if (wc < 2) {
                const f32x2* CS = (const f32x2*)(ws + WS_CS); bf16_t* KR = (bf16_t*)(ws + WS_KR);
#pragma unroll
                for (int ai = 0; ai < 2; ++ai)
#pragma unroll
                    for (int m = 0; m < 4; ++m) { const int row = row0 + ai * 128 + wr * 64 + m * 16 + fr; const int i0 = (wc * 32 + 8 * fq) >> 1;
                        const f32x4 a = acc[ai][0][m][0], b = acc[ai][0][m][1]; const float t1[4] = {a[0], a[2], b[0], b[2]}, t2[4] = {a[1], a[3], b[1], b[3]};
                        float o1[4], o2[4];
#pragma unroll
                        for (int j = 0; j < 4; ++j) { const f32x2 cs = CS[row * 32 + i0 + j]; o1[j] = t1[j] * cs.x - t2[j] * cs.y; o2[j] = t2[j] * cs.x + t1[j] * cs.y; }
                        u32x2 w1, w2; w1.x = cvt_pk_bf16(o1[0], o1[1]); w1.y = cvt_pk_bf16(o1[2], o1[3]); w2.x = cvt_pk_bf16(o2[0], o2[1]); w2.y = cvt_pk_bf16(o2[2], o2[3]);
                        *(u32x2*)(KR + (size_t)row * 64 + i0) = w1; *(u32x2*)(KR + (size_t)row * 64 + 32 + i0) = w2; }
            }
            return;
        }
        bf16_t* dst; int ldc, cbase = 0; int act = 0;
        float scale = 1.f; int stat = 0; float* stp = nullptr; const float* bias = nullptr;
        if (mode == M_GELU)           { dst = (bf16_t*)(ws + WS_UG); ldc = D; cbase = pn * 256; act = 1; }
        else if (mode == M_GELU_STAT) { dst = (bf16_t*)(ws + WS_VG); ldc = D; cbase = (pn - 8) * 256; act = 1; stat = 2; stp = (float*)(ws + WS_VST) + (size_t)((pn - 8) * 4 + wc) * S * 2; }
        else if (mode == M_SILU)      { act = 2; ldc = D; if (pn < 24) { dst = (bf16_t*)(ws + WS_ZA); cbase = (pn - 16) * 256; } else if (pn < 37) { dst = (bf16_t*)dout; cbase = (pn - 29) * 256; } else { dst = (bf16_t*)dout + (size_t)S * D; cbase = (pn - 45) * 256; } }
        else if (mode == M_RAW_SS)    { ldc = 512; stat = 1; if (pn < 26) { dst = (bf16_t*)(ws + WS_CQ); cbase = (pn - 24) * 256; stp = (float*)(ws + WS_CQST) + (size_t)((pn - 24) * 4 + wc) * S; }
                                        else { dst = (bf16_t*)(ws + WS_CKV); cbase = (pn - 26) * 256; stp = (float*)(ws + WS_CKVST) + (size_t)((pn - 26) * 4 + wc) * S; } }
        else if (mode == M_QM)        { const int t = pn - 37; dst = (bf16_t*)(ws + WS_QMH) + (size_t)(t >> 1) * S * 512; ldc = 512; cbase = (t & 1) * 256; scale = MSCALE; }
        else if (mode == M_GATE)      { dst = (bf16_t*)(ws + WS_G); ldc = 3 * D; cbase = (pn - 53) * 256; act = 3; bias = bgate + cbase; }
        else if (mode == M_MEMK)      { dst = (bf16_t*)(ws + WS_KMH) + (size_t)(pn >> 1) * ML * 512; ldc = 512; cbase = (pn & 1) * 256; }
        else                          { dst = (bf16_t*)(ws + WS_VMT); ldc = ML; cbase = 0; }
#pragma unroll
        for (int ai = 0; ai < 2; ++ai)
#pragma unroll
            for (int m = 0; m < 4; ++m) { const int rt = ai * 128 + wr * 64 + m * 16 + fr; float s1 = 0.f, s2 = 0.f;
#pragma unroll
                for (int bj = 0; bj < 2; ++bj) { const int ct = bj * 128 + wc * 32 + 8 * fq;
                    float v[8] = {acc[ai][bj][m][0][0], acc[ai][bj][m][0][1], acc[ai][bj][m][0][2], acc[ai][bj][m][0][3], acc[ai][bj][m][1][0], acc[ai][bj][m][1][1], acc[ai][bj][m][1][2], acc[ai][bj][m][1][3]};
                    if (act == 1) {
#pragma unroll
                        for (int j = 0; j < 8; ++j) v[j] = act_gelu(v[j]);
                    } else if (act == 2) {
#pragma unroll
                        for (int j = 0; j < 8; ++j) v[j] = act_silu(v[j]);
                    } else if (act == 3) { const f32x4 b0 = *(const f32x4*)(bias + ct), b1 = *(const f32x4*)(bias + ct + 4);
#pragma unroll
                        for (int j = 0; j < 4; ++j) { v[j] = act_sigmoid(v[j] + b0[j]); v[4 + j] = act_sigmoid(v[4 + j] + b1[j]); }
                    } else {
#pragma unroll
                        for (int j = 0; j < 8; ++j) v[j] *= scale;
                    }
                    if (stat) {
#pragma unroll
                        for (int j = 0; j < 8; ++j) { s1 += v[j]; s2 += v[j] * v[j]; }
                    }
                    *(u32x4*)(dst + (size_t)(row0 + rt) * ldc + cbase + ct) = pack8(v);
                }
                if (stat) { s1 += __shfl_xor(s1, 16); s1 += __shfl_xor(s1, 32); s2 += __shfl_xor(s2, 16); s2 += __shfl_xor(s2, 32);
                    if (fq == 0) { if (stat == 2) *(f32x2*)(stp + (size_t)(row0 + rt) * 2) = (f32x2){s1, s2}; else stp[row0 + rt] = s2; } }
            }
    }
};

struct SchedP1 {
    const unsigned char* ws; int G, c;
    __device__ __forceinline__ bool next(int i, Unit& u) const {
        const int L = i * G + c; constexpr int NMAIN = 32 * NT_IN;
        if (L >= NMAIN + 16) return false;
        if (L < NMAIN) { const int wg = (L % 8) * (NMAIN / 8) + L / 8; constexpr int nig = 8 * NT_IN; const int gid = wg / nig, w = wg % nig; const int pm = gid * 8 + (w % 8), pn = w / 8;
            u.pm = pm; u.pn = pn; u.A = (const char*)(ws + WS_H) + (size_t)pm * 256 * D * 2; u.B = (const char*)(ws + WS_WIN) + (size_t)pn * 256 * D * 2;
            u.mode = pn < 8 ? M_GELU : pn < 16 ? M_GELU_STAT : pn < 24 ? M_SILU : pn < 28 ? M_RAW_SS : pn == 28 ? M_KROPE : pn < 37 ? M_SILU : pn < 45 ? M_QM : pn < 53 ? M_SILU : M_GATE; }
        else if (L < NMAIN + 8) { const int pn = L - NMAIN; u.pm = 0; u.pn = pn; u.A = (const char*)(ws + WS_MEMN); u.B = (const char*)(ws + WS_WMEM) + (size_t)pn * 256 * D * 2; u.mode = M_MEMK; }
        else { const int pm = L - NMAIN - 8; u.pm = pm; u.pn = 0; u.A = (const char*)(ws + WS_WMEM) + (size_t)(2048 + pm * 256) * D * 2; u.B = (const char*)(ws + WS_MEMN); u.mode = M_MEMV; }
        return true;
    }
};

struct EpiP2 {
    __device__ __forceinline__ int probe_id() const { return 2; }
    __device__ __forceinline__ bool twice() const { return EPI_TWICE == 2; }
    __device__ __forceinline__ bool keep_acc(const Unit&) const { return false; }
    unsigned char* ws; LAS float* xch;
    __device__ __forceinline__ void operator()(f32x4 (&acc)[2][2][4][2], const Unit& u, int wr, int wc, int fr, int fq) const {
        const int mode = u.mode, row0 = u.pm * 256;
        if (mode == M_MEMS) {
            LAS float* XM = xch; LAS float* XS = xch + 1024;
#pragma unroll
            for (int ai = 0; ai < 2; ++ai)
#pragma unroll
                for (int m = 0; m < 4; ++m) { float t = -1e30f;
#pragma unroll
                    for (int bj = 0; bj < 2; ++bj)
#pragma unroll
                        for (int n = 0; n < 2; ++n) { const f32x4 x = acc[ai][bj][m][n]; t = fmaxf(t, fmaxf(fmaxf(x[0], x[1]), fmaxf(x[2], x[3]))); }
                    t = fmaxf(t, __shfl_xor(t, 16)); t = fmaxf(t, __shfl_xor(t, 32));
                    if (fq == 0) XM[(ai * 128 + wr * 64 + m * 16 + fr) * 4 + wc] = t; }
            asm volatile("s_waitcnt lgkmcnt(0)" ::: "memory"); __builtin_amdgcn_s_barrier(); asm volatile("" ::: "memory");
#pragma unroll
            for (int ai = 0; ai < 2; ++ai)
#pragma unroll
                for (int m = 0; m < 4; ++m) { const int rt = ai * 128 + wr * 64 + m * 16 + fr; const f32x4 q = *(const LAS f32x4*)(XM + rt * 4);
                    const float mxr = fmaxf(fmaxf(q[0], q[1]), fmaxf(q[2], q[3])); float s = 0.f;
#pragma unroll
                    for (int bj = 0; bj < 2; ++bj)
#pragma unroll
                        for (int n = 0; n < 2; ++n)
#pragma unroll
                            for (int e = 0; e < 4; ++e) { const float x = fast_exp2(acc[ai][bj][m][n][e] - mxr); acc[ai][bj][m][n][e] = x; s += x; }
                    s += __shfl_xor(s, 16); s += __shfl_xor(s, 32);
                    if (fq == 0) XS[rt * 4 + wc] = s; }
            asm volatile("s_waitcnt lgkmcnt(0)" ::: "memory"); __builtin_amdgcn_s_barrier(); asm volatile("" ::: "memory");
            bf16_t* P = (bf16_t*)(ws + WS_P) + (size_t)u.pn * S * 256;
#pragma unroll
            for (int ai = 0; ai < 2; ++ai)
#pragma unroll
                for (int m = 0; m < 4; ++m) { const int rt = ai * 128 + wr * 64 + m * 16 + fr; const f32x4 q = *(const LAS f32x4*)(XS + rt * 4);
                    const float iv = fast_rcp((q[0] + q[1]) + (q[2] + q[3]));
#pragma unroll
                    for (int bj = 0; bj < 2; ++bj) { float v[8];
#pragma unroll
                        for (int j = 0; j < 8; ++j) v[j] = acc[ai][bj][m][j >> 2][j & 3] * iv;
                        *(u32x4*)(P + (size_t)(row0 + rt) * 256 + bj * 128 + wc * 32 + 8 * fq) = pack8(v); } }
            return;
        }
        const float* stp = (const float*)(ws + (mode == M_QUP ? WS_CQST : WS_CKVST));
        const f32x2* CS = (const f32x2*)(ws + WS_CS);
        LAS float* RS = xch + 2048 + 64;
        { const int t_ = ((wr * 4 + wc) * 4 + fq) * 16 + fr;
          if (t_ < 256) { float ss = 0.f;
#pragma unroll
              for (int j = 0; j < 8; ++j) ss += stp[(size_t)j * S + row0 + t_];
              RS[t_] = 1.0f / sqrtf(ss * (1.f / 512.f) + EPS); }
          asm volatile("s_waitcnt lgkmcnt(0)" ::: "memory"); __builtin_amdgcn_s_barrier(); asm volatile("" ::: "memory"); }
#pragma unroll
        for (int ai = 0; ai < 2; ++ai)
#pragma unroll
            for (int m = 0; m < 4; ++m) { const int row = row0 + ai * 128 + wr * 64 + m * 16 + fr;
                const float rs = RS[ai * 128 + wr * 64 + m * 16 + fr];
#pragma unroll
                for (int bj = 0; bj < 2; ++bj) { const int ct = bj * 128 + wc * 32 + 8 * fq;
                    float v[8] = {acc[ai][bj][m][0][0], acc[ai][bj][m][0][1], acc[ai][bj][m][0][2], acc[ai][bj][m][0][3], acc[ai][bj][m][1][0], acc[ai][bj][m][1][1], acc[ai][bj][m][1][2], acc[ai][bj][m][1][3]};
#pragma unroll
                    for (int j = 0; j < 8; ++j) v[j] *= rs;
                    if (mode == M_QUP) { const int cg = u.pn * 256 + ct, head = cg / DQK, w = cg - head * DQK;
                        bf16_t* q = (bf16_t*)(ws + WS_QB) + ((size_t)head * S + row) * DQK;
                        if (w < 128) *(u32x4*)(q + w) = pack8(v);
                        else { const int i0 = (w - 128) >> 1; float o1[4], o2[4];
#pragma unroll
                            for (int j = 0; j < 4; ++j) { const f32x2 cs = CS[row * 32 + i0 + j]; const float t1 = v[2 * j], t2 = v[2 * j + 1]; o1[j] = t1 * cs.x - t2 * cs.y; o2[j] = t2 * cs.x + t1 * cs.y; }
                            u32x2 w1, w2; w1.x = cvt_pk_bf16(o1[0], o1[1]); w1.y = cvt_pk_bf16(o1[2], o1[3]); w2.x = cvt_pk_bf16(o2[0], o2[1]); w2.y = cvt_pk_bf16(o2[2], o2[3]);
                            *(u32x2*)(q + 128 + i0) = w1; *(u32x2*)(q + 160 + i0) = w2; } }
                    else { const int head = u.pn;
                        if (bj == 0) *(u32x4*)((bf16_t*)(ws + WS_KB) + ((size_t)head * S + row) * DQK + wc * 32 + 8 * fq) = pack8(v);
                        else *(u32x4*)((bf16_t*)(ws + WS_VB) + ((size_t)head * S + row) * DV + wc * 32 + 8 * fq) = pack8(v); }
                }
                if (mode == M_KVUP && wc < 2) {
                    const u32x4 kr = *(const u32x4*)((const bf16_t*)(ws + WS_KR) + (size_t)row * 64 + (wc * 4 + fq) * 8);
                    *(u32x4*)((bf16_t*)(ws + WS_KB) + ((size_t)u.pn * S + row) * DQK + 128 + (wc * 4 + fq) * 8) = kr; }
            }
    }
};
struct SchedP2 {
    const unsigned char* ws; int G, c;
    __device__ __forceinline__ bool next(int i, Unit& u) const {
        if (i >= 4 || c >= 256) return false;
        const int x = c & 7, l = i * 32 + (c >> 3);
        if (l < 48) { const int pm = 4 * x + (l & 3), pn = l >> 2; u.pm = pm; u.pn = pn; u.mode = M_QUP; u.A = (const char*)(ws + WS_CQ) + (size_t)pm * 256 * 512 * 2; u.B = (const char*)(ws + WS_WUQ) + (size_t)pn * 256 * 512 * 2; }
        else if (l < 112) { const int l2 = l - 48, pm = 4 * x + (l2 & 3), pn = l2 >> 2; u.pm = pm; u.pn = pn; u.mode = M_KVUP; u.A = (const char*)(ws + WS_CKV) + (size_t)pm * 256 * 512 * 2; u.B = (const char*)(ws + WS_WUKV) + (size_t)pn * 256 * 512 * 2; }
        else { const int l2 = l - 112, pm = 4 * x + (l2 & 3), h = l2 >> 2; u.pm = pm; u.pn = h; u.mode = M_MEMS; u.A = (const char*)(ws + WS_QMH) + ((size_t)h * S + pm * 256) * 512 * 2; u.B = (const char*)(ws + WS_KMH) + (size_t)h * ML * 512 * 2; }
        return true;
    }
};

struct EpiMulZ {
    __device__ __forceinline__ int probe_id() const { return 3; }
    __device__ __forceinline__ bool twice() const { return EPI_TWICE == 3; }
    __device__ __forceinline__ bool keep_acc(const Unit&) const { return false; }
    unsigned char* dout; bool dry;
    __device__ __forceinline__ void operator()(f32x4 (&acc)[2][2][4][2], const Unit& u, int wr, int wc, int fr, int fq) const {
        bf16_t* Z = (bf16_t*)dout + (size_t)S * D; const int row0 = u.pm * 256, cb = u.pn * 256;
        EPI_LOOP_BEGIN
            bf16_t* p = Z + (size_t)(row0 + rt) * D + cb + ct; float z[8]; unpack8(*(const u32x4*)p, z);
#pragma unroll
            for (int j = 0; j < 8; ++j) v[j] *= z[j];
            if (!dry) *(u32x4*)p = pack8(v);
        EPI_LOOP_END
    }
};
struct SchedP3b {
    const unsigned char* ws; int G, c;
    __device__ __forceinline__ bool next(int i, Unit& u) const {
        if (i >= 1 || c >= 256) return false;
        const int l = c >> 3, pm = 4 * (c & 7) + (l & 3), hn = l >> 2, h = hn >> 1; u.pm = pm; u.pn = hn; u.mode = M_MULZ;
        u.A = (const char*)(ws + WS_P) + ((size_t)h * S + pm * 256) * 256 * 2; u.B = (const char*)(ws + WS_VMT) + (size_t)hn * 256 * 256 * 2; return true;
    }
};

struct EpiP4 {
    __device__ __forceinline__ int probe_id() const { return 4; }
    __device__ __forceinline__ bool twice() const { return EPI_TWICE == 4; }
    unsigned char* ws;
    __device__ __forceinline__ bool keep_acc(const Unit& u) const { return u.mode != M_BR2; }
    __device__ __forceinline__ void operator()(f32x4 (&acc)[2][2][4][2], const Unit& u, int wr, int wc, int fr, int fq) const {
        const int n = u.mode - M_BR0, row0 = u.pm * 256, cb = u.pn * 256;
        const bf16_t* G = (const bf16_t*)(ws + WS_G) + (size_t)n * D; bf16_t* MG = (bf16_t*)(ws + WS_MERGED); constexpr float GMIN = 9.094947e-13f;
#pragma unroll
        for (int ai = 0; ai < 2; ++ai) {
            u32x4 ga[4][2], gb[4][2];
#pragma unroll
            for (int m = 0; m < 4; ++m)
#pragma unroll
                for (int bj = 0; bj < 2; ++bj) { const size_t r = (size_t)(row0 + ai * 128 + wr * 64 + m * 16 + fr); const bf16_t* gp = G + r * 3 * D + cb + bj * 128 + wc * 32 + 8 * fq;
                    ga[m][bj] = *(const u32x4*)gp; if (n < 2) gb[m][bj] = *(const u32x4*)(gp + D); }
#pragma unroll
            for (int m = 0; m < 4; ++m)
#pragma unroll
                for (int bj = 0; bj < 2; ++bj) { float g[8]; unpack8(ga[m][bj], g);
                    if (n < 2) { float gn[8]; unpack8(gb[m][bj], gn);
#pragma unroll
                        for (int j = 0; j < 8; ++j) acc[ai][bj][m][j >> 2][j & 3] *= fmaxf(g[j], GMIN) * fast_rcp(fmaxf(gn[j], GMIN)); }
                    else { float v[8]; const size_t r = (size_t)(row0 + ai * 128 + wr * 64 + m * 16 + fr);
#pragma unroll
                        for (int j = 0; j < 8; ++j) v[j] = acc[ai][bj][m][j >> 2][j & 3] * fmaxf(g[j], GMIN);
                        *(u32x4*)(MG + r * D + cb + bj * 128 + wc * 32 + 8 * fq) = pack8(v); } }
        }
    }
};
struct SchedP4 {
    const unsigned char* ws; const unsigned char* dout; int G, c;
    __device__ __forceinline__ bool next(int i, Unit& u) const {
        if (i >= 3 || c >= 256) return false;
        const int vc = (c % 8) * 32 + c / 8, pm = vc / 8, pn = vc % 8; u.pm = pm; u.pn = pn; u.mode = M_BR0 + i;
        const unsigned char* y = i == 0 ? ws + WS_UG : i == 1 ? dout : dout + (size_t)S * D * 2;
        u.A = (const char*)y + (size_t)pm * 256 * D * 2; u.B = (const char*)(ws + WS_WBR) + ((size_t)i * D + pn * 256) * D * 2; return true;
    }
};

struct EpiP5 {
    __device__ __forceinline__ int probe_id() const { return 5; }
    __device__ __forceinline__ bool twice() const { return EPI_TWICE == 5; }
    __device__ __forceinline__ bool keep_acc(const Unit&) const { return false; }
    unsigned char* ws; float* out;
    __device__ __forceinline__ void operator()(f32x4 (&acc)[2][2][4][2], const Unit& u, int wr, int wc, int fr, int fq) const {
        const int row0 = u.pm * 256, cb = u.pn * 256; float* st = (float*)(ws + WS_OST) + (size_t)(u.pn * 4 + wc) * S;
#pragma unroll
        for (int ai = 0; ai < 2; ++ai)
#pragma unroll
            for (int m = 0; m < 4; ++m) { const int rt = ai * 128 + wr * 64 + m * 16 + fr; float s2 = 0.f;
#pragma unroll
                for (int bj = 0; bj < 2; ++bj) { const int ct = bj * 128 + wc * 32 + 8 * fq; const f32x4 a = acc[ai][bj][m][0], b = acc[ai][bj][m][1];
                    s2 += (a[0] * a[0] + a[1] * a[1]) + (a[2] * a[2] + a[3] * a[3]) + (b[0] * b[0] + b[1] * b[1]) + (b[2] * b[2] + b[3] * b[3]);
                    const float v_[8] = {a[0], a[1], a[2], a[3], b[0], b[1], b[2], b[3]}; *(u32x4*)((bf16_t*)(ws + WS_MP) + (size_t)(row0 + rt) * D + cb + ct) = pack8(v_); }
                s2 += __shfl_xor(s2, 16); s2 += __shfl_xor(s2, 32);
                if (fq == 0) st[row0 + rt] = s2; }
    }
};
struct SchedP5 {
    const unsigned char* ws; int G, c;
    __device__ __forceinline__ bool next(int i, Unit& u) const {
        if (i >= 1 || c >= 256) return false;
        const int vc = (c % 8) * 32 + c / 8, pm = vc / 8, pn = vc % 8; u.pm = pm; u.pn = pn; u.mode = M_OUT;
        u.A = (const char*)(ws + WS_MERGED) + (size_t)pm * 256 * D * 2; u.B = (const char*)(ws + WS_WOUT) + (size_t)pn * 256 * D * 2; return true;
    }
};

enum { MAP_ID = 0, MAP_WIN, MAP_UQ };
__device__ __forceinline__ int map_row(int map, int n) {
    if (map == MAP_WIN) { if (n < 7168) return n; if (n < 7232) { const int i = n - 7168; return 7168 + (i < 32 ? 2 * i : 2 * (i - 32) + 1); } return n + 192; }
    if (map == MAP_UQ) { const int h = n / DQK, w = n - h * DQK; if (w < 128) return n; const int i = w - 128; return h * DQK + 128 + (i < 32 ? 2 * i : 2 * (i - 32) + 1); }
    return n;
}
struct WTile { const float* W; bf16_t* WT; const float* kgain; int K, N, row_off, map, k0, n0; float sc; };
struct WSeg { const float* W; bf16_t* WT; const float* kgain; int K, N, row_off, map; float sc; };
__device__ __forceinline__ WTile wtile_of(const WSeg& s, int r) { WTile t; t.W = s.W; t.WT = s.WT; t.kgain = s.kgain; t.K = s.K; t.N = s.N; t.row_off = s.row_off; t.map = s.map; t.sc = s.sc;
    const int nblk = s.N / 64; t.k0 = 64 * (r / nblk); t.n0 = 64 * (r % nblk); return t; }
__device__ __forceinline__ void wtile_issue(const WTile& t, f32x4 (&r)[16], int lane) {
    const float* p = t.W + (size_t)(t.k0 + (lane >> 4)) * t.N + t.n0 + 4 * (lane & 15);
#pragma unroll
    for (int q = 0; q < 16; ++q) r[q] = *(const f32x4*)(p + (size_t)(4 * q) * t.N);
}
__device__ __forceinline__ void wtile_finish(const WTile& t, const f32x4 (&r)[16], LAS float* scr, int lane) {
#pragma unroll
    for (int q = 0; q < 16; ++q) { const int k = 4 * q + (lane >> 4); f32x4 v = r[q] * t.sc; if (t.kgain) v = v * t.kgain[t.k0 + k];
        *(LAS f32x4*)(scr + k * 64 + ((4 * (lane & 15)) ^ (((k >> 3) & 7) << 3))) = v; }
    asm volatile("s_waitcnt lgkmcnt(0)" ::: "memory");
    const int c = lane & 7;
#pragma unroll
    for (int j = 0; j < 8; ++j) { const int n = (lane >> 3) + 8 * j; const LAS float* s = scr + (8 * c) * 64 + (n ^ (c << 3));
        u32x4 o; o.x = cvt_pk_bf16(s[0 * 64], s[1 * 64]); o.y = cvt_pk_bf16(s[2 * 64], s[3 * 64]); o.z = cvt_pk_bf16(s[4 * 64], s[5 * 64]); o.w = cvt_pk_bf16(s[6 * 64], s[7 * 64]);
        *(u32x4*)(t.WT + (size_t)(t.row_off + map_row(t.map, t.n0 + n)) * t.K + t.k0 + 8 * c) = o; }
    asm volatile("s_waitcnt lgkmcnt(0)" ::: "memory");
}
template <int NSEG> __device__ __forceinline__ WTile wtile_decode(const WSeg (&seg)[NSEG], int it) {
    int r = it;
#pragma unroll
    for (int s = 0; s < NSEG - 1; ++s) { const int cnt = (seg[s].K / 64) * (seg[s].N / 64); if (r < cnt) return wtile_of(seg[s], r); r -= cnt; }
    return wtile_of(seg[NSEG - 1], r);
}
template <int NSEG> __device__ __forceinline__ void wconv_run(const WSeg (&seg)[NSEG], int ntiles, int it0, int stride, LAS float* scr, int lane) {
    if (it0 >= ntiles) return;
    f32x4 ra[16], rb[16];
    WTile ta = wtile_decode(seg, it0), tb = ta; wtile_issue(ta, ra, lane);
    for (int it = it0; it < ntiles; it += 2 * stride) {
        const bool hb = it + stride < ntiles; if (hb) { tb = wtile_decode(seg, it + stride); wtile_issue(tb, rb, lane); }
        wtile_finish(ta, ra, scr, lane);
        if (!hb) break;
        const bool ha = it + 2 * stride < ntiles; if (ha) { ta = wtile_decode(seg, it + 2 * stride); wtile_issue(ta, ra, lane); }
        wtile_finish(tb, rb, scr, lane);
    }
}
__device__ __forceinline__ void rms_row_to_bf16(const float* xrow, const float* g, bf16_t* orow, int lane) {
    const f32x4* xr = (const f32x4*)xrow + lane; const f32x4* gr = (const f32x4*)g + lane;
    f32x4 v[8]; float s = 0.f;
#pragma unroll
    for (int j = 0; j < 8; ++j) { v[j] = xr[64 * j]; s += (v[j].x * v[j].x + v[j].y * v[j].y) + (v[j].z * v[j].z + v[j].w * v[j].w); }
    const float rs = 1.0f / sqrtf(wave_sum(s) * (1.f / D) + EPS);
    u32x2* o8 = (u32x2*)orow + lane;
#pragma unroll
    for (int j = 0; j < 8; ++j) { const f32x4 gg = gr[64 * j]; u32x2 w; w.x = cvt_pk_bf16(v[j].x * rs * gg.x, v[j].y * rs * gg.y); w.y = cvt_pk_bf16(v[j].z * rs * gg.z, v[j].w * rs * gg.w); o8[64 * j] = w; }
}
__device__ __forceinline__ void phase0(const Ptrs& P, LAS unsigned char* lds, int vcu, int G, int tid, int lane, int wave) {
    unsigned char* ws = P.ws;
    LAS float* scr = (LAS float*)(lds + wave * 16384);
    const int gw = vcu * NWAVES + wave, NGW = G * NWAVES;
    { const WSeg seg[5] = {
          {P.in[4], (bf16_t*)(ws + WS_WIN), nullptr, D, IN_TOTAL, 0, MAP_WIN, 1.f},
          {P.in[15], (bf16_t*)(ws + WS_WIN), nullptr, D, 6144, 53 * 256, MAP_ID, 1.f},
          {P.in[10], (bf16_t*)(ws + WS_WUQ), P.in[9], 512, 3072, 0, MAP_UQ, QSCALE},
          {P.in[12], (bf16_t*)(ws + WS_WUKV), P.in[11], 512, 4096, 0, MAP_ID, 1.f},
          {P.in[14], (bf16_t*)(ws + WS_WMEM), nullptr, D, 4096, 0, MAP_ID, 1.f}};
      constexpr int NT0 = 32 * (IN_TOTAL / 64) + 32 * 96 + 8 * 48 + 8 * 64 + 32 * 64;
      wconv_run(seg, NT0, gw, NGW, scr, lane); }
    { u32x4* z = (u32x4*)((bf16_t*)(ws + WS_WIN) + (size_t)7232 * D); const int n16 = 192 * D * 2 / 16;
      for (int i = vcu * NTHREADS + tid; i < n16; i += G * NTHREADS) z[i] = (u32x4){0u, 0u, 0u, 0u}; }
    const int gwr = gw >= 416 ? gw - 416 : gw + NGW - 416;
    for (int m = gwr; m < S + ML; m += NGW) {
        if (m < S) rms_row_to_bf16(P.in[0] + (size_t)m * D, P.in[3], (bf16_t*)(ws + WS_H) + (size_t)m * D, lane);
        else rms_row_to_bf16(P.in[1] + (size_t)(m - S) * D, P.in[13], (bf16_t*)(ws + WS_MEMN) + (size_t)(m - S) * D, lane);
    }
    { const int* pos = (const int*)P.in[2]; f32x2* CS = (f32x2*)(ws + WS_CS);
      for (int e = vcu * NTHREADS + tid; e < S * 32; e += G * NTHREADS) { const int row = e >> 5, i = e & 31;
          const double inv = exp2(-(double)i * (13.287712379549449 / 32.0));
          const float invf = (float)inv; const float angf = (float)pos[row] * invf;
          const double a = (double)angf; const double k = rint(a * 0.15915494309189535); const float r = (float)(a - k * 6.283185307179586);
          CS[e] = (f32x2){__cosf(r), __sinf(r)}; } }
    { const float* w = P.in[7]; bf16_t* o = (bf16_t*)(ws + WS_WSM);
      for (int e = vcu * NTHREADS + tid; e < 16 * 128 * 128 / 2; e += G * NTHREADS) { const int idx = e * 2, t = (idx >> 7) & 127, s = idx & 127;
          const float a = s <= t ? w[idx] : 0.f, b = (s + 1) <= t ? w[idx + 1] : 0.f; ((unsigned*)o)[e] = cvt_pk_bf16(a, b); } }
}
__device__ __forceinline__ void phase_wconv2(const Ptrs& P, LAS unsigned char* lds, int vcu, int G, int lane, int wave) {
    unsigned char* ws = P.ws; LAS float* scr = (LAS float*)(lds + wave * 16384);
    const int gw = vcu * NWAVES + wave, NGW = G * NWAVES;
    const WSeg seg[4] = {
        {P.in[17], (bf16_t*)(ws + WS_WBR), nullptr, D, D, 0, MAP_ID, 1.f},
        {P.in[17] + (size_t)D * D, (bf16_t*)(ws + WS_WBR), nullptr, D, D, D, MAP_ID, 1.f},
        {P.in[17] + (size_t)2 * D * D, (bf16_t*)(ws + WS_WBR), nullptr, D, D, 2 * D, MAP_ID, 1.f},
        {P.in[18], (bf16_t*)(ws + WS_WOUT), nullptr, D, D, 0, MAP_ID, 1.f}};
    wconv_run(seg, 4 * 32 * 32, gw, NGW, scr, lane);
}

namespace att {
constexpr int NW = 8, QBLK = 32, KVBLK = 64, QB = 256;
constexpr int SHM_V = KVBLK * DV * 2, SHM_K = KVBLK * DQK * 2;
constexpr int OFF_V = 0, OFF_K = 2 * SHM_V, OFF_WS = 2 * SHM_V + 2 * SHM_K, OFF_QS = OFF_WS + 2048;
constexpr int NQR = 6;
constexpr float THR = 6.f;
#define SBAR() __builtin_amdgcn_sched_barrier(0)
#define KSWZ(row, colB) ((row) * 384 + ((colB) ^ ((((row) >> 1) & 7) << 4)))
__device__ __forceinline__ int v_st(int k, int c) { const int kk = (k & ~0xC) | ((k & 4) << 1) | ((k & 8) >> 1); return ((kk >> 3) * 4 + (c >> 5)) * 512 + ((kk & 7) * 32 + (c & 31)) * 2; }
__device__ __forceinline__ int v_rd_base(int lane) { return ((lane & 3) << 3) | (((lane >> 2) & 3) << 6) | (((lane >> 4) & 1) << 5) | (((lane >> 5) & 1) << 8); }
constexpr int v_rd_off(int d0, int ks, int half) { return d0 * 512 + ks * 4096 + half * 2048; }
__device__ __forceinline__ int crow(int r, int hi) { return (r & 3) + 8 * (r >> 2) + 4 * hi; }
__device__ __forceinline__ void mask_tile(f32x16& p0, f32x16& p1, int dq) {
    const float NEG = -__builtin_inff();
#pragma unroll
    for (int r = 0; r < 16; ++r) { const int c = (r & 3) + 8 * (r >> 2); if (dq - c < 0) p0[r] = NEG; if (dq - c - 32 < 0) p1[r] = NEG; }
}
__device__ __forceinline__ void partialSM(f32x16& p0, f32x16& p1, float& m_reg, float& mn, float& alpha) {
    float pmax = p0[0];
#pragma unroll
    for (int r = 1; r < 16; ++r) pmax = fmaxf(pmax, p0[r]);
#pragma unroll
    for (int r = 0; r < 16; ++r) pmax = fmaxf(pmax, p1[r]);
    { auto rr = __builtin_amdgcn_permlane32_swap(__float_as_uint(pmax), __float_as_uint(pmax), false, false); pmax = fmaxf(__uint_as_float(rr[0]), __uint_as_float(rr[1])); }
    if (__builtin_expect(__all((pmax - m_reg) <= THR), 1)) { mn = m_reg; alpha = 1.f; }
    else { mn = fmaxf(m_reg, pmax); alpha = fast_exp2(m_reg - mn); m_reg = mn; }
#pragma unroll
    for (int r = 0; r < 16; ++r) p0[r] = p0[r] - mn;
#pragma unroll
    for (int r = 0; r < 16; ++r) p1[r] = p1[r] - mn;
#pragma unroll
    for (int r = 0; r < 16; ++r) p0[r] = fast_exp2(p0[r]);
}
__device__ __forceinline__ void finishSM(f32x16& p0, f32x16& p1, float alpha, float& l_reg, bf16x8& pa0, bf16x8& pa1, bf16x8& pa2, bf16x8& pa3) {
#pragma unroll
    for (int r = 0; r < 16; ++r) p1[r] = fast_exp2(p1[r]);
    float ps = 0;
#pragma unroll
    for (int r = 0; r < 16; ++r) ps += p0[r];
#pragma unroll
    for (int r = 0; r < 16; ++r) ps += p1[r];
    { auto rr = __builtin_amdgcn_permlane32_swap(__float_as_uint(ps), __float_as_uint(ps), false, false); ps = __uint_as_float(rr[0]) + __uint_as_float(rr[1]); }
    l_reg = l_reg * alpha + ps;
#define PK4(P, B_, OUT) do { unsigned a0 = cvt_pk_bf16(P[B_+0], P[B_+1]), a1 = cvt_pk_bf16(P[B_+2], P[B_+3]); unsigned b0 = cvt_pk_bf16(P[B_+4], P[B_+5]), b1 = cvt_pk_bf16(P[B_+6], P[B_+7]); \
        auto r0 = __builtin_amdgcn_permlane32_swap(a0, b0, false, false); auto r1 = __builtin_amdgcn_permlane32_swap(a1, b1, false, false); \
        u32x4 w = {r0[0], r1[0], r0[1], r1[1]}; OUT = *reinterpret_cast<bf16x8*>(&w); } while (0)
    PK4(p0, 0, pa0); PK4(p0, 8, pa1); PK4(p1, 0, pa2); PK4(p1, 8, pa3);
#undef PK4
}
template <int KB>
__device__ __forceinline__ void qkt(f32x16& p0, f32x16& p1, const char* K_lds, int r32, int hi, const bf16x8* qr, const char* qs) {
    p0 = f32x16{}; p1 = f32x16{};
    const char* kb[4];
#pragma unroll
    for (int dd = 0; dd < 4; ++dd) kb[dd] = K_lds + KB * SHM_K + KSWZ(r32, (dd * 16 + hi * 8) * 2);
#pragma unroll
    for (int d0 = 0; d0 < 12; ++d0) { const char* a = kb[d0 & 3] + (d0 >> 2) * 128;
        bf16x8 b0 = *reinterpret_cast<const bf16x8*>(a);
        bf16x8 b1 = *reinterpret_cast<const bf16x8*>(a + 32 * 384);
        const bf16x8 q = d0 < NQR ? qr[d0] : *reinterpret_cast<const bf16x8*>(qs + (d0 - NQR) * 1024);
        p0 = __builtin_amdgcn_mfma_f32_32x32x16_bf16(b0, q, p0, 0, 0, 0);
        p1 = __builtin_amdgcn_mfma_f32_32x32x16_bf16(b1, q, p1, 0, 0, 0); }
}
#define TRRD(dst, off) asm volatile("ds_read_b64_tr_b16 %0, %1 offset:%2" : "=&v"(dst) : "v"(vb0), "i"(off) : "memory")
#define PV_D0(OO, VBOFF, d0) do { s16x4 l0, l1, l2, l3, h0, h1, h2, h3; constexpr int b_ = (VBOFF) + v_rd_off(d0, 0, 0); \
        TRRD(l0, b_); TRRD(h0, b_ + 2048); TRRD(l1, b_ + 4096); TRRD(h1, b_ + 6144); TRRD(l2, b_ + 8192); TRRD(h2, b_ + 10240); TRRD(l3, b_ + 12288); TRRD(h3, b_ + 14336); \
        asm volatile("s_waitcnt lgkmcnt(0)" ::: "memory"); SBAR(); \
        OO = __builtin_amdgcn_mfma_f32_32x32x16_bf16(pa0, (bf16x8){l0[0], l0[1], l0[2], l0[3], h0[0], h0[1], h0[2], h0[3]}, OO, 0, 0, 0); \
        OO = __builtin_amdgcn_mfma_f32_32x32x16_bf16(pa1, (bf16x8){l1[0], l1[1], l1[2], l1[3], h1[0], h1[1], h1[2], h1[3]}, OO, 0, 0, 0); \
        OO = __builtin_amdgcn_mfma_f32_32x32x16_bf16(pa2, (bf16x8){l2[0], l2[1], l2[2], l2[3], h2[0], h2[1], h2[2], h2[3]}, OO, 0, 0, 0); \
        OO = __builtin_amdgcn_mfma_f32_32x32x16_bf16(pa3, (bf16x8){l3[0], l3[1], l3[2], l3[3], h3[0], h3[1], h3[2], h3[3]}, OO, 0, 0, 0); } while (0)
template <int VB>
__device__ __forceinline__ void pv_tile(f32x16* o, int vb0, bf16x8 pa0, bf16x8 pa1, bf16x8 pa2, bf16x8 pa3) {
    PV_D0(o[0], VB * SHM_V, 0); PV_D0(o[1], VB * SHM_V, 1); PV_D0(o[2], VB * SHM_V, 2); PV_D0(o[3], VB * SHM_V, 3);
}

__device__ __forceinline__ void attn_block(const bf16_t* Qh, const bf16_t* Kh, const bf16_t* Vh, bf16_t* ZY, int P0, char* lds, const int tid, const bool dry = false) {
    const int wid = __builtin_amdgcn_readfirstlane(tid >> 6), lane = tid & 63, r32 = lane & 31, hi = lane >> 5;
    const int NT = (P0 + QB) / KVBLK;
    const int qlo = P0 + wid * QBLK, qm = qlo + r32 - 4 * hi;
    char* V_lds = lds + OFF_V; char* K_lds = lds + OFF_K;
    float* wsf = (float*)(lds + OFF_WS) + wid * 64; float* li_l = wsf, * al_l = wsf + 32;
    float m_reg = -1e30f, l_reg = 0; f32x16 o[4] = {};
    const int sr = tid >> 4, sc = (tid & 15) * 8, vst0 = v_st(sr, sc), vst1 = v_st(32 + sr, sc);
    int kws[3];
#pragma unroll
    for (int i = 0; i < 3; ++i) { const int id = tid + 512 * i, row = id / 24, ch = id - row * 24; kws[i] = KSWZ(row, ch * 16); }
    const int vb0 = (int)(uintptr_t)V_lds + v_rd_base(lane);
    bf16x8 qr[NQR];
    char* qs = lds + OFF_QS + wid * ((12 - NQR) * 1024) + lane * 16;
#pragma unroll
    for (int d0 = 0; d0 < 12; ++d0) { const bf16x8 q = *reinterpret_cast<const bf16x8*>(Qh + (size_t)(P0 + wid * QBLK + r32) * DQK + d0 * 16 + hi * 8);
        if (d0 < NQR) qr[d0] = q; else *reinterpret_cast<bf16x8*>(qs + (d0 - NQR) * 1024) = q; }
    bf16x8 st_k0, st_k1, st_k2, st_v0, st_v1;
#define VMW() asm volatile("s_waitcnt vmcnt(0)" ::: "memory")
#define SLOAD(t) do { const char* kp = (const char*)Kh + (size_t)(t) * SHM_K + tid * 16; st_k0 = *(const bf16x8*)kp; st_k1 = *(const bf16x8*)(kp + 8192); st_k2 = *(const bf16x8*)(kp + 16384); \
        st_v0 = *(const bf16x8*)(Vh + (size_t)((t) * KVBLK + sr) * DV + sc); st_v1 = *(const bf16x8*)(Vh + (size_t)((t) * KVBLK + 32 + sr) * DV + sc); } while (0)
#define SWRITE(bf) do { *(bf16x8*)(K_lds + (bf) * SHM_K + kws[0]) = st_k0; *(bf16x8*)(K_lds + (bf) * SHM_K + kws[1]) = st_k1; *(bf16x8*)(K_lds + (bf) * SHM_K + kws[2]) = st_k2; \
        *(bf16x8*)(V_lds + (bf) * SHM_V + vst0) = st_v0; *(bf16x8*)(V_lds + (bf) * SHM_V + vst1) = st_v1; } while (0)
#define RESC(a) do { if (__any((a) < 1.f)) { if (hi == 0) al_l[r32] = (a); asm volatile("s_waitcnt lgkmcnt(0)" ::: "memory"); \
        _Pragma("unroll") for (int d_ = 0; d_ < 4; ++d_) _Pragma("unroll") for (int r = 0; r < 16; ++r) o[d_][r] *= al_l[crow(r, hi)]; } } while (0)
#define MASKT(P0_, P1_, t) do { const int kb_ = (t) * KVBLK; if (kb_ + KVBLK - 1 > qlo) mask_tile(P0_, P1_, qm - kb_); } while (0)
    f32x16 pA0, pA1, pB0, pB1; float mnA, mnB, alA, alB; bf16x8 pa0, pa1, pa2, pa3;
    SLOAD(0); VMW(); SWRITE(0); SBAR(); SLOAD(1);
    __syncthreads();
    SBAR(); qkt<0>(pA0, pA1, K_lds, r32, hi, qr, qs);
    MASKT(pA0, pA1, 0); partialSM(pA0, pA1, m_reg, mnA, alA);
    VMW(); SWRITE(1);
    __syncthreads();
#define HALF_STEP(PX0, PX1, mnX, alX, PY0, PY1, alY, t, KB, VB, SB) do { \
        SBAR(); qkt<KB>(PX0, PX1, K_lds, r32, hi, qr, qs); \
        finishSM(PY0, PY1, alY, l_reg, pa0, pa1, pa2, pa3); SBAR(); \
        if ((t) + 1 < NT) { SLOAD((t) + 1); SBAR(); } \
        pv_tile<VB>(o, vb0, pa0, pa1, pa2, pa3); MASKT(PX0, PX1, (t)); partialSM(PX0, PX1, m_reg, mnX, alX); \
        __syncthreads(); \
        if ((t) + 1 < NT) { VMW(); SWRITE(SB); } \
        RESC(alX); __syncthreads(); } while (0)
    for (int t = 1; t + 1 < NT; t += 2) {
        HALF_STEP(pB0, pB1, mnB, alB, pA0, pA1, alA, t, 1, 0, 0);
        HALF_STEP(pA0, pA1, mnA, alA, pB0, pB1, alB, t + 1, 0, 1, 1);
    }
    SBAR(); qkt<1>(pB0, pB1, K_lds, r32, hi, qr, qs); SBAR();
    finishSM(pA0, pA1, alA, l_reg, pa0, pa1, pa2, pa3); SBAR();
    pv_tile<0>(o, vb0, pa0, pa1, pa2, pa3);
    MASKT(pB0, pB1, NT - 1); partialSM(pB0, pB1, m_reg, mnB, alB); RESC(alB);
    finishSM(pB0, pB1, alB, l_reg, pa0, pa1, pa2, pa3); SBAR(); pv_tile<1>(o, vb0, pa0, pa1, pa2, pa3);
    if (hi == 0) li_l[r32] = l_reg; asm volatile("s_waitcnt lgkmcnt(0)" ::: "memory");
    float rli[16];
#pragma unroll
    for (int r = 0; r < 16; ++r) rli[r] = fast_rcp(li_l[crow(r, hi)]);
    __syncthreads();
    bf16_t* stg = (bf16_t*)lds + wid * 4096;
#pragma unroll
    for (int r = 0; r < 16; ++r) { const int orow = crow(r, hi);
#pragma unroll
        for (int d0 = 0; d0 < 4; ++d0) { const float v = o[d0][r] * rli[r]; const float vn = __shfl_xor(v, 1);
            if ((r32 & 1) == 0) *(unsigned*)(stg + orow * 128 + d0 * 32 + r32) = cvt_pk_bf16(v, vn); } }
    asm volatile("s_waitcnt lgkmcnt(0)" ::: "memory");
    bf16_t* zy = ZY + (size_t)(P0 + wid * QBLK) * D;
#pragma unroll
    for (int i = 0; i < 8; ++i) { const int id = lane + 64 * i, row = id >> 4, ch = id & 15; float a[8], z[8];
        unpack8(*(const u32x4*)(stg + row * 128 + ch * 8), a); bf16_t* p = zy + (size_t)row * D + ch * 8; unpack8(*(const u32x4*)p, z);
#pragma unroll
        for (int j = 0; j < 8; ++j) a[j] *= z[j];
        if (!dry) *(u32x4*)p = pack8(a); }
    __syncthreads();
#undef SLOAD
#undef SWRITE
#undef RESC
#undef MASKT
#undef HALF_STEP
}

constexpr int NQR2 = 12;
constexpr int OFF2_V = 0, OFF2_K = 3 * SHM_V, OFF2_WS = OFF2_K + 2 * SHM_K, OFF2_QS = OFF2_WS + 2048;
__device__ __forceinline__ void glds16(const void* gsrc, unsigned lds_dst) { unsigned keep;
    asm volatile("s_mov_b32 %0, m0\n\ts_mov_b32 m0, %2\n\ts_nop 0\n\tglobal_load_lds_dwordx4 %1, off\n\ts_mov_b32 m0, %0" : "=&s"(keep) : "v"(gsrc), "s"(lds_dst) : "memory"); }
__device__ __forceinline__ void qkt2(f32x16& p0, f32x16& p1, const char* kbase, const int (&ko)[4], const bf16x8* qr, const char* qs) {
    p0 = f32x16{}; p1 = f32x16{};
#pragma unroll
    for (int d0 = 0; d0 < 12; ++d0) { const char* a = kbase + ko[d0 & 3] + (d0 >> 2) * 128;
        bf16x8 b0 = *reinterpret_cast<const bf16x8*>(a);
        bf16x8 b1 = *reinterpret_cast<const bf16x8*>(a + 32 * 384);
        const bf16x8 q = d0 < NQR2 ? qr[d0 < NQR2 ? d0 : 0] : *reinterpret_cast<const bf16x8*>(qs + (d0 - NQR2) * 1024);
        p0 = __builtin_amdgcn_mfma_f32_32x32x16_bf16(b0, q, p0, 0, 0, 0);
        p1 = __builtin_amdgcn_mfma_f32_32x32x16_bf16(b1, q, p1, 0, 0, 0); }
}
typedef short v4i16_t __attribute__((ext_vector_type(4)));
__device__ __forceinline__ s16x4 vtr(const LAS char* p) { return __builtin_bit_cast(s16x4, __builtin_amdgcn_ds_read_tr16_b64_v4i16((LAS v4i16_t*)p)); }
__device__ __forceinline__ void pv_tile2(f32x16* o, const LAS char* vp, bf16x8 pa0, bf16x8 pa1, bf16x8 pa2, bf16x8 pa3) {
#pragma unroll
    for (int d0 = 0; d0 < 4; ++d0) {
        const s16x4 l0 = vtr(vp + d0 * 512), h0 = vtr(vp + d0 * 512 + 2048), l1 = vtr(vp + d0 * 512 + 4096), h1 = vtr(vp + d0 * 512 + 6144);
        const s16x4 l2 = vtr(vp + d0 * 512 + 8192), h2 = vtr(vp + d0 * 512 + 10240), l3 = vtr(vp + d0 * 512 + 12288), h3 = vtr(vp + d0 * 512 + 14336);
        o[d0] = __builtin_amdgcn_mfma_f32_32x32x16_bf16(pa0, (bf16x8){l0[0], l0[1], l0[2], l0[3], h0[0], h0[1], h0[2], h0[3]}, o[d0], 0, 0, 0);
        o[d0] = __builtin_amdgcn_mfma_f32_32x32x16_bf16(pa1, (bf16x8){l1[0], l1[1], l1[2], l1[3], h1[0], h1[1], h1[2], h1[3]}, o[d0], 0, 0, 0);
        o[d0] = __builtin_amdgcn_mfma_f32_32x32x16_bf16(pa2, (bf16x8){l2[0], l2[1], l2[2], l2[3], h2[0], h2[1], h2[2], h2[3]}, o[d0], 0, 0, 0);
        o[d0] = __builtin_amdgcn_mfma_f32_32x32x16_bf16(pa3, (bf16x8){l3[0], l3[1], l3[2], l3[3], h3[0], h3[1], h3[2], h3[3]}, o[d0], 0, 0, 0); }
}
__device__ __forceinline__ void attn_block2(const bf16_t* Qh, const bf16_t* Kh, const bf16_t* Vh, bf16_t* ZY, int P0, char* lds, const int tid, const bool dry = false) {
    const int wid = __builtin_amdgcn_readfirstlane(tid >> 6), lane = tid & 63, r32 = lane & 31, hi = lane >> 5;
    const int NT = (P0 + QB) / KVBLK;
    const int qlo = P0 + wid * QBLK, qm = qlo + r32 - 4 * hi;
    char* V_lds = lds + OFF2_V; char* K_lds = lds + OFF2_K;
    float* wsf = (float*)(lds + OFF2_WS) + wid * 64; float* li_l = wsf, * al_l = wsf + 32;
    float m_reg = -1e30f, l_reg = 0; f32x16 o[4] = {};
    const unsigned lds0 = (unsigned)(uintptr_t)lds; const bool lead = ATT_LEADMODE == 0 ? (wid < 4) : (ATT_LEADMODE == 1);
    int kso[3], vso[2];
#pragma unroll
    for (int j = 0; j < 3; ++j) { const int q = (wid * 3 + j) * 1024 + lane * 16, row = q / 384, pos = q - row * 384; kso[j] = row * 384 + (pos ^ (((row >> 1) & 7) << 4)); }
#pragma unroll
    for (int j = 0; j < 2; ++j) { const int q = (wid * 2 + j) * 1024 + lane * 16, sub = q >> 9, within = q & 511, kk = (sub >> 2) * 8 + (within >> 6), cc = (within & 63) >> 1;
        const int k = (kk & ~0xC) | ((kk & 4) << 1) | ((kk & 8) >> 1), c = (sub & 3) * 32 + cc; vso[j] = k * (DV * 2) + c * 2; }
#define DMA_KV(t, kb, vb) do { const char* kt_ = (const char*)Kh + (size_t)(t) * SHM_K; const char* vt_ = (const char*)Vh + (size_t)(t) * SHM_V; \
        _Pragma("unroll") for (int j_ = 0; j_ < 3; ++j_) glds16(kt_ + kso[j_], (unsigned)__builtin_amdgcn_readfirstlane(lds0 + OFF2_K + (kb) * SHM_K + (wid * 3 + j_) * 1024)); \
        _Pragma("unroll") for (int j_ = 0; j_ < 2; ++j_) glds16(vt_ + vso[j_], (unsigned)__builtin_amdgcn_readfirstlane(lds0 + OFF2_V + (vb) * SHM_V + (wid * 2 + j_) * 1024)); } while (0)
#define WAIT_BAR() asm volatile("s_waitcnt vmcnt(0) lgkmcnt(0)\n\ts_barrier" ::: "memory")
    int ko[4];
#pragma unroll
    for (int dd = 0; dd < 4; ++dd) ko[dd] = KSWZ(r32, (dd * 16 + hi * 8) * 2);
    const LAS char* vbb = (const LAS char*)lds + OFF2_V + v_rd_base(lane);
    DMA_KV(0, 0, 0);
    bf16x8 qr[NQR2];
    char* qs = lds + OFF2_QS + wid * ((12 - NQR2) * 1024) + lane * 16;
#pragma unroll
    for (int d0 = 0; d0 < 12; ++d0) { const bf16x8 q = *reinterpret_cast<const bf16x8*>(Qh + (size_t)(P0 + wid * QBLK + r32) * DQK + d0 * 16 + hi * 8);
        if (d0 < NQR2) qr[d0 < NQR2 ? d0 : 0] = q; else *reinterpret_cast<bf16x8*>(qs + (d0 - NQR2) * 1024) = q; }
#define RESC(a) do { if (__any((a) < 1.f)) { if (hi == 0) al_l[r32] = (a); asm volatile("s_waitcnt lgkmcnt(0)" ::: "memory"); \
        _Pragma("unroll") for (int d_ = 0; d_ < 4; ++d_) _Pragma("unroll") for (int r = 0; r < 16; ++r) o[d_][r] *= al_l[crow(r, hi)]; } } while (0)
#define MASKT(P0_, P1_, t) do { const int kb_ = (t) * KVBLK; if (kb_ + KVBLK - 1 > qlo) mask_tile(P0_, P1_, qm - kb_); } while (0)
    f32x16 pA0, pA1, pB0, pB1; float mnA, mnB, alA, alB; bf16x8 pa0, pa1, pa2, pa3;
#if ATT_PROBE
    unsigned long long pacc_ = 0;
#endif
    WAIT_BAR();
    DMA_KV(1, 1, 1);
    SBAR(); qkt2(pA0, pA1, K_lds, ko, qr, qs);
    MASKT(pA0, pA1, 0); partialSM(pA0, pA1, m_reg, mnA, alA);
    WAIT_BAR();
    int vcur = 0, vnext = 2 * SHM_V;
#define ROT3(x) ((x) == 2 * SHM_V ? 0 : (x) + SHM_V)
#if ATT_PROBE
#define TP(k, stmt) do { if (ATT_PROBE == (k)) { SBAR(); const unsigned long long t0_ = __builtin_amdgcn_s_memrealtime(); stmt; SBAR(); pacc_ += __builtin_amdgcn_s_memrealtime() - t0_; } else { stmt; } } while (0)
#else
#define TP(k, stmt) do { stmt; } while (0)
#endif
#define HALF_STEP_A(PX0, PX1, mnX, alX, PY0, PY1, alY, t, KBO) do { \
        if ((t) + 1 < NT) DMA_KV((t) + 1, 1 - (KBO), vnext / SHM_V); \
        SBAR(); TP(1, qkt2(PX0, PX1, K_lds + (KBO) * SHM_K, ko, qr, qs)); \
        TP(2, finishSM(PY0, PY1, alY, l_reg, pa0, pa1, pa2, pa3)); SBAR(); \
        TP(3, pv_tile2(o, vbb + vcur, pa0, pa1, pa2, pa3)); TP(4, MASKT(PX0, PX1, (t)); partialSM(PX0, PX1, m_reg, mnX, alX)); \
        TP(5, RESC(alX); vcur = ROT3(vcur); vnext = ROT3(vnext); \
        WAIT_BAR()); } while (0)
#define HALF_STEP_B(PX0, PX1, mnX, alX, PY0, PY1, alY, t, KBO) do { \
        TP(6, if ((t) + 1 < NT) DMA_KV((t) + 1, 1 - (KBO), vnext / SHM_V)); \
        SBAR(); TP(2, finishSM(PY0, PY1, alY, l_reg, pa0, pa1, pa2, pa3)); SBAR(); \
        TP(3, pv_tile2(o, vbb + vcur, pa0, pa1, pa2, pa3)); SBAR(); \
        TP(1, qkt2(PX0, PX1, K_lds + (KBO) * SHM_K, ko, qr, qs)); SBAR(); \
        TP(4, MASKT(PX0, PX1, (t)); partialSM(PX0, PX1, m_reg, mnX, alX)); \
        TP(5, RESC(alX); vcur = ROT3(vcur); vnext = ROT3(vnext); \
        WAIT_BAR()); } while (0)
    if (ATT_PRIO && !lead) __builtin_amdgcn_s_setprio(1);
    if (lead) {
        for (int t = 1; t + 1 < NT; t += 2) {
            HALF_STEP_A(pB0, pB1, mnB, alB, pA0, pA1, alA, t, 1);
            HALF_STEP_A(pA0, pA1, mnA, alA, pB0, pB1, alB, t + 1, 0);
        }
    } else {
        for (int t = 1; t + 1 < NT; t += 2) {
            HALF_STEP_B(pB0, pB1, mnB, alB, pA0, pA1, alA, t, 1);
            HALF_STEP_B(pA0, pA1, mnA, alA, pB0, pB1, alB, t + 1, 0);
        }
    }
    if (ATT_PRIO && !lead) __builtin_amdgcn_s_setprio(0);
    SBAR(); qkt2(pB0, pB1, K_lds + SHM_K, ko, qr, qs); SBAR();
    finishSM(pA0, pA1, alA, l_reg, pa0, pa1, pa2, pa3); SBAR();
    pv_tile2(o, vbb + vcur, pa0, pa1, pa2, pa3); vcur = ROT3(vcur);
    MASKT(pB0, pB1, NT - 1); partialSM(pB0, pB1, m_reg, mnB, alB); RESC(alB);
    finishSM(pB0, pB1, alB, l_reg, pa0, pa1, pa2, pa3); SBAR(); pv_tile2(o, vbb + vcur, pa0, pa1, pa2, pa3);
#if ATT_PROBE
    { const unsigned long long t1_ = __builtin_amdgcn_s_memrealtime(); while (__builtin_amdgcn_s_memrealtime() - t1_ < 4ull * pacc_) __builtin_amdgcn_s_sleep(8); }
#endif
    if (hi == 0) li_l[r32] = l_reg; asm volatile("s_waitcnt lgkmcnt(0)" ::: "memory");
    float rli[16];
#pragma unroll
    for (int r = 0; r < 16; ++r) rli[r] = fast_rcp(li_l[crow(r, hi)]);
    __syncthreads();
    bf16_t* stg = (bf16_t*)lds + wid * 4096;
#pragma unroll
    for (int r = 0; r < 16; ++r) { const int orow = crow(r, hi);
#pragma unroll
        for (int d0 = 0; d0 < 4; ++d0) { const float v = o[d0][r] * rli[r]; const float vn = __shfl_xor(v, 1);
            if ((r32 & 1) == 0) *(unsigned*)(stg + orow * 128 + d0 * 32 + r32) = cvt_pk_bf16(v, vn); } }
    asm volatile("s_waitcnt lgkmcnt(0)" ::: "memory");
    bf16_t* zy = ZY + (size_t)(P0 + wid * QBLK) * D;
#pragma unroll
    for (int i = 0; i < 8; ++i) { const int id = lane + 64 * i, row = id >> 4, ch = id & 15; float a[8], z[8];
        unpack8(*(const u32x4*)(stg + row * 128 + ch * 8), a); bf16_t* p = zy + (size_t)row * D + ch * 8; unpack8(*(const u32x4*)p, z);
#pragma unroll
        for (int j = 0; j < 8; ++j) a[j] *= z[j];
        if (!dry) *(u32x4*)p = pack8(a); }
    __syncthreads();
#undef DMA_KV
#undef WAIT_BAR
#undef RESC
#undef MASKT
#undef ROT3
#undef HALF_STEP_A
#undef HALF_STEP_B
}

constexpr int OFF3_V = 0, OFF3_K = 4 * SHM_V, OFF3_WS = OFF3_K + 3 * SHM_K + 256;
__device__ __forceinline__ void attn_block3(const bf16_t* Qh, const bf16_t* Kh, const bf16_t* Vh, bf16_t* ZY, int P0, char* lds, const int tid, const bool dry = false) {
    const int wid = __builtin_amdgcn_readfirstlane(tid >> 6), lane = tid & 63, r32 = lane & 31, hi = lane >> 5;
    const bool lag = wid >= 4;
    const int NT = (P0 + QB) / KVBLK;
    const int qlo = P0 + wid * QBLK, qm = qlo + r32 - 4 * hi;
    char* K_lds = lds + OFF3_K;
    float* wsf = (float*)(lds + OFF3_WS) + wid * 64; float* li_l = wsf, * al_l = wsf + 32;
    float m_reg = -1e30f, l_reg = 0; f32x16 o[4] = {};
    const unsigned lds0 = (unsigned)(uintptr_t)lds;
    int kso[3], vso[2];
#pragma unroll
    for (int j = 0; j < 3; ++j) { const int q = (wid * 3 + j) * 1024 + lane * 16, row = q / 384, pos = q - row * 384; kso[j] = row * 384 + (pos ^ (((row >> 1) & 7) << 4)); }
#pragma unroll
    for (int j = 0; j < 2; ++j) { const int q = (wid * 2 + j) * 1024 + lane * 16, sub = q >> 9, within = q & 511, kk = (sub >> 2) * 8 + (within >> 6), cc = (within & 63) >> 1;
        const int k = (kk & ~0xC) | ((kk & 4) << 1) | ((kk & 8) >> 1), c = (sub & 3) * 32 + cc; vso[j] = k * (DV * 2) + c * 2; }
    int kis = 0, vis = 0, kq = 0, vp = 0;
#define ROTK(x) ((x) == 2 * SHM_K ? 0 : (x) + SHM_K)
#define ROTV(x) ((x) == 3 * SHM_V ? 0 : (x) + SHM_V)
#define DMA_TILE(t) do { const char* kt_ = (const char*)Kh + (size_t)(t) * SHM_K; const char* vt_ = (const char*)Vh + (size_t)(t) * SHM_V; \
        _Pragma("unroll") for (int j_ = 0; j_ < 3; ++j_) glds16(kt_ + kso[j_], (unsigned)__builtin_amdgcn_readfirstlane(lds0 + OFF3_K + kis + (wid * 3 + j_) * 1024)); \
        _Pragma("unroll") for (int j_ = 0; j_ < 2; ++j_) glds16(vt_ + vso[j_], (unsigned)__builtin_amdgcn_readfirstlane(lds0 + OFF3_V + vis + (wid * 2 + j_) * 1024)); \
        kis = ROTK(kis); vis = ROTV(vis); } while (0)
#define END_M() asm volatile("s_waitcnt vmcnt(0) lgkmcnt(0)\n\ts_barrier" ::: "memory")
#define END_V() asm volatile("s_waitcnt lgkmcnt(0)\n\ts_barrier" ::: "memory")
    int ko[4];
#pragma unroll
    for (int dd = 0; dd < 4; ++dd) ko[dd] = KSWZ(r32, (dd * 16 + hi * 8) * 2);
    const LAS char* vbb = (const LAS char*)lds + OFF3_V + v_rd_base(lane);
    DMA_TILE(0); DMA_TILE(1);
    bf16x8 qr[12];
#pragma unroll
    for (int d0 = 0; d0 < 12; ++d0) qr[d0] = *reinterpret_cast<const bf16x8*>(Qh + (size_t)(P0 + wid * QBLK + r32) * DQK + d0 * 16 + hi * 8);
#define RESC(a) do { if (__any((a) < 1.f)) { if (hi == 0) al_l[r32] = (a); asm volatile("s_waitcnt lgkmcnt(0)" ::: "memory"); \
        _Pragma("unroll") for (int d_ = 0; d_ < 4; ++d_) _Pragma("unroll") for (int r = 0; r < 16; ++r) o[d_][r] *= al_l[crow(r, hi)]; } } while (0)
#if ATT_PROBE
    unsigned long long pacc_ = 0;
#define TP3(k, stmt) do { if (ATT_PROBE == (k)) { SBAR(); const unsigned long long t0_ = __builtin_amdgcn_s_memrealtime(); stmt; SBAR(); pacc_ += __builtin_amdgcn_s_memrealtime() - t0_; } else { stmt; } } while (0)
#else
#define TP3(k, stmt) do { stmt; } while (0)
#endif
    f32x16 p0, p1; float mn, al; bf16x8 pa0, pa1, pa2, pa3;
    END_M();
    if (lag) END_V();
    for (int i = 0; i < NT; ++i) {
        const char* kb_ = K_lds + kq; bf16x8 ka[8], kb2[8];
#define KLOAD(dst, blk) do { _Pragma("unroll") for (int dd = 0; dd < 4; ++dd) { const char* a = kb_ + ko[dd] + (blk) * 128; dst[2 * dd] = *reinterpret_cast<const bf16x8*>(a); dst[2 * dd + 1] = *reinterpret_cast<const bf16x8*>(a + 32 * 384); } } while (0)
#define KMMA(srcf, blk) do { _Pragma("unroll") for (int dd = 0; dd < 4; ++dd) { p0 = __builtin_amdgcn_mfma_f32_32x32x16_bf16(srcf[2 * dd], qr[(blk) * 4 + dd], p0, 0, 0, 0); p1 = __builtin_amdgcn_mfma_f32_32x32x16_bf16(srcf[2 * dd + 1], qr[(blk) * 4 + dd], p1, 0, 0, 0); } } while (0)
        SBAR();
        { _Pragma("unroll") for (int dd = 0; dd < 2; ++dd) { const char* a = kb_ + ko[dd]; ka[2 * dd] = *reinterpret_cast<const bf16x8*>(a); ka[2 * dd + 1] = *reinterpret_cast<const bf16x8*>(a + 32 * 384); } }
        SBAR();
        TP3(1, if (i >= 1) { pv_tile2(o, vbb + vp, pa0, pa1, pa2, pa3); vp = ROTV(vp); });
        SBAR();
#if ATT_PROBE == 2
        const unsigned long long tq0_ = __builtin_amdgcn_s_memrealtime();
#endif
        { p0 = f32x16{}; p1 = f32x16{};
          { _Pragma("unroll") for (int dd = 2; dd < 4; ++dd) { const char* a = kb_ + ko[dd]; ka[2 * dd] = *reinterpret_cast<const bf16x8*>(a); ka[2 * dd + 1] = *reinterpret_cast<const bf16x8*>(a + 32 * 384); } }
          KLOAD(kb2, 1); SBAR(); KMMA(ka, 0); SBAR(); KLOAD(ka, 2); SBAR(); KMMA(kb2, 1); SBAR(); KMMA(ka, 2);
#undef KLOAD
#undef KMMA
          kq = ROTK(kq); }
#if ATT_PROBE == 2
        SBAR(); pacc_ += __builtin_amdgcn_s_memrealtime() - tq0_;
#endif
        TP3(3, END_M());
        TP3(4, if (i + 2 < NT) DMA_TILE(i + 2));
        SBAR();
        TP3(5, { const int kb_ = i * KVBLK; if (kb_ + KVBLK - 1 > qlo) mask_tile(p0, p1, qm - kb_); }
        partialSM(p0, p1, m_reg, mn, al); RESC(al);
        finishSM(p0, p1, al, l_reg, pa0, pa1, pa2, pa3));
        TP3(6, END_V());
    }
    SBAR(); pv_tile2(o, vbb + vp, pa0, pa1, pa2, pa3);
    if (!lag) END_V();
#if ATT_PROBE
    { const unsigned long long t1_ = __builtin_amdgcn_s_memrealtime(); while (__builtin_amdgcn_s_memrealtime() - t1_ < 4ull * pacc_) __builtin_amdgcn_s_sleep(8); }
#endif
    if (hi == 0) li_l[r32] = l_reg; asm volatile("s_waitcnt lgkmcnt(0)" ::: "memory");
    float rli[16];
#pragma unroll
    for (int r = 0; r < 16; ++r) rli[r] = fast_rcp(li_l[crow(r, hi)]);
    __syncthreads();
    bf16_t* stg = (bf16_t*)lds + wid * 4096;
#pragma unroll
    for (int r = 0; r < 16; ++r) { const int orow = crow(r, hi);
#pragma unroll
        for (int d0 = 0; d0 < 4; ++d0) { const float v = o[d0][r] * rli[r]; const float vn = __shfl_xor(v, 1);
            if ((r32 & 1) == 0) *(unsigned*)(stg + orow * 128 + d0 * 32 + r32) = cvt_pk_bf16(v, vn); } }
    asm volatile("s_waitcnt lgkmcnt(0)" ::: "memory");
    bf16_t* zy = ZY + (size_t)(P0 + wid * QBLK) * D;
#pragma unroll
    for (int i = 0; i < 8; ++i) { const int id = lane + 64 * i, row = id >> 4, ch = id & 15; float a[8], z[8];
        unpack8(*(const u32x4*)(stg + row * 128 + ch * 8), a); bf16_t* p = zy + (size_t)row * D + ch * 8; unpack8(*(const u32x4*)p, z);
#pragma unroll
        for (int j = 0; j < 8; ++j) a[j] *= z[j];
        if (!dry) *(u32x4*)p = pack8(a); }
    __syncthreads();
#undef TP3
#undef ROTK
#undef ROTV
#undef DMA_TILE
#undef END_M
#undef END_V
#undef RESC
}

__device__ __forceinline__ void mixer_block(unsigned char* ws, const float* ln_g, const float* ln_b, const float* b_s, int chunk, int g, char* lds, const int tid, const bool dry = false) {
    const int wid = __builtin_amdgcn_readfirstlane(tid >> 6), lane = tid & 63, r32 = lane & 31, hi = lane >> 5;
    const int rb = wid & 3, dh = wid >> 2;
    const bf16_t* Vg = (const bf16_t*)(ws + WS_VG); const f32x2* VMR = (const f32x2*)(ws + WS_VMR);
    const int sr = tid >> 4, sc = (tid & 15) * 8; const int row0 = chunk * 128, col0 = g * 128;
    float lg[8], lb[8];
#pragma unroll
    for (int j = 0; j < 8; ++j) { lg[j] = ln_g[col0 + sc + j]; lb[j] = ln_b[col0 + sc + j]; }
#pragma unroll
    for (int q = 0; q < 4; ++q) { const int s = q * 32 + sr; const f32x2 mr = VMR[row0 + s]; float v[8];
        unpack8(*(const u32x4*)(Vg + (size_t)(row0 + s) * D + col0 + sc), v);
#pragma unroll
        for (int j = 0; j < 8; ++j) v[j] = (v[j] - mr.x) * mr.y * lg[j] + lb[j];
        *(u32x4*)(lds + (q >> 1) * SHM_V + v_st((q & 1) * 32 + sr, sc)) = pack8(v); }
    const bf16_t* Wm = (const bf16_t*)(ws + WS_WSM) + ((size_t)g * 128 + rb * 32 + r32) * 128;
    bf16x8 wa[2][4];
#pragma unroll
    for (int kt = 0; kt < 2; ++kt)
#pragma unroll
        for (int ks = 0; ks < 4; ++ks) wa[kt][ks] = *(const bf16x8*)(Wm + kt * 64 + ks * 16 + hi * 8);
    __syncthreads();
    const int vb0 = (int)(uintptr_t)lds + v_rd_base(lane);
    f32x16 o0 = {}, o1 = {};
    if (dh == 0) {
        { bf16x8 pa0 = wa[0][0], pa1 = wa[0][1], pa2 = wa[0][2], pa3 = wa[0][3]; PV_D0(o0, 0, 0); PV_D0(o1, 0, 1); }
        if (rb >= 2) { bf16x8 pa0 = wa[1][0], pa1 = wa[1][1], pa2 = wa[1][2], pa3 = wa[1][3]; PV_D0(o0, SHM_V, 0); PV_D0(o1, SHM_V, 1); }
    } else {
        { bf16x8 pa0 = wa[0][0], pa1 = wa[0][1], pa2 = wa[0][2], pa3 = wa[0][3]; PV_D0(o0, 0, 2); PV_D0(o1, 0, 3); }
        if (rb >= 2) { bf16x8 pa0 = wa[1][0], pa1 = wa[1][1], pa2 = wa[1][2], pa3 = wa[1][3]; PV_D0(o0, SHM_V, 2); PV_D0(o1, SHM_V, 3); }
    }
    float* stg = (float*)(lds + 2 * SHM_V) + wid * 2048;
#pragma unroll
    for (int r = 0; r < 16; ++r) { const int tr = crow(r, hi); stg[tr * 64 + r32] = o0[r]; stg[tr * 64 + 32 + r32] = o1[r]; }
    asm volatile("s_waitcnt lgkmcnt(0)" ::: "memory");
    bf16_t* Ug = (bf16_t*)(ws + WS_UG); const bf16_t* Za = (const bf16_t*)(ws + WS_ZA);
#pragma unroll
    for (int i = 0; i < 4; ++i) { const int id = lane + 64 * i, tr = id >> 3, ch = id & 7, t = rb * 32 + tr; const float bs = b_s[g * 128 + t];
        const size_t off = (size_t)(row0 + t) * D + col0 + dh * 64 + ch * 8;
        const f32x4 s0 = *(const f32x4*)(stg + tr * 64 + ch * 8), s1 = *(const f32x4*)(stg + tr * 64 + ch * 8 + 4);
        float u[8], z[8], y[8]; unpack8(*(const u32x4*)(Ug + off), u); unpack8(*(const u32x4*)(Za + off), z);
#pragma unroll
        for (int j = 0; j < 4; ++j) { y[j] = u[j] * (s0[j] + bs) * z[j]; y[4 + j] = u[4 + j] * (s1[j] + bs) * z[4 + j]; }
        if (!dry) *(u32x4*)(Ug + off) = pack8(y); }
    __syncthreads();
}
#undef SBAR
}


#define XB_TMO      128
#define XB_XCNT(j)  (256  + 64 * (j))
#define XB_XSUB(j)  (1280 + 64 * (j))
#define XB_XGEN(j)  (2304 + 64 * (j))
#define XB_TOP      3328
#define XB_TOPGEN   3392
#define XCD_BAR_WORDS 3456
#define XB_SPIN_CAP (1u << 22)
__device__ __forceinline__ unsigned xb_ld(unsigned* p)              { return __hip_atomic_load(p, __ATOMIC_RELAXED, __HIP_MEMORY_SCOPE_AGENT); }
__device__ __forceinline__ unsigned xb_add(unsigned* p, unsigned v) { return __hip_atomic_fetch_add(p, v, __ATOMIC_RELAXED, __HIP_MEMORY_SCOPE_AGENT); }
__device__ __forceinline__ unsigned xb_xcc_id() { return (unsigned)__builtin_amdgcn_s_getreg((3 << 11) | 20) & 0xFu; }
#define XB_SPIN(cond, bar) do { unsigned _sp = 0; while (cond) { __builtin_amdgcn_s_sleep(1); \
    if ((++_sp & 255u) == 0u) { if (xb_ld(&(bar)[XB_TMO])) break; if (_sp > XB_SPIN_CAP) { atomicAdd(&(bar)[XB_TMO], 1u); break; } } } } while (0)
__device__ __forceinline__ void xcd_barrier_complete(unsigned* bar, unsigned x, unsigned& nloc, unsigned& nx) {
    const unsigned G = gridDim.x;
    unsigned sum, cnt, mine, sp = 0u;
    for (;;) {
        sum = 0u; cnt = 0u; mine = 0u;
#pragma unroll
        for (unsigned j = 0; j < 16; ++j) { const unsigned c = xb_ld(&bar[XB_XCNT(j)]); sum += c; cnt += (c > 0u) ? 1u : 0u; mine = (j == x) ? c : mine; }
        if (sum == G) break;
        __builtin_amdgcn_s_sleep(1);
        if ((++sp & 255u) == 0u) { if (xb_ld(&bar[XB_TMO])) break; if (sp > XB_SPIN_CAP) { atomicAdd(&bar[XB_TMO], 1u); break; } }
    }
    nloc = mine > 0u ? mine : 1u; nx = cnt > 0u ? cnt : 1u;
}
__device__ __forceinline__ void xcd_barrier(unsigned* bar, volatile LAS unsigned* st, const int tid) {
    asm volatile("s_waitcnt vmcnt(0)" ::: "memory");
    __syncthreads();
    if (tid == 0) {
        const unsigned x = xb_xcc_id();
        __builtin_amdgcn_s_waitcnt(0);
        unsigned nloc = st[0], nx = st[1];
        if (nloc == 0u) { xcd_barrier_complete(bar, x, nloc, nx); st[0] = nloc; st[1] = nx; }
        const unsigned old = xb_add(&bar[XB_XSUB(x)], 1u);
        const unsigned gen = old / nloc;
        if (old + 1u == (gen + 1u) * nloc) {
            __builtin_amdgcn_fence(__ATOMIC_RELEASE, "agent");
            asm volatile("s_waitcnt vmcnt(0)" ::: "memory");
            const unsigned og = xb_add(&bar[XB_TOP], 1u);
            const unsigned tg = og / nx;
            if (og + 1u == (tg + 1u) * nx) xb_add(&bar[XB_TOPGEN], 1u);
            else XB_SPIN(xb_ld(&bar[XB_TOPGEN]) == tg, bar);
            __builtin_amdgcn_fence(__ATOMIC_ACQUIRE, "agent");
            xb_add(&bar[XB_XGEN(x)], 1u);
            asm volatile("s_waitcnt vmcnt(0)" ::: "memory");
        } else {
            XB_SPIN(xb_ld(&bar[XB_XGEN(x)]) == gen, bar);
            __builtin_amdgcn_fence(__ATOMIC_ACQUIRE, "agent");
            asm volatile("s_waitcnt vmcnt(0)" ::: "memory");
        }
    }
    __syncthreads();
}

typedef const __attribute__((address_space(4))) Ptrs* KargPtr;
#define PHASE_ENV() KargPtr kp_ = (KargPtr)__builtin_amdgcn_kernarg_segment_ptr(); asm volatile("" : "+s"(kp_)); \
    const int wave = wave0_; int lane = (int)__builtin_amdgcn_mbcnt_hi(~0u, __builtin_amdgcn_mbcnt_lo(~0u, 0u)); asm volatile("" : "+v"(lane)); const int tid = wave * 64 + lane; \
    int G = gridDim.x, c = blockIdx.x; asm volatile("" : "+s"(G), "+s"(c)); const int vcu = (G % 8 == 0) ? (c % 8) * (G / 8) + c / 8 : c; \
    unsigned char* ws = kp_->ws; unsigned char* dout = (unsigned char*)kp_->out; (void)lane; (void)wave; (void)vcu; (void)ws; (void)dout
__global__ void __launch_bounds__(NTHREADS, 2) hybrid_fwd(Ptrs Punused) {
    extern __shared__ __attribute__((aligned(16))) unsigned char lds_raw[];
    LAS unsigned char* lds = (LAS unsigned char*)lds_raw;
    const int wave0_ = __builtin_amdgcn_readfirstlane((int)threadIdx.x >> 6);
    int lo, hi; { KargPtr k0 = (KargPtr)__builtin_amdgcn_kernarg_segment_ptr(); lo = k0->ph_lo; hi = k0->ph_hi; }
#ifndef PH_MASK
#define PH_MASK 0x7f
#endif
#ifndef P3_MASK
#define P3_MASK 15
#endif
#ifndef REP_MASK
#define REP_MASK 0
#endif
#define IN(k) (((PH_MASK >> (k)) & 1) && lo <= (k) && (k) < hi)
#define REPS(k) (((REP_MASK >> (k)) & 1) ? 2 : 1)
#if MK_SINGLE
    volatile LAS unsigned* bst_ = (volatile LAS unsigned*)(lds + BARST_OFF);
    { if ((int)threadIdx.x == 0) { bst_[0] = 0u; bst_[1] = 0u; KargPtr k0 = (KargPtr)__builtin_amdgcn_kernarg_segment_ptr(); (void)xb_add(&((unsigned*)k0->ws)[XB_XCNT(xb_xcc_id())], 1u); } __syncthreads(); }
#define SEAM(k) do { if (IN(k) && IN((k) + 1)) { PHASE_ENV(); if (kp_->use_cg) cg::this_grid().sync(); else xcd_barrier((unsigned*)ws, bst_, tid); } } while (0)
#else
#define SEAM(k) do { } while (0)
#endif
    for (int rep_ = 0; rep_ < REPS(0); ++rep_) if (IN(0)) { PHASE_ENV(); Ptrs P; { const __attribute__((address_space(4))) unsigned long long* s_ = (const __attribute__((address_space(4))) unsigned long long*)kp_; unsigned long long* d_ = (unsigned long long*)&P; _Pragma("unroll") for (int i_ = 0; i_ < (int)(sizeof(Ptrs) / 8); ++i_) d_[i_] = s_[i_]; } phase0(P, lds, vcu, G, tid, lane, wave); }
    SEAM(0);
    for (int rep_ = 0; rep_ < REPS(1); ++rep_) if (IN(1)) { PHASE_ENV(); SchedP1 Sc{ws, G, c}; EpiP1 E{ws, dout, kp_->in[16]}; pg8::gemm_phase<2048>(lds, Sc, E, tid, ROT1 ? (c & 7) * 4 : 0); }
    SEAM(1);
    for (int rep_ = 0; rep_ < REPS(2); ++rep_) if (IN(2)) { PHASE_ENV();
        { const f32x2* st = (const f32x2*)(ws + WS_VST); f32x2* mr = (f32x2*)(ws + WS_VMR);
          for (int row = c * 32 + (tid >> 4); row < S; row += G * 32) { const int sub = tid & 15;
              const f32x2 p0 = st[(size_t)sub * S + row], p1 = st[(size_t)(sub + 16) * S + row]; float s1 = p0.x + p1.x, s2 = p0.y + p1.y;
#pragma unroll
              for (int o = 1; o < 16; o <<= 1) { s1 += __shfl_xor(s1, o); s2 += __shfl_xor(s2, o); }
              const float mean = s1 * (1.f / D); const float var = fmaxf(s2 * (1.f / D) - mean * mean, 0.f); if (sub == 0) mr[row] = (f32x2){mean, 1.0f / sqrtf(var + EPS)}; } }
        SchedP2 Sc{ws, G, c}; EpiP2 E{ws, (LAS float*)(lds + XCH_OFF)}; pg8::gemm_phase<512>(lds, Sc, E, tid);
    }
    SEAM(2);
    if (IN(3)) {
#ifndef REP3
#define REP3 0
#endif
        for (int rep_ = ((REP3 & 1) ? 0 : 1); rep_ < 2; ++rep_) if (P3_MASK & 1) { PHASE_ENV(); if (vcu < 256) { const int h = vcu >> 4, x = vcu & 15;
            const bf16_t* Qh = (const bf16_t*)(ws + WS_QB) + (size_t)h * S * DQK; const bf16_t* Kh = (const bf16_t*)(ws + WS_KB) + (size_t)h * S * DQK; const bf16_t* Vh = (const bf16_t*)(ws + WS_VB) + (size_t)h * S * DV;
            bf16_t* ZY = (bf16_t*)dout + h * DV;
            att::ATTN_FN(Qh, Kh, Vh, ZY, (31 - x) * 256, (char*)lds_raw, tid, rep_ == 0); att::ATTN_FN(Qh, Kh, Vh, ZY, x * 256, (char*)lds_raw, tid, rep_ == 0); } }
        for (int rep_ = ((REP3 & 2) ? 0 : 1); rep_ < 2; ++rep_) if (P3_MASK & 2) { PHASE_ENV(); SchedP3b Sc{ws, G, c}; EpiMulZ E{dout, rep_ == 0}; pg8::gemm_phase<256>(lds, Sc, E, tid); }
        for (int rep_ = ((REP3 & 4) ? 0 : 1); rep_ < 2; ++rep_) if (P3_MASK & 4) { PHASE_ENV(); const float* lng = kp_->in[5]; const float* lnb = kp_->in[6]; const float* bs = kp_->in[8];
            for (int it = vcu; it < 1024; it += G) att::mixer_block(ws, lng, lnb, bs, it >> 4, it & 15, (char*)lds_raw, tid, rep_ == 0); }
        for (int rep_ = ((REP3 & 8) ? 0 : 1); rep_ < 2; ++rep_) if (P3_MASK & 8) { PHASE_ENV(); Ptrs P; { const __attribute__((address_space(4))) unsigned long long* s_ = (const __attribute__((address_space(4))) unsigned long long*)kp_; unsigned long long* d_ = (unsigned long long*)&P; _Pragma("unroll") for (int i_ = 0; i_ < (int)(sizeof(Ptrs) / 8); ++i_) d_[i_] = s_[i_]; } phase_wconv2(P, lds, vcu, G, lane, wave); }
    }
    SEAM(3);
    for (int rep_ = 0; rep_ < REPS(4); ++rep_) if (IN(4)) { PHASE_ENV(); SchedP4 Sc{ws, dout, G, c}; EpiP4 E{ws}; pg8::gemm_phase<2048>(lds, Sc, E, tid, ROT45 ? (c & 7) * 4 : 0); }
    SEAM(4);
    for (int rep_ = 0; rep_ < REPS(5); ++rep_) if (IN(5)) { PHASE_ENV(); SchedP5 Sc{ws, G, c}; EpiP5 E{ws, (float*)dout}; pg8::gemm_phase<2048>(lds, Sc, E, tid, ROT45 ? (c & 7) * 4 : 0); }
    SEAM(5);
    if (IN(6)) { PHASE_ENV();
        const float* st = (const float*)(ws + WS_OST); const float* x = kp_->in[0]; const float* gp = kp_->in[19]; float* outp = (float*)dout;
        for (int row = vcu * NWAVES + wave; row < S; row += G * NWAVES) {
            float s = lane < 32 ? st[(size_t)lane * S + row] : 0.f; s = wave_sum(s);
            const float rs = 1.0f / sqrtf(s * (1.f / D) + EPS);
            const f32x4* xr = (const f32x4*)(x + (size_t)row * D); f32x4* orow = (f32x4*)(outp + (size_t)row * D); const f32x4* gr = (const f32x4*)gp; const u32x4* ob = (const u32x4*)((const bf16_t*)(ws + WS_MP) + (size_t)row * D);
#pragma unroll
            for (int j = 0; j < 4; ++j) { const int q = 64 * j + lane; float a[8]; unpack8(ob[q], a); const f32x4 x0 = xr[2 * q], x1 = xr[2 * q + 1], g0 = gr[2 * q], g1 = gr[2 * q + 1];
                orow[2 * q] = x0 + (f32x4){a[0], a[1], a[2], a[3]} * rs * g0; orow[2 * q + 1] = x1 + (f32x4){a[4], a[5], a[6], a[7]} * rs * g1; }
        }
    }
#undef IN
#undef SEAM
}

extern "C" void kernel_launch(void* const* d_in, const int* in_sizes, int n_in, void* d_out, int out_size, void* d_ws, size_t ws_size, hipStream_t stream) {
    static int grid = 0;
    if (grid == 0) {
        if (n_in != 20 || out_size != S * D || ws_size < WS_END) { fprintf(stderr, "kernel_launch: unexpected shapes (n_in %d out %d ws %zu)\n", n_in, out_size, ws_size); grid = -1; return; }
        int dev = 0, cus = 0, per_cu = 0;
        (void)hipGetDevice(&dev); (void)hipDeviceGetAttribute(&cus, hipDeviceAttributeMultiprocessorCount, dev);
        (void)hipFuncSetAttribute((const void*)hybrid_fwd, hipFuncAttributeMaxDynamicSharedMemorySize, LDS_BYTES);
        (void)hipOccupancyMaxActiveBlocksPerMultiprocessor(&per_cu, (const void*)hybrid_fwd, NTHREADS, LDS_BYTES);
        if (per_cu < 1) { fprintf(stderr, "kernel_launch: occupancy query reports %d blocks per CU\n", per_cu); }
        grid = cus;
        (void)hipGetLastError();
    }
    if (grid < 0) return;
    Ptrs p{};
    for (int i = 0; i < 20; ++i) p.in[i] = (const float*)d_in[i];
    p.out = (float*)d_out; p.ws = (unsigned char*)d_ws;
#if MK_SINGLE
    (void)hipMemsetAsync(d_ws, 0, CTL_ZERO_BYTES, stream);
    p.ph_lo = 0; p.ph_hi = 7;
    void* args[] = {&p};
    hipError_t e = hipLaunchCooperativeKernel((const void*)hybrid_fwd, dim3(grid), dim3(NTHREADS), args, LDS_BYTES, stream);
    if (e != hipSuccess) fprintf(stderr, "cooperative launch failed: %s (grid %d)\n", hipGetErrorString(e), grid);
#else
    for (int k = 0; k < 7; ++k) { p.ph_lo = k; p.ph_hi = k + 1; hipLaunchKernelGGL(hybrid_fwd, dim3(grid), dim3(NTHREADS), LDS_BYTES, stream, p); }
#endif
}
```

```cpp
#include <hip/hip_runtime.h>
#include <hip/hip_cooperative_groups.h>
#include <cstdio>
#include <cstdint>
namespace cg = cooperative_groups;

#ifndef MK_SINGLE
#define MK_SINGLE 1
#endif

#define LAS __attribute__((address_space(3)))
typedef unsigned short bf16_t;
typedef short bf16x8 __attribute__((ext_vector_type(8)));
typedef short s16x4 __attribute__((ext_vector_type(4)));
typedef float f32x4 __attribute__((ext_vector_type(4)));
typedef float f32x2 __attribute__((ext_vector_type(2)));
typedef float f32x16 __attribute__((ext_vector_type(16)));
typedef unsigned u32x4 __attribute__((ext_vector_type(4)));
typedef unsigned u32x2 __attribute__((ext_vector_type(2)));

constexpr int S = 8192, D = 2048, ML = 256, NH = 16, DQK = 192, DV = 128;
constexpr int IN_TOTAL = 13376, NT_IN = 77;
constexpr float EPS = 1e-6f, LOG2E = 1.4426950408889634f;
constexpr float QSCALE = 0.07216878364870322f * 1.4426950408889634f;
constexpr float MSCALE = 0.04419417382415922f * 1.4426950408889634f;
constexpr int NTHREADS = 512, NWAVES = 8;
constexpr int RING_BYTES = 131072, XCH_OFF = RING_BYTES, BARST_OFF = XCH_OFF + 8192, LDS_BYTES = 147456;
constexpr size_t CTL_ZERO_BYTES = 16384;

constexpr size_t MiB = 1u << 20;
constexpr size_t WS_CS = 1 * MiB;
constexpr size_t WS_VST = 3 * MiB;
constexpr size_t WS_CQST = 5 * MiB;
constexpr size_t WS_CKVST = 5 * MiB + 256 * 1024;
constexpr size_t WS_VMR = 5 * MiB + 512 * 1024;
constexpr size_t WS_OST = 6 * MiB;
constexpr size_t WS_WSM = 7 * MiB;
constexpr size_t WS_KR = 8 * MiB;
constexpr size_t WS_KMH = 9 * MiB;
constexpr size_t WS_VMT = 10 * MiB;
constexpr size_t WS_WUQ = 11 * MiB;
constexpr size_t WS_WUKV = 14 * MiB;
constexpr size_t WS_WIN = 18 * MiB;
constexpr size_t WS_WMEM = 95 * MiB;
constexpr size_t WS_H = 111 * MiB;
constexpr size_t WS_MEMN = 143 * MiB;
constexpr size_t WS_UG = 144 * MiB;
constexpr size_t WS_VG = 176 * MiB;
constexpr size_t WS_ZA = 208 * MiB;
constexpr size_t WS_CQ = 240 * MiB;
constexpr size_t WS_CKV = 248 * MiB;
constexpr size_t WS_QMH = 256 * MiB;
constexpr size_t WS_G = 288 * MiB;
constexpr size_t WS_VB = 384 * MiB;
constexpr size_t WS_QB = 18 * MiB;
constexpr size_t WS_KB = 66 * MiB;
constexpr size_t WS_P = 114 * MiB;
constexpr size_t WS_WBR = 240 * MiB;
constexpr size_t WS_WOUT = 264 * MiB;
constexpr size_t WS_MP = 18 * MiB;
constexpr size_t WS_MERGED = 82 * MiB;
constexpr size_t WS_END = 416 * MiB;

typedef __bf16 bf16x2_t __attribute__((ext_vector_type(2)));
__device__ __forceinline__ unsigned cvt_pk_bf16(float lo, float hi) { const f32x2 v = {lo, hi}; const bf16x2_t b = __builtin_convertvector(v, bf16x2_t); return __builtin_bit_cast(unsigned, b); }
__device__ __forceinline__ float bf_lo(unsigned w) { return __uint_as_float(w << 16); }
__device__ __forceinline__ float bf_hi(unsigned w) { return __uint_as_float(w & 0xffff0000u); }
__device__ __forceinline__ u32x4 pack8(const float* v) { u32x4 w; w.x = cvt_pk_bf16(v[0], v[1]); w.y = cvt_pk_bf16(v[2], v[3]); w.z = cvt_pk_bf16(v[4], v[5]); w.w = cvt_pk_bf16(v[6], v[7]); return w; }
__device__ __forceinline__ void unpack8(u32x4 w, float* v) { v[0] = bf_lo(w.x); v[1] = bf_hi(w.x); v[2] = bf_lo(w.y); v[3] = bf_hi(w.y); v[4] = bf_lo(w.z); v[5] = bf_hi(w.z); v[6] = bf_lo(w.w); v[7] = bf_hi(w.w); }
__device__ __forceinline__ float fast_rcp(float x) { return __builtin_amdgcn_rcpf(x); }
__device__ __forceinline__ float fast_exp2(float x) { return __builtin_amdgcn_exp2f(x); }
__device__ __forceinline__ float act_gelu(float x) { const float u = x * (1.f + 0.044715f * x * x); return x * fast_rcp(1.f + fast_exp2(-2.3022081983f * u)); }
__device__ __forceinline__ float act_silu(float x) { return x * fast_rcp(1.f + fast_exp2(-LOG2E * x)); }
__device__ __forceinline__ float act_sigmoid(float x) { return fast_rcp(1.f + fast_exp2(-LOG2E * x)); }
__device__ __forceinline__ float act_gate_e(float x) { return fminf(1.f + fast_exp2(-LOG2E * x), 1.0995116e12f); }
__device__ __forceinline__ float wave_sum(float v) {
#pragma unroll
    for (int o = 1; o < 64; o <<= 1) v += __shfl_xor(v, o);
    return v;
}

namespace pg8 {
constexpr int BM = 256, BK = 64, HALF = 128, HTB = HALF * BK * 2, STAGE_BYTES = 8 * HTB;
__host__ __device__ __forceinline__ int lds_byte(int r, int c) { const int st = (r >> 4) * 2 + (c >> 5), rr = r & 15, cc = c & 31, ob = rr * 64 + cc * 2; return st * 1024 + (ob ^ (((ob >> 9) & 1) << 5)); }
__host__ __device__ __forceinline__ void stage_rc(int b, int& R, int& C) { const int st = b / 1024, sb = b % 1024, swz = sb ^ (((sb >> 9) & 1) << 5); R = (st >> 1) * 16 + swz / 64; C = (st & 1) * 32 + (swz % 64) / 2; }
__host__ __device__ __forceinline__ int perm32(int rho) { const int n = rho >> 4, i = rho & 15; return 8 * (i >> 2) + 4 * n + (i & 3); }

struct Unit { const char* A; const char* B; int pm, pn, mode; };

template <int K, class Sched, class Epi>
__device__ __forceinline__ void gemm_phase(LAS unsigned char* lds, const Sched& S, const Epi& E, const int tid) {
    const int wid = __builtin_amdgcn_readfirstlane(tid >> 6), lane = tid & 63, wr = wid >> 2, wc = wid & 3, fr = lane & 15, fq = lane >> 4;
    constexpr int nt = K / BK;
    unsigned voffA[2], voffB[2];
#pragma unroll
    for (int i = 0; i < 2; ++i) { int R, C; stage_rc(tid * 16 + i * 8192, R, C); const int Rb = (R & ~31) + perm32(R & 31);
        voffA[i] = (unsigned)(R * K + C) * 2u; voffB[i] = (unsigned)(Rb * K + C) * 2u; }
    constexpr size_t kstep = (size_t)(BK * 2);
    constexpr size_t hstep = (size_t)HALF * K * 2;
    const unsigned ldsw = (unsigned)wid * 1024u;
    const int aoff = lds_byte(wr * 64 + fr, fq * 8), boff = lds_byte(wc * 32 + fr, fq * 8);
#define PG8_SA(b, h) (((b) * 2 + (h)) * HTB)
#define PG8_SB(b, h) ((4 + (b) * 2 + (h)) * HTB)
#define PG8_STAGE(bufoff, gbase, voff) do { _Pragma("unroll") for (int _i = 0; _i < 2; ++_i) \
        __builtin_amdgcn_global_load_lds((const unsigned*)((const char*)(gbase) + (voff)[_i]), (LAS unsigned*)(lds + (bufoff) + ldsw + _i * 8192), 16, 0, 0); } while (0)
#define PG8_LDA(dst, b, h) do { _Pragma("unroll") for (int m = 0; m < 4; ++m) _Pragma("unroll") for (int k = 0; k < 2; ++k) dst[m][k] = *(const LAS bf16x8*)(lds + PG8_SA(b, h) + aoff + m * 2048 + k * 1024); } while (0)
#define PG8_LDB(dst, b, h) do { _Pragma("unroll") for (int n = 0; n < 2; ++n) _Pragma("unroll") for (int k = 0; k < 2; ++k) dst[n][k] = *(const LAS bf16x8*)(lds + PG8_SB(b, h) + boff + n * 2048 + k * 1024); } while (0)
#define PG8_MMA(ai, bj, At, Bt) do { __builtin_amdgcn_s_setprio(1); _Pragma("unroll") for (int m = 0; m < 4; ++m) _Pragma("unroll") for (int n = 0; n < 2; ++n) _Pragma("unroll") for (int k = 0; k < 2; ++k) \
        acc[ai][bj][m][n] = __builtin_amdgcn_mfma_f32_16x16x32_bf16(Bt[n][k], At[m][k], acc[ai][bj][m][n], 0, 0, 0); __builtin_amdgcn_s_setprio(0); } while (0)
#define PG8_WAIT_V(n) asm volatile("s_waitcnt vmcnt(" #n ")" ::: "memory")
#define PG8_WAIT_L(n) asm volatile("s_waitcnt lgkmcnt(" #n ")" ::: "memory")
#define PG8_BAR __builtin_amdgcn_s_barrier()
#define PG8_SCHED __builtin_amdgcn_sched_barrier(0)
    Unit cur, nxt; int ui = 0;
    if (!S.next(0, cur)) return;
    f32x4 acc[2][2][4][2];
#pragma unroll
    for (int a = 0; a < 2; ++a)
#pragma unroll
        for (int b = 0; b < 2; ++b)
#pragma unroll
            for (int m = 0; m < 4; ++m)
#pragma unroll
                for (int n = 0; n < 2; ++n) acc[a][b][m][n] = (f32x4){0.f, 0.f, 0.f, 0.f};
    bf16x8 At[4][2], B0[2][2], B1[2][2];
    const char* cA = cur.A; const char* cB = cur.B;
#define PG8_KT(t) ((size_t)((t) & (nt - 1)) * kstep)
    PG8_STAGE(PG8_SB(0, 0), cB + PG8_KT(0), voffB); PG8_STAGE(PG8_SB(0, 1), cB + hstep + PG8_KT(0), voffB); PG8_STAGE(PG8_SA(0, 0), cA + PG8_KT(0), voffA); PG8_STAGE(PG8_SA(0, 1), cA + hstep + PG8_KT(0), voffA);
    if (wr == 1) PG8_BAR;
    PG8_WAIT_V(2); PG8_BAR;
    PG8_STAGE(PG8_SB(1, 0), cB + PG8_KT(1), voffB); PG8_STAGE(PG8_SA(1, 0), cA + PG8_KT(1), voffA); PG8_STAGE(PG8_SB(1, 1), cB + hstep + PG8_KT(1), voffB);
    PG8_WAIT_V(6); PG8_BAR;
    for (;;) {
        const bool has_next = S.next(ui + 1, nxt);
        const char* nA = has_next ? nxt.A : cA; const char* nB = has_next ? nxt.B : cB;
        for (int t = 0; t < nt; t += 2) {
            const bool last = (t == nt - 2);
            const char* a1 = cA + PG8_KT(t + 1);
            const char* a2 = (last ? nA : cA) + PG8_KT(t + 2); const char* b2 = (last ? nB : cB) + PG8_KT(t + 2);
            const char* a3 = (last ? nA : cA) + PG8_KT(t + 3); const char* b3 = (last ? nB : cB) + PG8_KT(t + 3);
            PG8_LDB(B0, 0, 0); PG8_LDB(B1, 0, 1); PG8_SCHED; PG8_LDA(At, 0, 0); PG8_STAGE(PG8_SA(1, 1), a1 + hstep, voffA);
            PG8_WAIT_V(8); PG8_WAIT_L(0); PG8_BAR; PG8_MMA(0, 0, At, B0); PG8_MMA(0, 1, At, B1); PG8_BAR; PG8_SCHED;
            PG8_LDA(At, 0, 1); PG8_STAGE(PG8_SB(0, 0), b2, voffB); PG8_STAGE(PG8_SB(0, 1), b2 + hstep, voffB); PG8_STAGE(PG8_SA(0, 0), a2, voffA);
            PG8_WAIT_V(8); PG8_WAIT_L(0); PG8_BAR; PG8_MMA(1, 0, At, B0); PG8_MMA(1, 1, At, B1); PG8_BAR; PG8_SCHED;
            PG8_LDB(B0, 1, 0); PG8_LDB(B1, 1, 1); PG8_SCHED; PG8_LDA(At, 1, 0); PG8_STAGE(PG8_SA(0, 1), a2 + hstep, voffA);
            PG8_WAIT_V(8); PG8_WAIT_L(0); PG8_BAR; PG8_MMA(0, 0, At, B0); PG8_MMA(0, 1, At, B1); PG8_BAR; PG8_SCHED;
            PG8_LDA(At, 1, 1); PG8_STAGE(PG8_SB(1, 0), b3, voffB); PG8_STAGE(PG8_SB(1, 1), b3 + hstep, voffB); PG8_STAGE(PG8_SA(1, 0), a3, voffA);
            PG8_WAIT_V(8); PG8_WAIT_L(0); PG8_BAR; PG8_MMA(1, 0, At, B0); PG8_MMA(1, 1, At, B1); PG8_BAR; PG8_SCHED;
        }
        if (wr == 0) PG8_BAR;
        E(acc, cur, wr, wc, fr, fq);
        if (!has_next) break;
        if (!E.keep_acc(cur)) {
#pragma unroll
        for (int a = 0; a < 2; ++a)
#pragma unroll
            for (int b = 0; b < 2; ++b)
#pragma unroll
                for (int m = 0; m < 4; ++m)
#pragma unroll
                    for (int n = 0; n < 2; ++n) acc[a][b][m][n] = (f32x4){0.f, 0.f, 0.f, 0.f};
        }
        cur = nxt; cA = nA; cB = nB; ++ui;
        if (wr == 1) PG8_BAR;
    }
    PG8_WAIT_V(0);
    PG8_BAR;
#undef PG8_KT
#undef PG8_SA
#undef PG8_SB
#undef PG8_STAGE
#undef PG8_LDA
#undef PG8_LDB
#undef PG8_MMA
#undef PG8_WAIT_V
#undef PG8_WAIT_L
#undef PG8_BAR
#undef PG8_SCHED
}
}
using pg8::Unit;

#define EPI_LOOP_BEGIN \
    _Pragma("unroll") for (int ai = 0; ai < 2; ++ai) _Pragma("unroll") for (int m = 0; m < 4; ++m) { const int rt = ai * 128 + wr * 64 + m * 16 + fr; \
    _Pragma("unroll") for (int bj = 0; bj < 2; ++bj) { const int ct = bj * 128 + wc * 32 + 8 * fq; \
        float v[8] = {acc[ai][bj][m][0][0], acc[ai][bj][m][0][1], acc[ai][bj][m][0][2], acc[ai][bj][m][0][3], acc[ai][bj][m][1][0], acc[ai][bj][m][1][1], acc[ai][bj][m][1][2], acc[ai][bj][m][1][3]};
#define EPI_LOOP_END } }

enum { M_GELU = 0, M_GELU_STAT, M_SILU, M_RAW_SS, M_KROPE, M_QM, M_GATE, M_MEMK, M_MEMV,
       M_QUP, M_KVUP, M_MEMS,
       M_MULZ, M_BR0, M_BR1, M_BR2, M_OUT };

struct Ptrs {
    const float* in[20]; float* out; unsigned char* ws; int ph_lo, ph_hi; int use_cg, pad;
};

struct EpiP1 {
    __device__ __forceinline__ bool keep_acc(const Unit&) const { return false; }
    unsigned char* ws; unsigned char* dout; const float* bgate;
    __device__ __forceinline__ void operator()(f32x4 (&acc)[2][2][4][2], const Unit& u, int wr, int wc, int fr, int fq) const {
        const int mode = u.mode, pn = u.pn, row0 = u.pm * 256;
        if (mode == M_KROPE) {
            if (wc < 2) {
                const f32x2* CS = (const f32x2*)(ws + WS_CS); bf16_t* KR = (bf16_t*)(ws + WS_KR);
#pragma unroll
                for (int ai = 0; ai < 2; ++ai)
#pragma unroll
                    for (int m = 0; m < 4; ++m) { const int row = row0 + ai * 128 + wr * 64 + m * 16 + fr; const int i0 = (wc * 32 + 8 * fq) >> 1;
                        const f32x4 a = acc[ai][0][m][0], b = acc[ai][0][m][1]; const float t1[4] = {a[0], a[2], b[0], b[2]}, t2[4] = {a[1], a[3], b[1], b[3]};
                        float o1[4], o2[4];
#pragma unroll
                        for (int j = 0; j < 4; ++j) { const f32x2 cs = CS[row * 32 + i0 + j]; o1[j] = t1[j] * cs.x - t2[j] * cs.y; o2[j] = t2[j] * cs.x + t1[j] * cs.y; }
                        u32x2 w1, w2; w1.x = cvt_pk_bf16(o1[0], o1[1]); w1.y = cvt_pk_bf16(o1[2], o1[3]); w2.x = cvt_pk_bf16(o2[0], o2[1]); w2.y = cvt_pk_bf16(o2[2], o2[3]);
                        *(u32x2*)(KR + (size_t)row * 64 + i0) = w1; *(u32x2*)(KR + (size_t)row * 64 + 32 + i0) = w2; }
            }
            return;
        }
        bf16_t* dst; int ldc, cbase = 0; int act = 0;
        float scale = 1.f; int stat = 0; float* stp = nullptr; const float* bias = nullptr;
        if (mode == M_GELU)           { dst = (bf16_t*)(ws + WS_UG); ldc = D; cbase = pn * 256; act = 0; }
        else if (mode == M_GELU_STAT) { dst = (bf16_t*)(ws + WS_VG); ldc = D; cbase = (pn - 8) * 256; act = 1; stat = 2; stp = (float*)(ws + WS_VST) + (size_t)((pn - 8) * 4 + wc) * S * 2; }
        else if (mode == M_SILU)      { act = 0; ldc = D;     if (pn < 24) { dst = (bf16_t*)(ws + WS_ZA); cbase = (pn - 16) * 256; } else if (pn < 37) { dst = (bf16_t*)dout; cbase = (pn - 29) * 256; } else { dst = (bf16_t*)dout + (size_t)S * D; cbase = (pn - 45) * 256; } }
        else if (mode == M_RAW_SS)    { ldc = 512; stat = 1; if (pn < 26) { dst = (bf16_t*)(ws + WS_CQ); cbase = (pn - 24) * 256; stp = (float*)(ws + WS_CQST) + (size_t)((pn - 24) * 4 + wc) * S; }
                                        else { dst = (bf16_t*)(ws + WS_CKV); cbase = (pn - 26) * 256; stp = (float*)(ws + WS_CKVST) + (size_t)((pn - 26) * 4 + wc) * S; } }
        else if (mode == M_QM)        { const int t = pn - 37; dst = (bf16_t*)(ws + WS_QMH) + (size_t)(t >> 1) * S * 512; ldc = 512; cbase = (t & 1) * 256; scale = MSCALE; }
        else if (mode == M_GATE)      { dst = (bf16_t*)(ws + WS_G); ldc = 3 * D; cbase = (pn - 53) * 256; act = 3; bias = bgate + cbase; }
        else if (mode == M_MEMK)      { dst = (bf16_t*)(ws + WS_KMH) + (size_t)(pn >> 1) * ML * 512; ldc = 512; cbase = (pn & 1) * 256; }
        else                          { dst = (bf16_t*)(ws + WS_VMT); ldc = ML; cbase = 0; }
#pragma unroll
        for (int ai = 0; ai < 2; ++ai)
#pragma unroll
            for (int m = 0; m < 4; ++m) { const int rt = ai * 128 + wr * 64 + m * 16 + fr; float s1 = 0.f, s2 = 0.f;
#pragma unroll
                for (int bj = 0; bj < 2; ++bj) { const int ct = bj * 128 + wc * 32 + 8 * fq;
                    float v[8] = {acc[ai][bj][m][0][0], acc[ai][bj][m][0][1], acc[ai][bj][m][0][2], acc[ai][bj][m][0][3], acc[ai][bj][m][1][0], acc[ai][bj][m][1][1], acc[ai][bj][m][1][2], acc[ai][bj][m][1][3]};
                    if (act == 1) {
#pragma unroll
                        for (int j = 0; j < 8; ++j) v[j] = act_gelu(v[j]);
                    } else if (act == 2) {
#pragma unroll
                        for (int j = 0; j < 8; ++j) v[j] = act_silu(v[j]);
                    } else if (act == 3) { const f32x4 b0 = *(const f32x4*)(bias + ct), b1 = *(const f32x4*)(bias + ct + 4);
#pragma unroll
                        for (int j = 0; j < 4; ++j) { v[j] = act_gate_e(v[j] + b0[j]); v[4 + j] = act_gate_e(v[4 + j] + b1[j]); }
                    } else {
#pragma unroll
                        for (int j = 0; j < 8; ++j) v[j] *= scale;
                    }
                    if (stat) {
#pragma unroll
                        for (int j = 0; j < 8; ++j) { s1 += v[j]; s2 += v[j] * v[j]; }
                    }
                    *(u32x4*)(dst + (size_t)(row0 + rt) * ldc + cbase + ct) = pack8(v);
                }
                if (stat) { s1 += __shfl_xor(s1, 16); s1 += __shfl_xor(s1, 32); s2 += __shfl_xor(s2, 16); s2 += __shfl_xor(s2, 32);
                    if (fq == 0) { if (stat == 2) *(f32x2*)(stp + (size_t)(row0 + rt) * 2) = (f32x2){s1, s2}; else stp[row0 + rt] = s2; } }
            }
    }
};

struct SchedP1 {
    const unsigned char* ws; int G, c;
    __device__ __forceinline__ bool next(int i, Unit& u) const {
        const int L = i * G + c; constexpr int NMAIN = 32 * NT_IN;
        if (L >= NMAIN + 16) return false;
        if (L < NMAIN) { const int wg = (L % 8) * (NMAIN / 8) + L / 8; constexpr int nig = 8 * NT_IN; const int gid = wg / nig, w = wg % nig; const int pm = gid * 8 + (w % 8), pn = w / 8;
            u.pm = pm; u.pn = pn; u.A = (const char*)(ws + WS_H) + (size_t)pm * 256 * D * 2; u.B = (const char*)(ws + WS_WIN) + (size_t)pn * 256 * D * 2;
            u.mode = pn < 8 ? M_GELU : pn < 16 ? M_GELU_STAT : pn < 24 ? M_SILU : pn < 28 ? M_RAW_SS : pn == 28 ? M_KROPE : pn < 37 ? M_SILU : pn < 45 ? M_QM : pn < 53 ? M_SILU : M_GATE; }
        else if (L < NMAIN + 8) { const int pn = L - NMAIN; u.pm = 0; u.pn = pn; u.A = (const char*)(ws + WS_MEMN); u.B = (const char*)(ws + WS_WMEM) + (size_t)pn * 256 * D * 2; u.mode = M_MEMK; }
        else { const int pm = L - NMAIN - 8; u.pm = pm; u.pn = 0; u.A = (const char*)(ws + WS_WMEM) + (size_t)(2048 + pm * 256) * D * 2; u.B = (const char*)(ws + WS_MEMN); u.mode = M_MEMV; }
        return true;
    }
};

struct EpiP2 {
    __device__ __forceinline__ bool keep_acc(const Unit&) const { return false; }
    unsigned char* ws; LAS float* xch;
    __device__ __forceinline__ void operator()(f32x4 (&acc)[2][2][4][2], const Unit& u, int wr, int wc, int fr, int fq) const {
        const int mode = u.mode, row0 = u.pm * 256;
        if (mode == M_MEMS) {
            LAS float* XM = xch; LAS float* XS = xch + 1024;
#pragma unroll
            for (int ai = 0; ai < 2; ++ai)
#pragma unroll
                for (int m = 0; m < 4; ++m) { float t = -1e30f;
#pragma unroll
                    for (int bj = 0; bj < 2; ++bj)
#pragma unroll
                        for (int n = 0; n < 2; ++n) { const f32x4 x = acc[ai][bj][m][n]; t = fmaxf(t, fmaxf(fmaxf(x[0], x[1]), fmaxf(x[2], x[3]))); }
                    t = fmaxf(t, __shfl_xor(t, 16)); t = fmaxf(t, __shfl_xor(t, 32));
                    if (fq == 0) XM[(ai * 128 + wr * 64 + m * 16 + fr) * 4 + wc] = t; }
            asm volatile("s_waitcnt lgkmcnt(0)" ::: "memory"); __builtin_amdgcn_s_barrier(); asm volatile("" ::: "memory");
#pragma unroll
            for (int ai = 0; ai < 2; ++ai)
#pragma unroll
                for (int m = 0; m < 4; ++m) { const int rt = ai * 128 + wr * 64 + m * 16 + fr; const f32x4 q = *(const LAS f32x4*)(XM + rt * 4);
                    const float mxr = fmaxf(fmaxf(q[0], q[1]), fmaxf(q[2], q[3])); float s = 0.f;
#pragma unroll
                    for (int bj = 0; bj < 2; ++bj)
#pragma unroll
                        for (int n = 0; n < 2; ++n)
#pragma unroll
                            for (int e = 0; e < 4; ++e) { const float x = fast_exp2(acc[ai][bj][m][n][e] - mxr); acc[ai][bj][m][n][e] = x; s += x; }
                    s += __shfl_xor(s, 16); s += __shfl_xor(s, 32);
                    if (fq == 0) XS[rt * 4 + wc] = s; }
            asm volatile("s_waitcnt lgkmcnt(0)" ::: "memory"); __builtin_amdgcn_s_barrier(); asm volatile("" ::: "memory");
            bf16_t* P = (bf16_t*)(ws + WS_P) + (size_t)u.pn * S * 256;
#pragma unroll
            for (int ai = 0; ai < 2; ++ai)
#pragma unroll
                for (int m = 0; m < 4; ++m) { const int rt = ai * 128 + wr * 64 + m * 16 + fr; const f32x4 q = *(const LAS f32x4*)(XS + rt * 4);
                    const float iv = fast_rcp((q[0] + q[1]) + (q[2] + q[3]));
#pragma unroll
                    for (int bj = 0; bj < 2; ++bj) { float v[8];
#pragma unroll
                        for (int j = 0; j < 8; ++j) v[j] = acc[ai][bj][m][j >> 2][j & 3] * iv;
                        *(u32x4*)(P + (size_t)(row0 + rt) * 256 + bj * 128 + wc * 32 + 8 * fq) = pack8(v); } }
            return;
        }
        const float* stp = (const float*)(ws + (mode == M_QUP ? WS_CQST : WS_CKVST));
        const f32x2* CS = (const f32x2*)(ws + WS_CS);
        LAS float* RS = xch + 2048 + 64;
        { const int t_ = ((wr * 4 + wc) * 4 + fq) * 16 + fr;
          if (t_ < 256) { float ss = 0.f;
#pragma unroll
              for (int j = 0; j < 8; ++j) ss += stp[(size_t)j * S + row0 + t_];
              RS[t_] = 1.0f / sqrtf(ss * (1.f / 512.f) + EPS); }
          asm volatile("s_waitcnt lgkmcnt(0)" ::: "memory"); __builtin_amdgcn_s_barrier(); asm volatile("" ::: "memory"); }
#pragma unroll
        for (int ai = 0; ai < 2; ++ai)
#pragma unroll
            for (int m = 0; m < 4; ++m) { const int row = row0 + ai * 128 + wr * 64 + m * 16 + fr;
                const float rs = RS[ai * 128 + wr * 64 + m * 16 + fr];
#pragma unroll
                for (int bj = 0; bj < 2; ++bj) { const int ct = bj * 128 + wc * 32 + 8 * fq;
                    float v[8] = {acc[ai][bj][m][0][0], acc[ai][bj][m][0][1], acc[ai][bj][m][0][2], acc[ai][bj][m][0][3], acc[ai][bj][m][1][0], acc[ai][bj][m][1][1], acc[ai][bj][m][1][2], acc[ai][bj][m][1][3]};
#pragma unroll
                    for (int j = 0; j < 8; ++j) v[j] *= rs;
                    if (mode == M_QUP) { const int cg = u.pn * 256 + ct, head = cg / DQK, w = cg - head * DQK;
                        bf16_t* q = (bf16_t*)(ws + WS_QB) + ((size_t)head * S + row) * DQK;
                        if (w < 128) *(u32x4*)(q + w) = pack8(v);
                        else { const int i0 = (w - 128) >> 1; float o1[4], o2[4];
#pragma unroll
                            for (int j = 0; j < 4; ++j) { const f32x2 cs = CS[row * 32 + i0 + j]; const float t1 = v[2 * j], t2 = v[2 * j + 1]; o1[j] = t1 * cs.x - t2 * cs.y; o2[j] = t2 * cs.x + t1 * cs.y; }
                            u32x2 w1, w2; w1.x = cvt_pk_bf16(o1[0], o1[1]); w1.y = cvt_pk_bf16(o1[2], o1[3]); w2.x = cvt_pk_bf16(o2[0], o2[1]); w2.y = cvt_pk_bf16(o2[2], o2[3]);
                            *(u32x2*)(q + 128 + i0) = w1; *(u32x2*)(q + 160 + i0) = w2; } }
                    else { const int head = u.pn;
                        if (bj == 0) *(u32x4*)((bf16_t*)(ws + WS_KB) + ((size_t)head * S + row) * DQK + wc * 32 + 8 * fq) = pack8(v);
                        else *(u32x4*)((bf16_t*)(ws + WS_VB) + ((size_t)head * S + row) * DV + wc * 32 + 8 * fq) = pack8(v); }
                }
                if (mode == M_KVUP && wc < 2) {
                    const u32x4 kr = *(const u32x4*)((const bf16_t*)(ws + WS_KR) + (size_t)row * 64 + (wc * 4 + fq) * 8);
                    *(u32x4*)((bf16_t*)(ws + WS_KB) + ((size_t)u.pn * S + row) * DQK + 128 + (wc * 4 + fq) * 8) = kr; }
            }
    }
};
struct SchedP2 {
    const unsigned char* ws; int G, c;
    __device__ __forceinline__ bool next(int i, Unit& u) const {
        if (i >= 4 || c >= 256) return false;
        const int x = c & 7, l = i * 32 + (c >> 3);
        if (l < 48) { const int pm = 4 * x + (l & 3), pn = l >> 2; u.pm = pm; u.pn = pn; u.mode = M_QUP; u.A = (const char*)(ws + WS_CQ) + (size_t)pm * 256 * 512 * 2; u.B = (const char*)(ws + WS_WUQ) + (size_t)pn * 256 * 512 * 2; }
        else if (l < 112) { const int l2 = l - 48, pm = 4 * x + (l2 & 3), pn = l2 >> 2; u.pm = pm; u.pn = pn; u.mode = M_KVUP; u.A = (const char*)(ws + WS_CKV) + (size_t)pm * 256 * 512 * 2; u.B = (const char*)(ws + WS_WUKV) + (size_t)pn * 256 * 512 * 2; }
        else { const int l2 = l - 112, pm = 4 * x + (l2 & 3), h = l2 >> 2; u.pm = pm; u.pn = h; u.mode = M_MEMS; u.A = (const char*)(ws + WS_QMH) + ((size_t)h * S + pm * 256) * 512 * 2; u.B = (const char*)(ws + WS_KMH) + (size_t)h * ML * 512 * 2; }
        return true;
    }
};

struct EpiMulZ {
    __device__ __forceinline__ bool keep_acc(const Unit&) const { return false; }
    unsigned char* dout;
    __device__ __forceinline__ void operator()(f32x4 (&acc)[2][2][4][2], const Unit& u, int wr, int wc, int fr, int fq) const {
        bf16_t* Z = (bf16_t*)dout + (size_t)S * D; const int row0 = u.pm * 256, cb = u.pn * 256;
        EPI_LOOP_BEGIN
            bf16_t* p = Z + (size_t)(row0 + rt) * D + cb + ct; float z[8]; unpack8(*(const u32x4*)p, z);
#pragma unroll
            for (int j = 0; j < 8; ++j) v[j] *= act_silu(z[j]);
            *(u32x4*)p = pack8(v);
        EPI_LOOP_END
    }
};
struct SchedP3b {
    const unsigned char* ws; int G, c;
    __device__ __forceinline__ bool next(int i, Unit& u) const {
        if (i >= 1 || c >= 256) return false;
        const int l = c >> 3, pm = 4 * (c & 7) + (l & 3), hn = l >> 2, h = hn >> 1; u.pm = pm; u.pn = hn; u.mode = M_MULZ;
        u.A = (const char*)(ws + WS_P) + ((size_t)h * S + pm * 256) * 256 * 2; u.B = (const char*)(ws + WS_VMT) + (size_t)hn * 256 * 256 * 2; return true;
    }
};

struct EpiP4 {
    unsigned char* ws;
    __device__ __forceinline__ bool keep_acc(const Unit& u) const { return u.mode != M_BR2; }
    __device__ __forceinline__ void operator()(f32x4 (&acc)[2][2][4][2], const Unit& u, int wr, int wc, int fr, int fq) const {
        const int n = u.mode - M_BR0, row0 = u.pm * 256, cb = u.pn * 256;
        const bf16_t* G = (const bf16_t*)(ws + WS_G) + (size_t)n * D; bf16_t* MG = (bf16_t*)(ws + WS_MERGED);
#pragma unroll
        for (int ai = 0; ai < 2; ++ai) {
            u32x4 ga[4][2], gb[4][2];
#pragma unroll
            for (int m = 0; m < 4; ++m)
#pragma unroll
                for (int bj = 0; bj < 2; ++bj) { const size_t r = (size_t)(row0 + ai * 128 + wr * 64 + m * 16 + fr); const bf16_t* gp = G + r * 3 * D + cb + bj * 128 + wc * 32 + 8 * fq;
                    ga[m][bj] = *(const u32x4*)gp; if (n < 2) gb[m][bj] = *(const u32x4*)(gp + D); }
#pragma unroll
            for (int m = 0; m < 4; ++m)
#pragma unroll
                for (int bj = 0; bj < 2; ++bj) { float g[8]; unpack8(ga[m][bj], g);
                    if (n < 2) { float gn[8]; unpack8(gb[m][bj], gn);
#pragma unroll
                        for (int j = 0; j < 8; ++j) acc[ai][bj][m][j >> 2][j & 3] *= gn[j] * fast_rcp(g[j]); }
                    else { float v[8]; const size_t r = (size_t)(row0 + ai * 128 + wr * 64 + m * 16 + fr);
#pragma unroll
                        for (int j = 0; j < 8; ++j) v[j] = acc[ai][bj][m][j >> 2][j & 3] * fast_rcp(g[j]);
                        *(u32x4*)(MG + r * D + cb + bj * 128 + wc * 32 + 8 * fq) = pack8(v); } }
        }
    }
};
struct SchedP4 {
    const unsigned char* ws; const unsigned char* dout; int G, c;
    __device__ __forceinline__ bool next(int i, Unit& u) const {
        if (i >= 3 || c >= 256) return false;
        const int vc = (c % 8) * 32 + c / 8, pm = vc / 8, pn = vc % 8; u.pm = pm; u.pn = pn; u.mode = M_BR0 + i;
        const unsigned char* y = i == 0 ? ws + WS_UG : i == 1 ? dout : dout + (size_t)S * D * 2;
        u.A = (const char*)y + (size_t)pm * 256 * D * 2; u.B = (const char*)(ws + WS_WBR) + ((size_t)i * D + pn * 256) * D * 2; return true;
    }
};

struct EpiP5 {
    __device__ __forceinline__ bool keep_acc(const Unit&) const { return false; }
    unsigned char* ws; float* out;
    __device__ __forceinline__ void operator()(f32x4 (&acc)[2][2][4][2], const Unit& u, int wr, int wc, int fr, int fq) const {
        const int row0 = u.pm * 256, cb = u.pn * 256; float* st = (float*)(ws + WS_OST) + (size_t)(u.pn * 4 + wc) * S;
#pragma unroll
        for (int ai = 0; ai < 2; ++ai)
#pragma unroll
            for (int m = 0; m < 4; ++m) { const int rt = ai * 128 + wr * 64 + m * 16 + fr; float s2 = 0.f;
#pragma unroll
                for (int bj = 0; bj < 2; ++bj) { const int ct = bj * 128 + wc * 32 + 8 * fq; const f32x4 a = acc[ai][bj][m][0], b = acc[ai][bj][m][1];
                    s2 += (a[0] * a[0] + a[1] * a[1]) + (a[2] * a[2] + a[3] * a[3]) + (b[0] * b[0] + b[1] * b[1]) + (b[2] * b[2] + b[3] * b[3]);
                    const float v_[8] = {a[0], a[1], a[2], a[3], b[0], b[1], b[2], b[3]}; *(u32x4*)((bf16_t*)(ws + WS_MP) + (size_t)(row0 + rt) * D + cb + ct) = pack8(v_); }
                s2 += __shfl_xor(s2, 16); s2 += __shfl_xor(s2, 32);
                if (fq == 0) st[row0 + rt] = s2; }
    }
};
struct SchedP5 {
    const unsigned char* ws; int G, c;
    __device__ __forceinline__ bool next(int i, Unit& u) const {
        if (i >= 1 || c >= 256) return false;
        const int vc = (c % 8) * 32 + c / 8, pm = vc / 8, pn = vc % 8; u.pm = pm; u.pn = pn; u.mode = M_OUT;
        u.A = (const char*)(ws + WS_MERGED) + (size_t)pm * 256 * D * 2; u.B = (const char*)(ws + WS_WOUT) + (size_t)pn * 256 * D * 2; return true;
    }
};

enum { MAP_ID = 0, MAP_WIN, MAP_UQ };
__device__ __forceinline__ int map_row(int map, int n) {
    if (map == MAP_WIN) { if (n < 7168) return n; if (n < 7232) { const int i = n - 7168; return 7168 + (i < 32 ? 2 * i : 2 * (i - 32) + 1); } return n + 192; }
    if (map == MAP_UQ) { const int h = n / DQK, w = n - h * DQK; if (w < 128) return n; const int i = w - 128; return h * DQK + 128 + (i < 32 ? 2 * i : 2 * (i - 32) + 1); }
    return n;
}
struct WTile { const float* W; bf16_t* WT; const float* kgain; int K, N, row_off, map, k0, n0; float sc; };
struct WSeg { const float* W; bf16_t* WT; const float* kgain; int K, N, row_off, map; float sc; };
__device__ __forceinline__ WTile wtile_of(const WSeg& s, int r) { WTile t; t.W = s.W; t.WT = s.WT; t.kgain = s.kgain; t.K = s.K; t.N = s.N; t.row_off = s.row_off; t.map = s.map; t.sc = s.sc;
    const int nblk = s.N / 64; t.k0 = 64 * (r / nblk); t.n0 = 64 * (r % nblk); return t; }
__device__ __forceinline__ void wtile_issue(const WTile& t, f32x4 (&r)[16], int lane) {
    const float* p = t.W + (size_t)(t.k0 + (lane >> 4)) * t.N + t.n0 + 4 * (lane & 15);
#pragma unroll
    for (int q = 0; q < 16; ++q) r[q] = *(const f32x4*)(p + (size_t)(4 * q) * t.N);
}
__device__ __forceinline__ void wtile_finish(const WTile& t, const f32x4 (&r)[16], LAS float* scr, int lane) {
#pragma unroll
    for (int q = 0; q < 16; ++q) { const int k = 4 * q + (lane >> 4); f32x4 v = r[q] * t.sc; if (t.kgain) v = v * t.kgain[t.k0 + k];
        *(LAS f32x4*)(scr + k * 64 + ((4 * (lane & 15)) ^ (((k >> 3) & 7) << 3))) = v; }
    asm volatile("s_waitcnt lgkmcnt(0)" ::: "memory");
    const int c = lane & 7;
#pragma unroll
    for (int j = 0; j < 8; ++j) { const int n = (lane >> 3) + 8 * j; const LAS float* s = scr + (8 * c) * 64 + (n ^ (c << 3));
        u32x4 o; o.x = cvt_pk_bf16(s[0 * 64], s[1 * 64]); o.y = cvt_pk_bf16(s[2 * 64], s[3 * 64]); o.z = cvt_pk_bf16(s[4 * 64], s[5 * 64]); o.w = cvt_pk_bf16(s[6 * 64], s[7 * 64]);
        *(u32x4*)(t.WT + (size_t)(t.row_off + map_row(t.map, t.n0 + n)) * t.K + t.k0 + 8 * c) = o; }
    asm volatile("s_waitcnt lgkmcnt(0)" ::: "memory");
}
template <int NSEG> __device__ __forceinline__ WTile wtile_decode(const WSeg (&seg)[NSEG], int it) {
    int r = it;
#pragma unroll
    for (int s = 0; s < NSEG - 1; ++s) { const int cnt = (seg[s].K / 64) * (seg[s].N / 64); if (r < cnt) return wtile_of(seg[s], r); r -= cnt; }
    return wtile_of(seg[NSEG - 1], r);
}
template <int NSEG> __device__ __forceinline__ void wconv_run(const WSeg (&seg)[NSEG], int ntiles, int it0, int stride, LAS float* scr, int lane) {
    if (it0 >= ntiles) return;
    f32x4 ra[16], rb[16];
    WTile ta = wtile_decode(seg, it0), tb = ta; wtile_issue(ta, ra, lane);
    for (int it = it0; it < ntiles; it += 2 * stride) {
        const bool hb = it + stride < ntiles; if (hb) { tb = wtile_decode(seg, it + stride); wtile_issue(tb, rb, lane); }
        wtile_finish(ta, ra, scr, lane);
        if (!hb) break;
        const bool ha = it + 2 * stride < ntiles; if (ha) { ta = wtile_decode(seg, it + 2 * stride); wtile_issue(ta, ra, lane); }
        wtile_finish(tb, rb, scr, lane);
    }
}
__device__ __forceinline__ void rms_row_to_bf16(const float* xrow, const float* g, bf16_t* orow, int lane) {
    const f32x4* xr = (const f32x4*)xrow + lane; const f32x4* gr = (const f32x4*)g + lane;
    f32x4 v[8]; float s = 0.f;
#pragma unroll
    for (int j = 0; j < 8; ++j) { v[j] = xr[64 * j]; s += (v[j].x * v[j].x + v[j].y * v[j].y) + (v[j].z * v[j].z + v[j].w * v[j].w); }
    const float rs = 1.0f / sqrtf(wave_sum(s) * (1.f / D) + EPS);
    u32x2* o8 = (u32x2*)orow + lane;
#pragma unroll
    for (int j = 0; j < 8; ++j) { const f32x4 gg = gr[64 * j]; u32x2 w; w.x = cvt_pk_bf16(v[j].x * rs * gg.x, v[j].y * rs * gg.y); w.y = cvt_pk_bf16(v[j].z * rs * gg.z, v[j].w * rs * gg.w); o8[64 * j] = w; }
}
__device__ __forceinline__ void phase0(const Ptrs& P, LAS unsigned char* lds, int vcu, int G, int tid, int lane, int wave) {
    unsigned char* ws = P.ws;
    LAS float* scr = (LAS float*)(lds + wave * 16384);
    const int gw = vcu * NWAVES + wave, NGW = G * NWAVES;
    { const WSeg seg[5] = {
          {P.in[4], (bf16_t*)(ws + WS_WIN), nullptr, D, IN_TOTAL, 0, MAP_WIN, 1.f},
          {P.in[15], (bf16_t*)(ws + WS_WIN), nullptr, D, 6144, 53 * 256, MAP_ID, 1.f},
          {P.in[10], (bf16_t*)(ws + WS_WUQ), P.in[9], 512, 3072, 0, MAP_UQ, QSCALE},
          {P.in[12], (bf16_t*)(ws + WS_WUKV), P.in[11], 512, 4096, 0, MAP_ID, 1.f},
          {P.in[14], (bf16_t*)(ws + WS_WMEM), nullptr, D, 4096, 0, MAP_ID, 1.f}};
      constexpr int NT0 = 32 * (IN_TOTAL / 64) + 32 * 96 + 8 * 48 + 8 * 64 + 32 * 64;
      wconv_run(seg, NT0, gw, NGW, scr, lane); }
    { u32x4* z = (u32x4*)((bf16_t*)(ws + WS_WIN) + (size_t)7232 * D); const int n16 = 192 * D * 2 / 16;
      for (int i = vcu * NTHREADS + tid; i < n16; i += G * NTHREADS) z[i] = (u32x4){0u, 0u, 0u, 0u}; }
    const int gwr = gw >= 416 ? gw - 416 : gw + NGW - 416;
    for (int m = gwr; m < S + ML; m += NGW) {
        if (m < S) rms_row_to_bf16(P.in[0] + (size_t)m * D, P.in[3], (bf16_t*)(ws + WS_H) + (size_t)m * D, lane);
        else rms_row_to_bf16(P.in[1] + (size_t)(m - S) * D, P.in[13], (bf16_t*)(ws + WS_MEMN) + (size_t)(m - S) * D, lane);
    }
    { const int* pos = (const int*)P.in[2]; f32x2* CS = (f32x2*)(ws + WS_CS);
      for (int e = vcu * NTHREADS + tid; e < S * 32; e += G * NTHREADS) { const int row = e >> 5, i = e & 31;
          const double inv = exp2(-(double)i * (13.287712379549449 / 32.0));
          const float invf = (float)inv; const float angf = (float)pos[row] * invf;
          const double a = (double)angf; const double k = rint(a * 0.15915494309189535); const float r = (float)(a - k * 6.283185307179586);
          CS[e] = (f32x2){__cosf(r), __sinf(r)}; } }
    { const float* w = P.in[7]; bf16_t* o = (bf16_t*)(ws + WS_WSM);
      for (int e = vcu * NTHREADS + tid; e < 16 * 128 * 128 / 2; e += G * NTHREADS) { const int idx = e * 2, t = (idx >> 7) & 127, s = idx & 127;
          const float a = s <= t ? w[idx] : 0.f, b = (s + 1) <= t ? w[idx + 1] : 0.f; ((unsigned*)o)[e] = cvt_pk_bf16(a, b); } }
}
__device__ __forceinline__ void phase_wconv2(const Ptrs& P, LAS unsigned char* lds, int vcu, int G, int lane, int wave) {
    unsigned char* ws = P.ws; LAS float* scr = (LAS float*)(lds + wave * 16384);
    const int gw = vcu * NWAVES + wave, NGW = G * NWAVES;
    const WSeg seg[4] = {
        {P.in[17], (bf16_t*)(ws + WS_WBR), nullptr, D, D, 0, MAP_ID, 1.f},
        {P.in[17] + (size_t)D * D, (bf16_t*)(ws + WS_WBR), nullptr, D, D, D, MAP_ID, 1.f},
        {P.in[17] + (size_t)2 * D * D, (bf16_t*)(ws + WS_WBR), nullptr, D, D, 2 * D, MAP_ID, 1.f},
        {P.in[18], (bf16_t*)(ws + WS_WOUT), nullptr, D, D, 0, MAP_ID, 1.f}};
    wconv_run(seg, 4 * 32 * 32, gw, NGW, scr, lane);
}

namespace att {
constexpr int NW = 8, QBLK = 32, KVBLK = 64, QB = 256;
constexpr int SHM_V = KVBLK * DV * 2, SHM_K = KVBLK * DQK * 2;
constexpr float THR = 6.f;
#define SBAR() __builtin_amdgcn_sched_barrier(0)
#define KSWZ(row, colB) ((row) * 384 + ((colB) ^ ((((row) >> 1) & 7) << 4)))
__device__ __forceinline__ int v_st(int k, int c) { const int kk = (k & ~0xC) | ((k & 4) << 1) | ((k & 8) >> 1); return ((kk >> 3) * 4 + (c >> 5)) * 512 + ((kk & 7) * 32 + (c & 31)) * 2; }
__device__ __forceinline__ int v_rd_base(int lane) { return ((lane & 3) << 3) | (((lane >> 2) & 3) << 6) | (((lane >> 4) & 1) << 5) | (((lane >> 5) & 1) << 8); }
constexpr int v_rd_off(int d0, int ks, int half) { return d0 * 512 + ks * 4096 + half * 2048; }
__device__ __forceinline__ int crow(int r, int hi) { return (r & 3) + 8 * (r >> 2) + 4 * hi; }
__device__ __forceinline__ void mask_tile(f32x16& p0, f32x16& p1, int dq) {
    const float NEG = -__builtin_inff();
#pragma unroll
    for (int r = 0; r < 16; ++r) { const int c = (r & 3) + 8 * (r >> 2); if (dq - c < 0) p0[r] = NEG; if (dq - c - 32 < 0) p1[r] = NEG; }
}
__device__ __forceinline__ void partialSM(f32x16& p0, f32x16& p1, float& m_reg, float& mn, float& alpha) {
    float pmax = p0[0];
#pragma unroll
    for (int r = 1; r < 16; ++r) pmax = fmaxf(pmax, p0[r]);
#pragma unroll
    for (int r = 0; r < 16; ++r) pmax = fmaxf(pmax, p1[r]);
    { auto rr = __builtin_amdgcn_permlane32_swap(__float_as_uint(pmax), __float_as_uint(pmax), false, false); pmax = fmaxf(__uint_as_float(rr[0]), __uint_as_float(rr[1])); }
    if (__builtin_expect(__all((pmax - m_reg) <= THR), 1)) { mn = m_reg; alpha = 1.f; }
    else { mn = fmaxf(m_reg, pmax); alpha = fast_exp2(m_reg - mn); m_reg = mn; }
#pragma unroll
    for (int r = 0; r < 16; ++r) p0[r] = p0[r] - mn;
#pragma unroll
    for (int r = 0; r < 16; ++r) p1[r] = p1[r] - mn;
#pragma unroll
    for (int r = 0; r < 16; ++r) p0[r] = fast_exp2(p0[r]);
}
__device__ __forceinline__ void finishSM(f32x16& p0, f32x16& p1, float alpha, float& l_reg, bf16x8& pa0, bf16x8& pa1, bf16x8& pa2, bf16x8& pa3) {
#pragma unroll
    for (int r = 0; r < 16; ++r) p1[r] = fast_exp2(p1[r]);
    float ps = 0;
#pragma unroll
    for (int r = 0; r < 16; ++r) ps += p0[r];
#pragma unroll
    for (int r = 0; r < 16; ++r) ps += p1[r];
    { auto rr = __builtin_amdgcn_permlane32_swap(__float_as_uint(ps), __float_as_uint(ps), false, false); ps = __uint_as_float(rr[0]) + __uint_as_float(rr[1]); }
    l_reg = l_reg * alpha + ps;
#define PK4(P, B_, OUT) do { unsigned a0 = cvt_pk_bf16(P[B_+0], P[B_+1]), a1 = cvt_pk_bf16(P[B_+2], P[B_+3]); unsigned b0 = cvt_pk_bf16(P[B_+4], P[B_+5]), b1 = cvt_pk_bf16(P[B_+6], P[B_+7]); \
        auto r0 = __builtin_amdgcn_permlane32_swap(a0, b0, false, false); auto r1 = __builtin_amdgcn_permlane32_swap(a1, b1, false, false); \
        u32x4 w = {r0[0], r1[0], r0[1], r1[1]}; OUT = *reinterpret_cast<bf16x8*>(&w); } while (0)
    PK4(p0, 0, pa0); PK4(p0, 8, pa1); PK4(p1, 0, pa2); PK4(p1, 8, pa3);
#undef PK4
}
#define TRRD(dst, off) asm volatile("ds_read_b64_tr_b16 %0, %1 offset:%2" : "=&v"(dst) : "v"(vb0), "i"(off) : "memory")
#define PV_D0(OO, VBOFF, d0) do { s16x4 l0, l1, l2, l3, h0, h1, h2, h3; constexpr int b_ = (VBOFF) + v_rd_off(d0, 0, 0); \
        TRRD(l0, b_); TRRD(h0, b_ + 2048); TRRD(l1, b_ + 4096); TRRD(h1, b_ + 6144); TRRD(l2, b_ + 8192); TRRD(h2, b_ + 10240); TRRD(l3, b_ + 12288); TRRD(h3, b_ + 14336); \
        asm volatile("s_waitcnt lgkmcnt(0)" ::: "memory"); SBAR(); \
        OO = __builtin_amdgcn_mfma_f32_32x32x16_bf16(pa0, (bf16x8){l0[0], l0[1], l0[2], l0[3], h0[0], h0[1], h0[2], h0[3]}, OO, 0, 0, 0); \
        OO = __builtin_amdgcn_mfma_f32_32x32x16_bf16(pa1, (bf16x8){l1[0], l1[1], l1[2], l1[3], h1[0], h1[1], h1[2], h1[3]}, OO, 0, 0, 0); \
        OO = __builtin_amdgcn_mfma_f32_32x32x16_bf16(pa2, (bf16x8){l2[0], l2[1], l2[2], l2[3], h2[0], h2[1], h2[2], h2[3]}, OO, 0, 0, 0); \
        OO = __builtin_amdgcn_mfma_f32_32x32x16_bf16(pa3, (bf16x8){l3[0], l3[1], l3[2], l3[3], h3[0], h3[1], h3[2], h3[3]}, OO, 0, 0, 0); } while (0)
__device__ __forceinline__ void glds16(const void* gsrc, unsigned lds_dst) { unsigned keep;
    asm volatile("s_mov_b32 %0, m0\n\ts_mov_b32 m0, %2\n\ts_nop 0\n\tglobal_load_lds_dwordx4 %1, off\n\ts_mov_b32 m0, %0" : "=&s"(keep) : "v"(gsrc), "s"(lds_dst) : "memory"); }
typedef short v4i16_t __attribute__((ext_vector_type(4)));
__device__ __forceinline__ s16x4 vtr(const LAS char* p) { return __builtin_bit_cast(s16x4, __builtin_amdgcn_ds_read_tr16_b64_v4i16((LAS v4i16_t*)p)); }
__device__ __forceinline__ void pv_tile2(f32x16* o, const LAS char* vp, bf16x8 pa0, bf16x8 pa1, bf16x8 pa2, bf16x8 pa3) {
#pragma unroll
    for (int d0 = 0; d0 < 4; ++d0) {
        const s16x4 l0 = vtr(vp + d0 * 512), h0 = vtr(vp + d0 * 512 + 2048), l1 = vtr(vp + d0 * 512 + 4096), h1 = vtr(vp + d0 * 512 + 6144);
        const s16x4 l2 = vtr(vp + d0 * 512 + 8192), h2 = vtr(vp + d0 * 512 + 10240), l3 = vtr(vp + d0 * 512 + 12288), h3 = vtr(vp + d0 * 512 + 14336);
        o[d0] = __builtin_amdgcn_mfma_f32_32x32x16_bf16(pa0, (bf16x8){l0[0], l0[1], l0[2], l0[3], h0[0], h0[1], h0[2], h0[3]}, o[d0], 0, 0, 0);
        o[d0] = __builtin_amdgcn_mfma_f32_32x32x16_bf16(pa1, (bf16x8){l1[0], l1[1], l1[2], l1[3], h1[0], h1[1], h1[2], h1[3]}, o[d0], 0, 0, 0);
        o[d0] = __builtin_amdgcn_mfma_f32_32x32x16_bf16(pa2, (bf16x8){l2[0], l2[1], l2[2], l2[3], h2[0], h2[1], h2[2], h2[3]}, o[d0], 0, 0, 0);
        o[d0] = __builtin_amdgcn_mfma_f32_32x32x16_bf16(pa3, (bf16x8){l3[0], l3[1], l3[2], l3[3], h3[0], h3[1], h3[2], h3[3]}, o[d0], 0, 0, 0); }
}
constexpr int OFF3_V = 0, OFF3_K = 4 * SHM_V, OFF3_WS = OFF3_K + 3 * SHM_K + 256;
__device__ __forceinline__ void attn_block3(const bf16_t* Qh, const bf16_t* Kh, const bf16_t* Vh, bf16_t* ZY, int P0, char* lds, const int tid) {
    const int wid = __builtin_amdgcn_readfirstlane(tid >> 6), lane = tid & 63, r32 = lane & 31, hi = lane >> 5;
    const bool lag = wid >= 4;
    const int NT = (P0 + QB) / KVBLK;
    const int qlo = P0 + wid * QBLK, qm = qlo + r32 - 4 * hi;
    char* K_lds = lds + OFF3_K;
    float* wsf = (float*)(lds + OFF3_WS) + wid * 64; float* li_l = wsf, * al_l = wsf + 32;
    float m_reg = -1e30f, l_reg = 0; f32x16 o[4] = {};
    const unsigned lds0 = (unsigned)(uintptr_t)lds;
    int kso[3], vso[2];
#pragma unroll
    for (int j = 0; j < 3; ++j) { const int q = (wid * 3 + j) * 1024 + lane * 16, row = q / 384, pos = q - row * 384; kso[j] = row * 384 + (pos ^ (((row >> 1) & 7) << 4)); }
#pragma unroll
    for (int j = 0; j < 2; ++j) { const int q = (wid * 2 + j) * 1024 + lane * 16, sub = q >> 9, within = q & 511, kk = (sub >> 2) * 8 + (within >> 6), cc = (within & 63) >> 1;
        const int k = (kk & ~0xC) | ((kk & 4) << 1) | ((kk & 8) >> 1), c = (sub & 3) * 32 + cc; vso[j] = k * (DV * 2) + c * 2; }
    int kis = 0, vis = 0, kq = 0, vp = 0;
#define ROTK(x) ((x) == 2 * SHM_K ? 0 : (x) + SHM_K)
#define ROTV(x) ((x) == 3 * SHM_V ? 0 : (x) + SHM_V)
#define DMA_TILE(t) do { const char* kt_ = (const char*)Kh + (size_t)(t) * SHM_K; const char* vt_ = (const char*)Vh + (size_t)(t) * SHM_V; \
        _Pragma("unroll") for (int j_ = 0; j_ < 3; ++j_) glds16(kt_ + kso[j_], (unsigned)__builtin_amdgcn_readfirstlane(lds0 + OFF3_K + kis + (wid * 3 + j_) * 1024)); \
        _Pragma("unroll") for (int j_ = 0; j_ < 2; ++j_) glds16(vt_ + vso[j_], (unsigned)__builtin_amdgcn_readfirstlane(lds0 + OFF3_V + vis + (wid * 2 + j_) * 1024)); \
        kis = ROTK(kis); vis = ROTV(vis); } while (0)
#define END_M() asm volatile("s_waitcnt vmcnt(0) lgkmcnt(0)\n\ts_barrier" ::: "memory")
#define END_V() asm volatile("s_waitcnt lgkmcnt(0)\n\ts_barrier" ::: "memory")
    int ko[4];
#pragma unroll
    for (int dd = 0; dd < 4; ++dd) ko[dd] = KSWZ(r32, (dd * 16 + hi * 8) * 2);
    const LAS char* vbb = (const LAS char*)lds + OFF3_V + v_rd_base(lane);
    DMA_TILE(0); DMA_TILE(1);
    bf16x8 qr[12];
#pragma unroll
    for (int d0 = 0; d0 < 12; ++d0) qr[d0] = *reinterpret_cast<const bf16x8*>(Qh + (size_t)(P0 + wid * QBLK + r32) * DQK + d0 * 16 + hi * 8);
#define RESC(a) do { if (__any((a) < 1.f)) { if (hi == 0) al_l[r32] = (a); asm volatile("s_waitcnt lgkmcnt(0)" ::: "memory"); \
        _Pragma("unroll") for (int d_ = 0; d_ < 4; ++d_) _Pragma("unroll") for (int r = 0; r < 16; ++r) o[d_][r] *= al_l[crow(r, hi)]; } } while (0)
    f32x16 p0, p1; float mn, al; bf16x8 pa0, pa1, pa2, pa3;
    END_M();
    if (lag) END_V();
    for (int i = 0; i < NT; ++i) {
        const char* kb_ = K_lds + kq; bf16x8 ka[8], kb2[8];
#define KLOAD(dst, blk) do { _Pragma("unroll") for (int dd = 0; dd < 4; ++dd) { const char* a = kb_ + ko[dd] + (blk) * 128; dst[2 * dd] = *reinterpret_cast<const bf16x8*>(a); dst[2 * dd + 1] = *reinterpret_cast<const bf16x8*>(a + 32 * 384); } } while (0)
#define KMMA(srcf, blk) do { _Pragma("unroll") for (int dd = 0; dd < 4; ++dd) { p0 = __builtin_amdgcn_mfma_f32_32x32x16_bf16(srcf[2 * dd], qr[(blk) * 4 + dd], p0, 0, 0, 0); p1 = __builtin_amdgcn_mfma_f32_32x32x16_bf16(srcf[2 * dd + 1], qr[(blk) * 4 + dd], p1, 0, 0, 0); } } while (0)
        SBAR();
        { _Pragma("unroll") for (int dd = 0; dd < 2; ++dd) { const char* a = kb_ + ko[dd]; ka[2 * dd] = *reinterpret_cast<const bf16x8*>(a); ka[2 * dd + 1] = *reinterpret_cast<const bf16x8*>(a + 32 * 384); } }
        SBAR();
        if (i >= 1) { pv_tile2(o, vbb + vp, pa0, pa1, pa2, pa3); vp = ROTV(vp); }
        SBAR();
        { p0 = f32x16{}; p1 = f32x16{};
          { _Pragma("unroll") for (int dd = 2; dd < 4; ++dd) { const char* a = kb_ + ko[dd]; ka[2 * dd] = *reinterpret_cast<const bf16x8*>(a); ka[2 * dd + 1] = *reinterpret_cast<const bf16x8*>(a + 32 * 384); } }
          KLOAD(kb2, 1); SBAR(); KMMA(ka, 0); SBAR(); KLOAD(ka, 2); SBAR(); KMMA(kb2, 1); SBAR(); KMMA(ka, 2);
#undef KLOAD
#undef KMMA
          kq = ROTK(kq); }
        END_M();
        if (i + 2 < NT) DMA_TILE(i + 2);
        SBAR();
        { const int kb_ = i * KVBLK; if (kb_ + KVBLK - 1 > qlo) mask_tile(p0, p1, qm - kb_); }
        partialSM(p0, p1, m_reg, mn, al); RESC(al);
        finishSM(p0, p1, al, l_reg, pa0, pa1, pa2, pa3);
        END_V();
    }
    SBAR(); pv_tile2(o, vbb + vp, pa0, pa1, pa2, pa3);
    if (!lag) END_V();
    if (hi == 0) li_l[r32] = l_reg; asm volatile("s_waitcnt lgkmcnt(0)" ::: "memory");
    float rli[16];
#pragma unroll
    for (int r = 0; r < 16; ++r) rli[r] = fast_rcp(li_l[crow(r, hi)]);
    __syncthreads();
    bf16_t* stg = (bf16_t*)lds + wid * 4096;
#pragma unroll
    for (int r = 0; r < 16; ++r) { const int orow = crow(r, hi);
#pragma unroll
        for (int d0 = 0; d0 < 4; ++d0) { const float v = o[d0][r] * rli[r]; const float vn = __shfl_xor(v, 1);
            if ((r32 & 1) == 0) *(unsigned*)(stg + orow * 128 + d0 * 32 + r32) = cvt_pk_bf16(v, vn); } }
    asm volatile("s_waitcnt lgkmcnt(0)" ::: "memory");
    bf16_t* zy = ZY + (size_t)(P0 + wid * QBLK) * D;
#pragma unroll
    for (int i = 0; i < 8; ++i) { const int id = lane + 64 * i, row = id >> 4, ch = id & 15; float a[8], z[8];
        unpack8(*(const u32x4*)(stg + row * 128 + ch * 8), a); bf16_t* p = zy + (size_t)row * D + ch * 8; unpack8(*(const u32x4*)p, z);
#pragma unroll
        for (int j = 0; j < 8; ++j) a[j] *= act_silu(z[j]);
        *(u32x4*)p = pack8(a); }
    __syncthreads();
#undef ROTK
#undef ROTV
#undef DMA_TILE
#undef END_M
#undef END_V
#undef RESC
}

__device__ __forceinline__ void mixer_block(unsigned char* ws, const float* ln_g, const float* ln_b, const float* b_s, int chunk, int g, char* lds, const int tid) {
    const int wid = __builtin_amdgcn_readfirstlane(tid >> 6), lane = tid & 63, r32 = lane & 31, hi = lane >> 5;
    const int rb = wid & 3, dh = wid >> 2;
    const bf16_t* Vg = (const bf16_t*)(ws + WS_VG); const f32x2* VMR = (const f32x2*)(ws + WS_VMR);
    const int sr = tid >> 4, sc = (tid & 15) * 8; const int row0 = chunk * 128, col0 = g * 128;
    float lg[8], lb[8];
#pragma unroll
    for (int j = 0; j < 8; ++j) { lg[j] = ln_g[col0 + sc + j]; lb[j] = ln_b[col0 + sc + j]; }
#pragma unroll
    for (int q = 0; q < 4; ++q) { const int s = q * 32 + sr; const f32x2 mr = VMR[row0 + s]; float v[8];
        unpack8(*(const u32x4*)(Vg + (size_t)(row0 + s) * D + col0 + sc), v);
#pragma unroll
        for (int j = 0; j < 8; ++j) v[j] = (v[j] - mr.x) * mr.y * lg[j] + lb[j];
        *(u32x4*)(lds + (q >> 1) * SHM_V + v_st((q & 1) * 32 + sr, sc)) = pack8(v); }
    const bf16_t* Wm = (const bf16_t*)(ws + WS_WSM) + ((size_t)g * 128 + rb * 32 + r32) * 128;
    bf16x8 wa[2][4];
#pragma unroll
    for (int kt = 0; kt < 2; ++kt)
#pragma unroll
        for (int ks = 0; ks < 4; ++ks) wa[kt][ks] = *(const bf16x8*)(Wm + kt * 64 + ks * 16 + hi * 8);
    __syncthreads();
    const int vb0 = (int)(uintptr_t)lds + v_rd_base(lane);
    f32x16 o0 = {}, o1 = {};
    if (dh == 0) {
        { bf16x8 pa0 = wa[0][0], pa1 = wa[0][1], pa2 = wa[0][2], pa3 = wa[0][3]; PV_D0(o0, 0, 0); PV_D0(o1, 0, 1); }
        if (rb >= 2) { bf16x8 pa0 = wa[1][0], pa1 = wa[1][1], pa2 = wa[1][2], pa3 = wa[1][3]; PV_D0(o0, SHM_V, 0); PV_D0(o1, SHM_V, 1); }
    } else {
        { bf16x8 pa0 = wa[0][0], pa1 = wa[0][1], pa2 = wa[0][2], pa3 = wa[0][3]; PV_D0(o0, 0, 2); PV_D0(o1, 0, 3); }
        if (rb >= 2) { bf16x8 pa0 = wa[1][0], pa1 = wa[1][1], pa2 = wa[1][2], pa3 = wa[1][3]; PV_D0(o0, SHM_V, 2); PV_D0(o1, SHM_V, 3); }
    }
    float* stg = (float*)(lds + 2 * SHM_V) + wid * 2048;
#pragma unroll
    for (int r = 0; r < 16; ++r) { const int tr = crow(r, hi); stg[tr * 64 + r32] = o0[r]; stg[tr * 64 + 32 + r32] = o1[r]; }
    asm volatile("s_waitcnt lgkmcnt(0)" ::: "memory");
    bf16_t* Ug = (bf16_t*)(ws + WS_UG); const bf16_t* Za = (const bf16_t*)(ws + WS_ZA);
#pragma unroll
    for (int i = 0; i < 4; ++i) { const int id = lane + 64 * i, tr = id >> 3, ch = id & 7, t = rb * 32 + tr; const float bs = b_s[g * 128 + t];
        const size_t off = (size_t)(row0 + t) * D + col0 + dh * 64 + ch * 8;
        const f32x4 s0 = *(const f32x4*)(stg + tr * 64 + ch * 8), s1 = *(const f32x4*)(stg + tr * 64 + ch * 8 + 4);
        float u[8], z[8], y[8]; unpack8(*(const u32x4*)(Ug + off), u); unpack8(*(const u32x4*)(Za + off), z);
#pragma unroll
        for (int j = 0; j < 4; ++j) { y[j] = act_gelu(u[j]) * (s0[j] + bs) * act_silu(z[j]); y[4 + j] = act_gelu(u[4 + j]) * (s1[j] + bs) * act_silu(z[4 + j]); }
        *(u32x4*)(Ug + off) = pack8(y); }
    __syncthreads();
}
#undef SBAR
}


#define XB_TMO      128
#define XB_XCNT(j)  (256  + 64 * (j))
#define XB_XSUB(j)  (1280 + 64 * (j))
#define XB_XGEN(j)  (2304 + 64 * (j))
#define XB_TOP      3328
#define XB_TOPGEN   3392
#define XCD_BAR_WORDS 3456
#define XB_SPIN_CAP (1u << 22)
__device__ __forceinline__ unsigned xb_ld(unsigned* p)              { return __hip_atomic_load(p, __ATOMIC_RELAXED, __HIP_MEMORY_SCOPE_AGENT); }
__device__ __forceinline__ unsigned xb_add(unsigned* p, unsigned v) { return __hip_atomic_fetch_add(p, v, __ATOMIC_RELAXED, __HIP_MEMORY_SCOPE_AGENT); }
__device__ __forceinline__ unsigned xb_xcc_id() { return (unsigned)__builtin_amdgcn_s_getreg((3 << 11) | 20) & 0xFu; }
#define XB_SPIN(cond, bar) do { unsigned _sp = 0; while (cond) { __builtin_amdgcn_s_sleep(1); \
    if ((++_sp & 255u) == 0u) { if (xb_ld(&(bar)[XB_TMO])) break; if (_sp > XB_SPIN_CAP) { atomicAdd(&(bar)[XB_TMO], 1u); break; } } } } while (0)
__device__ __forceinline__ void xcd_barrier_complete(unsigned* bar, unsigned x, unsigned& nloc, unsigned& nx) {
    const unsigned G = gridDim.x;
    unsigned sum, cnt, mine, sp = 0u;
    for (;;) {
        sum = 0u; cnt = 0u; mine = 0u;
#pragma unroll
        for (unsigned j = 0; j < 16; ++j) { const unsigned c = xb_ld(&bar[XB_XCNT(j)]); sum += c; cnt += (c > 0u) ? 1u : 0u; mine = (j == x) ? c : mine; }
        if (sum == G) break;
        __builtin_amdgcn_s_sleep(1);
        if ((++sp & 255u) == 0u) { if (xb_ld(&bar[XB_TMO])) break; if (sp > XB_SPIN_CAP) { atomicAdd(&bar[XB_TMO], 1u); break; } }
    }
    nloc = mine > 0u ? mine : 1u; nx = cnt > 0u ? cnt : 1u;
}
__device__ __forceinline__ void xcd_barrier(unsigned* bar, volatile LAS unsigned* st, const int tid) {
    asm volatile("s_waitcnt vmcnt(0)" ::: "memory");
    __syncthreads();
    if (tid == 0) {
        const unsigned x = xb_xcc_id();
        __builtin_amdgcn_s_waitcnt(0);
        unsigned nloc = st[0], nx = st[1];
        if (nloc == 0u) { xcd_barrier_complete(bar, x, nloc, nx); st[0] = nloc; st[1] = nx; }
        const unsigned old = xb_add(&bar[XB_XSUB(x)], 1u);
        const unsigned gen = old / nloc;
        if (old + 1u == (gen + 1u) * nloc) {
            __builtin_amdgcn_fence(__ATOMIC_RELEASE, "agent");
            asm volatile("s_waitcnt vmcnt(0)" ::: "memory");
            const unsigned og = xb_add(&bar[XB_TOP], 1u);
            const unsigned tg = og / nx;
            if (og + 1u == (tg + 1u) * nx) xb_add(&bar[XB_TOPGEN], 1u);
            else XB_SPIN(xb_ld(&bar[XB_TOPGEN]) == tg, bar);
            __builtin_amdgcn_fence(__ATOMIC_ACQUIRE, "agent");
            xb_add(&bar[XB_XGEN(x)], 1u);
            asm volatile("s_waitcnt vmcnt(0)" ::: "memory");
        } else {
            XB_SPIN(xb_ld(&bar[XB_XGEN(x)]) == gen, bar);
            __builtin_amdgcn_fence(__ATOMIC_ACQUIRE, "agent");
            asm volatile("s_waitcnt vmcnt(0)" ::: "memory");
        }
    }
    __syncthreads();
}

typedef const __attribute__((address_space(4))) Ptrs* KargPtr;
#define PHASE_ENV() KargPtr kp_ = (KargPtr)__builtin_amdgcn_kernarg_segment_ptr(); asm volatile("" : "+s"(kp_)); \
    const int wave = wave0_; int lane = (int)__builtin_amdgcn_mbcnt_hi(~0u, __builtin_amdgcn_mbcnt_lo(~0u, 0u)); asm volatile("" : "+v"(lane)); const int tid = wave * 64 + lane; \
    int G = gridDim.x, c = blockIdx.x; asm volatile("" : "+s"(G), "+s"(c)); const int vcu = (G % 8 == 0) ? (c % 8) * (G / 8) + c / 8 : c; \
    unsigned char* ws = kp_->ws; unsigned char* dout = (unsigned char*)kp_->out; (void)lane; (void)wave; (void)vcu; (void)ws; (void)dout
__global__ void __launch_bounds__(NTHREADS, 2) hybrid_fwd(Ptrs Punused) {
    extern __shared__ __attribute__((aligned(16))) unsigned char lds_raw[];
    LAS unsigned char* lds = (LAS unsigned char*)lds_raw;
    const int wave0_ = __builtin_amdgcn_readfirstlane((int)threadIdx.x >> 6);
    int lo, hi; { KargPtr k0 = (KargPtr)__builtin_amdgcn_kernarg_segment_ptr(); lo = k0->ph_lo; hi = k0->ph_hi; }
#define IN(k) (lo <= (k) && (k) < hi)
#if MK_SINGLE
    volatile LAS unsigned* bst_ = (volatile LAS unsigned*)(lds + BARST_OFF);
    { if ((int)threadIdx.x == 0) { bst_[0] = 0u; bst_[1] = 0u; KargPtr k0 = (KargPtr)__builtin_amdgcn_kernarg_segment_ptr(); (void)xb_add(&((unsigned*)k0->ws)[XB_XCNT(xb_xcc_id())], 1u); } __syncthreads(); }
#define SEAM(k) do { if (IN(k) && IN((k) + 1)) { PHASE_ENV(); if (kp_->use_cg) cg::this_grid().sync(); else xcd_barrier((unsigned*)ws, bst_, tid); } } while (0)
#else
#define SEAM(k) do { } while (0)
#endif
    if (IN(0)) { PHASE_ENV(); Ptrs P; { const __attribute__((address_space(4))) unsigned long long* s_ = (const __attribute__((address_space(4))) unsigned long long*)kp_; unsigned long long* d_ = (unsigned long long*)&P; _Pragma("unroll") for (int i_ = 0; i_ < (int)(sizeof(Ptrs) / 8); ++i_) d_[i_] = s_[i_]; } phase0(P, lds, vcu, G, tid, lane, wave); }
    SEAM(0);
    if (IN(1)) { PHASE_ENV(); SchedP1 Sc{ws, G, c}; EpiP1 E{ws, dout, kp_->in[16]}; pg8::gemm_phase<2048>(lds, Sc, E, tid); }
    SEAM(1);
    if (IN(2)) { PHASE_ENV();
        { const f32x2* st = (const f32x2*)(ws + WS_VST); f32x2* mr = (f32x2*)(ws + WS_VMR);
          for (int row = c * 32 + (tid >> 4); row < S; row += G * 32) { const int sub = tid & 15;
              const f32x2 p0 = st[(size_t)sub * S + row], p1 = st[(size_t)(sub + 16) * S + row]; float s1 = p0.x + p1.x, s2 = p0.y + p1.y;
#pragma unroll
              for (int o = 1; o < 16; o <<= 1) { s1 += __shfl_xor(s1, o); s2 += __shfl_xor(s2, o); }
              const float mean = s1 * (1.f / D); const float var = fmaxf(s2 * (1.f / D) - mean * mean, 0.f); if (sub == 0) mr[row] = (f32x2){mean, 1.0f / sqrtf(var + EPS)}; } }
        SchedP2 Sc{ws, G, c}; EpiP2 E{ws, (LAS float*)(lds + XCH_OFF)}; pg8::gemm_phase<512>(lds, Sc, E, tid);
    }
    SEAM(2);
    if (IN(3)) {
        { PHASE_ENV(); if (vcu < 256) { const int h = vcu >> 4, x = vcu & 15;
            const bf16_t* Qh = (const bf16_t*)(ws + WS_QB) + (size_t)h * S * DQK; const bf16_t* Kh = (const bf16_t*)(ws + WS_KB) + (size_t)h * S * DQK; const bf16_t* Vh = (const bf16_t*)(ws + WS_VB) + (size_t)h * S * DV;
            bf16_t* ZY = (bf16_t*)dout + h * DV;
            att::attn_block3(Qh, Kh, Vh, ZY, (31 - x) * 256, (char*)lds_raw, tid); att::attn_block3(Qh, Kh, Vh, ZY, x * 256, (char*)lds_raw, tid); } }
        { PHASE_ENV(); SchedP3b Sc{ws, G, c}; EpiMulZ E{dout}; pg8::gemm_phase<256>(lds, Sc, E, tid); }
        { PHASE_ENV(); const float* lng = kp_->in[5]; const float* lnb = kp_->in[6]; const float* bs = kp_->in[8];
            for (int it = vcu; it < 1024; it += G) att::mixer_block(ws, lng, lnb, bs, it >> 4, it & 15, (char*)lds_raw, tid); }
        { PHASE_ENV(); Ptrs P; { const __attribute__((address_space(4))) unsigned long long* s_ = (const __attribute__((address_space(4))) unsigned long long*)kp_; unsigned long long* d_ = (unsigned long long*)&P; _Pragma("unroll") for (int i_ = 0; i_ < (int)(sizeof(Ptrs) / 8); ++i_) d_[i_] = s_[i_]; } phase_wconv2(P, lds, vcu, G, lane, wave); }
    }
    SEAM(3);
    if (IN(4)) { PHASE_ENV(); SchedP4 Sc{ws, dout, G, c}; EpiP4 E{ws}; pg8::gemm_phase<2048>(lds, Sc, E, tid); }
    SEAM(4);
    if (IN(5)) { PHASE_ENV(); SchedP5 Sc{ws, G, c}; EpiP5 E{ws, (float*)dout}; pg8::gemm_phase<2048>(lds, Sc, E, tid); }
    SEAM(5);
    if (IN(6)) { PHASE_ENV();
        const float* st = (const float*)(ws + WS_OST); const float* x = kp_->in[0]; const float* gp = kp_->in[19]; float* outp = (float*)dout;
        for (int row = vcu * NWAVES + wave; row < S; row += G * NWAVES) {
            float s = lane < 32 ? st[(size_t)lane * S + row] : 0.f; s = wave_sum(s);
            const float rs = 1.0f / sqrtf(s * (1.f / D) + EPS);
            const f32x4* xr = (const f32x4*)(x + (size_t)row * D); f32x4* orow = (f32x4*)(outp + (size_t)row * D); const f32x4* gr = (const f32x4*)gp; const u32x4* ob = (const u32x4*)((const bf16_t*)(ws + WS_MP) + (size_t)row * D);
#pragma unroll
            for (int j = 0; j < 4; ++j) { const int q = 64 * j + lane; float a[8]; unpack8(ob[q], a); const f32x4 x0 = xr[2 * q], x1 = xr[2 * q + 1], g0 = gr[2 * q], g1 = gr[2 * q + 1];
                orow[2 * q] = x0 + (f32x4){a[0], a[1], a[2], a[3]} * rs * g0; orow[2 * q + 1] = x1 + (f32x4){a[4], a[5], a[6], a[7]} * rs * g1; }
        }
    }
#undef IN
#undef SEAM
}

extern "C" void kernel_launch(void* const* d_in, const int* in_sizes, int n_in, void* d_out, int out_size, void* d_ws, size_t ws_size, hipStream_t stream) {
    static int grid = 0;
    if (grid == 0) {
        if (n_in != 20 || out_size != S * D || ws_size < WS_END) { fprintf(stderr, "kernel_launch: unexpected shapes (n_in %d out %d ws %zu)\n", n_in, out_size, ws_size); grid = -1; return; }
        int dev = 0, cus = 0, per_cu = 0;
        (void)hipGetDevice(&dev); (void)hipDeviceGetAttribute(&cus, hipDeviceAttributeMultiprocessorCount, dev);
        (void)hipFuncSetAttribute((const void*)hybrid_fwd, hipFuncAttributeMaxDynamicSharedMemorySize, LDS_BYTES);
        (void)hipOccupancyMaxActiveBlocksPerMultiprocessor(&per_cu, (const void*)hybrid_fwd, NTHREADS, LDS_BYTES);
        if (per_cu < 1) { fprintf(stderr, "kernel_launch: occupancy query reports %d blocks per CU\n", per_cu); }
        grid = cus;
        (void)hipGetLastError();
    }
    if (grid < 0) return;
    Ptrs p{};
    for (int i = 0; i < 20; ++i) p.in[i] = (const float*)d_in[i];
    p.out = (float*)d_out; p.ws = (unsigned char*)d_ws;
#if MK_SINGLE
    (void)hipMemsetAsync(d_ws, 0, CTL_ZERO_BYTES, stream);
    p.ph_lo = 0; p.ph_hi = 7;
    void* args[] = {&p};
    hipError_t e = hipLaunchCooperativeKernel((const void*)hybrid_fwd, dim3(grid), dim3(NTHREADS), args, LDS_BYTES, stream);
    if (e != hipSuccess) fprintf(stderr, "cooperative launch failed: %s (grid %d)\n", hipGetErrorString(e), grid);
#else
    for (int k = 0; k < 7; ++k) { p.ph_lo = k; p.ph_hi = k + 1; hipLaunchKernelGGL(hybrid_fwd, dim3(grid), dim3(NTHREADS), LDS_BYTES, stream, p); }
#endif
}
```

```cpp
#include <hip/hip_runtime.h>
#include <hip/hip_cooperative_groups.h>
#include <cstdio>
#include <cstdint>
namespace cg = cooperative_groups;

#ifndef MK_SINGLE
#define MK_SINGLE 1
#endif

#define LAS __attribute__((address_space(3)))
typedef unsigned short bf16_t;
typedef short bf16x8 __attribute__((ext_vector_type(8)));
typedef short s16x4 __attribute__((ext_vector_type(4)));
typedef float f32x4 __attribute__((ext_vector_type(4)));
typedef float f32x2 __attribute__((ext_vector_type(2)));
typedef float f32x16 __attribute__((ext_vector_type(16)));
typedef unsigned u32x4 __attribute__((ext_vector_type(4)));
typedef unsigned u32x2 __attribute__((ext_vector_type(2)));

constexpr int S = 8192, D = 2048, ML = 256, NH = 16, DQK = 192, DV = 128;
constexpr int IN_TOTAL = 13376, NT_IN = 77;
constexpr float EPS = 1e-6f, LOG2E = 1.4426950408889634f;
constexpr float QSCALE = 0.07216878364870322f * 1.4426950408889634f;
constexpr float MSCALE = 0.04419417382415922f * 1.4426950408889634f;
constexpr int NTHREADS = 512, NWAVES = 8;
constexpr int RING_BYTES = 131072, XCH_OFF = RING_BYTES, BARST_OFF = XCH_OFF + 8192, LDS_BYTES = 147456;
constexpr size_t CTL_ZERO_BYTES = 16384;

constexpr size_t MiB = 1u << 20;
constexpr size_t WS_CS = 1 * MiB;
constexpr size_t WS_VST = 3 * MiB;
constexpr size_t WS_CQST = 5 * MiB;
constexpr size_t WS_CKVST = 5 * MiB + 256 * 1024;
constexpr size_t WS_VMR = 5 * MiB + 512 * 1024;
constexpr size_t WS_OST = 6 * MiB;
constexpr size_t WS_WSM = 7 * MiB;
constexpr size_t WS_KR = 8 * MiB;
constexpr size_t WS_KMH = 9 * MiB;
constexpr size_t WS_VMT = 10 * MiB;
constexpr size_t WS_WUQ = 11 * MiB;
constexpr size_t WS_WUKV = 14 * MiB;
constexpr size_t WS_WIN = 18 * MiB;
constexpr size_t WS_WMEM = 95 * MiB;
constexpr size_t WS_H = 111 * MiB;
constexpr size_t WS_MEMN = 143 * MiB;
constexpr size_t WS_UG = 144 * MiB;
constexpr size_t WS_VG = 176 * MiB;
constexpr size_t WS_ZA = 208 * MiB;
constexpr size_t WS_CQ = 240 * MiB;
constexpr size_t WS_CKV = 248 * MiB;
constexpr size_t WS_QMH = 256 * MiB;
constexpr size_t WS_G = 288 * MiB;
constexpr size_t WS_VB = 384 * MiB;
constexpr size_t WS_QB = 18 * MiB;
constexpr size_t WS_KB = 66 * MiB;
constexpr size_t WS_P = 114 * MiB;
constexpr size_t WS_WBR = 240 * MiB;
constexpr size_t WS_WOUT = 264 * MiB;
constexpr size_t WS_MP = 18 * MiB;
constexpr size_t WS_MERGED = 82 * MiB;
constexpr size_t WS_END = 416 * MiB;

typedef __bf16 bf16x2_t __attribute__((ext_vector_type(2)));
__device__ __forceinline__ unsigned cvt_pk_bf16(float lo, float hi) { const f32x2 v = {lo, hi}; const bf16x2_t b = __builtin_convertvector(v, bf16x2_t); return __builtin_bit_cast(unsigned, b); }
__device__ __forceinline__ float bf_lo(unsigned w) { return __uint_as_float(w << 16); }
__device__ __forceinline__ float bf_hi(unsigned w) { return __uint_as_float(w & 0xffff0000u); }
__device__ __forceinline__ u32x4 pack8(const float* v) { u32x4 w; w.x = cvt_pk_bf16(v[0], v[1]); w.y = cvt_pk_bf16(v[2], v[3]); w.z = cvt_pk_bf16(v[4], v[5]); w.w = cvt_pk_bf16(v[6], v[7]); return w; }
__device__ __forceinline__ void unpack8(u32x4 w, float* v) { v[0] = bf_lo(w.x); v[1] = bf_hi(w.x); v[2] = bf_lo(w.y); v[3] = bf_hi(w.y); v[4] = bf_lo(w.z); v[5] = bf_hi(w.z); v[6] = bf_lo(w.w); v[7] = bf_hi(w.w); }
__device__ __forceinline__ float fast_rcp(float x) { return __builtin_amdgcn_rcpf(x); }
__device__ __forceinline__ float fast_exp2(float x) { return __builtin_amdgcn_exp2f(x); }
__device__ __forceinline__ float act_gelu(float x) { const float u = x * (1.f + 0.044715f * x * x); return x * fast_rcp(1.f + fast_exp2(-2.3022081983f * u)); }
__device__ __forceinline__ float act_silu(float x) { return x * fast_rcp(1.f + fast_exp2(-LOG2E * x)); }
__device__ __forceinline__ float act_sigmoid(float x) { return fast_rcp(1.f + fast_exp2(-LOG2E * x)); }
__device__ __forceinline__ float wave_sum(float v) {
#pragma unroll
    for (int o = 1; o < 64; o <<= 1) v += __shfl_xor(v, o);
    return v;
}

namespace pg8 {
constexpr int BM = 256, BK = 64, HALF = 128, HTB = HALF * BK * 2, STAGE_BYTES = 8 * HTB;
__host__ __device__ __forceinline__ int lds_byte(int r, int c) { const int st = (r >> 4) * 2 + (c >> 5), rr = r & 15, cc = c & 31, ob = rr * 64 + cc * 2; return st * 1024 + (ob ^ (((ob >> 9) & 1) << 5)); }
__host__ __device__ __forceinline__ void stage_rc(int b, int& R, int& C) { const int st = b / 1024, sb = b % 1024, swz = sb ^ (((sb >> 9) & 1) << 5); R = (st >> 1) * 16 + swz / 64; C = (st & 1) * 32 + (swz % 64) / 2; }
__host__ __device__ __forceinline__ int perm32(int rho) { const int n = rho >> 4, i = rho & 15; return 8 * (i >> 2) + 4 * n + (i & 3); }

struct Unit { const char* A; const char* B; int pm, pn, mode; };

template <int K, class Sched, class Epi>
__device__ __forceinline__ void gemm_phase(LAS unsigned char* lds, const Sched& S, const Epi& E, const int tid) {
    const int wid = __builtin_amdgcn_readfirstlane(tid >> 6), lane = tid & 63, wr = wid >> 2, wc = wid & 3, fr = lane & 15, fq = lane >> 4;
    constexpr int nt = K / BK;
    unsigned voffA[2], voffB[2];
#pragma unroll
    for (int i = 0; i < 2; ++i) { int R, C; stage_rc(tid * 16 + i * 8192, R, C); const int Rb = (R & ~31) + perm32(R & 31);
        voffA[i] = (unsigned)(R * K + C) * 2u; voffB[i] = (unsigned)(Rb * K + C) * 2u; }
    constexpr size_t kstep = (size_t)(BK * 2);
    constexpr size_t hstep = (size_t)HALF * K * 2;
    const unsigned ldsw = (unsigned)wid * 1024u;
    const int aoff = lds_byte(wr * 64 + fr, fq * 8), boff = lds_byte(wc * 32 + fr, fq * 8);
#define PG8_SA(b, h) (((b) * 2 + (h)) * HTB)
#define PG8_SB(b, h) ((4 + (b) * 2 + (h)) * HTB)
#define PG8_STAGE(bufoff, gbase, voff) do { _Pragma("unroll") for (int _i = 0; _i < 2; ++_i) \
        __builtin_amdgcn_global_load_lds((const unsigned*)((const char*)(gbase) + (voff)[_i]), (LAS unsigned*)(lds + (bufoff) + ldsw + _i * 8192), 16, 0, 0); } while (0)
#define PG8_LDA(dst, b, h) do { _Pragma("unroll") for (int m = 0; m < 4; ++m) _Pragma("unroll") for (int k = 0; k < 2; ++k) dst[m][k] = *(const LAS bf16x8*)(lds + PG8_SA(b, h) + aoff + m * 2048 + k * 1024); } while (0)
#define PG8_LDB(dst, b, h) do { _Pragma("unroll") for (int n = 0; n < 2; ++n) _Pragma("unroll") for (int k = 0; k < 2; ++k) dst[n][k] = *(const LAS bf16x8*)(lds + PG8_SB(b, h) + boff + n * 2048 + k * 1024); } while (0)
#define PG8_MMA(ai, bj, At, Bt) do { __builtin_amdgcn_s_setprio(1); _Pragma("unroll") for (int m = 0; m < 4; ++m) _Pragma("unroll") for (int n = 0; n < 2; ++n) _Pragma("unroll") for (int k = 0; k < 2; ++k) \
        acc[ai][bj][m][n] = __builtin_amdgcn_mfma_f32_16x16x32_bf16(Bt[n][k], At[m][k], acc[ai][bj][m][n], 0, 0, 0); __builtin_amdgcn_s_setprio(0); } while (0)
#define PG8_WAIT_V(n) asm volatile("s_waitcnt vmcnt(" #n ")" ::: "memory")
#define PG8_WAIT_L(n) asm volatile("s_waitcnt lgkmcnt(" #n ")" ::: "memory")
#define PG8_BAR __builtin_amdgcn_s_barrier()
#define PG8_SCHED __builtin_amdgcn_sched_barrier(0)
    Unit cur, nxt; int ui = 0;
    if (!S.next(0, cur)) return;
    f32x4 acc[2][2][4][2];
#pragma unroll
    for (int a = 0; a < 2; ++a)
#pragma unroll
        for (int b = 0; b < 2; ++b)
#pragma unroll
            for (int m = 0; m < 4; ++m)
#pragma unroll
                for (int n = 0; n < 2; ++n) acc[a][b][m][n] = (f32x4){0.f, 0.f, 0.f, 0.f};
    bf16x8 At[4][2], B0[2][2], B1[2][2];
    const char* cA = cur.A; const char* cB = cur.B;
#define PG8_KT(t) ((size_t)((t) & (nt - 1)) * kstep)
    PG8_STAGE(PG8_SB(0, 0), cB + PG8_KT(0), voffB); PG8_STAGE(PG8_SB(0, 1), cB + hstep + PG8_KT(0), voffB); PG8_STAGE(PG8_SA(0, 0), cA + PG8_KT(0), voffA); PG8_STAGE(PG8_SA(0, 1), cA + hstep + PG8_KT(0), voffA);
    if (wr == 1) PG8_BAR;
    PG8_WAIT_V(2); PG8_BAR;
    PG8_STAGE(PG8_SB(1, 0), cB + PG8_KT(1), voffB); PG8_STAGE(PG8_SA(1, 0), cA + PG8_KT(1), voffA); PG8_STAGE(PG8_SB(1, 1), cB + hstep + PG8_KT(1), voffB);
    PG8_WAIT_V(6); PG8_BAR;
    for (;;) {
        const bool has_next = S.next(ui + 1, nxt);
        const char* nA = has_next ? nxt.A : cA; const char* nB = has_next ? nxt.B : cB;
        for (int t = 0; t < nt; t += 2) {
            const bool last = (t == nt - 2);
            const char* a1 = cA + PG8_KT(t + 1);
            const char* a2 = (last ? nA : cA) + PG8_KT(t + 2); const char* b2 = (last ? nB : cB) + PG8_KT(t + 2);
            const char* a3 = (last ? nA : cA) + PG8_KT(t + 3); const char* b3 = (last ? nB : cB) + PG8_KT(t + 3);
            PG8_LDB(B0, 0, 0); PG8_LDB(B1, 0, 1); PG8_SCHED; PG8_LDA(At, 0, 0); PG8_STAGE(PG8_SA(1, 1), a1 + hstep, voffA);
            PG8_WAIT_V(8); PG8_WAIT_L(0); PG8_BAR; PG8_MMA(0, 0, At, B0); PG8_MMA(0, 1, At, B1); PG8_BAR; PG8_SCHED;
            PG8_LDA(At, 0, 1); PG8_STAGE(PG8_SB(0, 0), b2, voffB); PG8_STAGE(PG8_SB(0, 1), b2 + hstep, voffB); PG8_STAGE(PG8_SA(0, 0), a2, voffA);
            PG8_WAIT_V(8); PG8_WAIT_L(0); PG8_BAR; PG8_MMA(1, 0, At, B0); PG8_MMA(1, 1, At, B1); PG8_BAR; PG8_SCHED;
            PG8_LDB(B0, 1, 0); PG8_LDB(B1, 1, 1); PG8_SCHED; PG8_LDA(At, 1, 0); PG8_STAGE(PG8_SA(0, 1), a2 + hstep, voffA);
            PG8_WAIT_V(8); PG8_WAIT_L(0); PG8_BAR; PG8_MMA(0, 0, At, B0); PG8_MMA(0, 1, At, B1); PG8_BAR; PG8_SCHED;
            PG8_LDA(At, 1, 1); PG8_STAGE(PG8_SB(1, 0), b3, voffB); PG8_STAGE(PG8_SB(1, 1), b3 + hstep, voffB); PG8_STAGE(PG8_SA(1, 0), a3, voffA);
            PG8_WAIT_V(8); PG8_WAIT_L(0); PG8_BAR; PG8_MMA(1, 0, At, B0); PG8_MMA(1, 1, At, B1); PG8_BAR; PG8_SCHED;
        }
        if (wr == 0) PG8_BAR;
        E(acc, cur, wr, wc, fr, fq);
        if (!has_next) break;
        if (!E.keep_acc(cur)) {
#pragma unroll
        for (int a = 0; a < 2; ++a)
#pragma unroll
            for (int b = 0; b < 2; ++b)
#pragma unroll
                for (int m = 0; m < 4; ++m)
#pragma unroll
                    for (int n = 0; n < 2; ++n) acc[a][b][m][n] = (f32x4){0.f, 0.f, 0.f, 0.f};
        }
        cur = nxt; cA = nA; cB = nB; ++ui;
        if (wr == 1) PG8_BAR;
    }
    PG8_WAIT_V(0);
    PG8_BAR;
#undef PG8_KT
#undef PG8_SA
#undef PG8_SB
#undef PG8_STAGE
#undef PG8_LDA
#undef PG8_LDB
#undef PG8_MMA
#undef PG8_WAIT_V
#undef PG8_WAIT_L
#undef PG8_BAR
#undef PG8_SCHED
}
}
using pg8::Unit;

#define EPI_LOOP_BEGIN \
    _Pragma("unroll") for (int ai = 0; ai < 2; ++ai) _Pragma("unroll") for (int m = 0; m < 4; ++m) { const int rt = ai * 128 + wr * 64 + m * 16 + fr; \
    _Pragma("unroll") for (int bj = 0; bj < 2; ++bj) { const int ct = bj * 128 + wc * 32 + 8 * fq; \
        float v[8] = {acc[ai][bj][m][0][0], acc[ai][bj][m][0][1], acc[ai][bj][m][0][2], acc[ai][bj][m][0][3], acc[ai][bj][m][1][0], acc[ai][bj][m][1][1], acc[ai][bj][m][1][2], acc[ai][bj][m][1][3]};
#define EPI_LOOP_END } }

enum { M_GELU = 0, M_GELU_STAT, M_SILU, M_RAW_SS, M_KROPE, M_QM, M_GATE, M_MEMK, M_MEMV,
       M_QUP, M_KVUP, M_MEMS,
       M_MULZ, M_BR0, M_BR1, M_BR2, M_OUT };

struct Ptrs {
    const float* in[20]; float* out; unsigned char* ws; int ph_lo, ph_hi; int use_cg, pad;
};

struct EpiP1 {
    __device__ __forceinline__ bool keep_acc(const Unit&) const { return false; }
    unsigned char* ws; unsigned char* dout; const float* bgate;
    __device__ __forceinline__ void operator()(f32x4 (&acc)[2][2][4][2], const Unit& u, int wr, int wc, int fr, int fq) const {
        const int mode = u.mode, pn = u.pn, row0 = u.pm * 256;
        if (mode == M_KROPE) {
            if (wc < 2) {
                const f32x2* CS = (const f32x2*)(ws + WS_CS); bf16_t* KR = (bf16_t*)(ws + WS_KR);
#pragma unroll
                for (int ai = 0; ai < 2; ++ai)
#pragma unroll
                    for (int m = 0; m < 4; ++m) { const int row = row0 + ai * 128 + wr * 64 + m * 16 + fr; const int i0 = (wc * 32 + 8 * fq) >> 1;
                        const f32x4 a = acc[ai][0][m][0], b = acc[ai][0][m][1]; const float t1[4] = {a[0], a[2], b[0], b[2]}, t2[4] = {a[1], a[3], b[1], b[3]};
                        float o1[4], o2[4];
#pragma unroll
                        for (int j = 0; j < 4; ++j) { const f32x2 cs = CS[row * 32 + i0 + j]; o1[j] = t1[j] * cs.x - t2[j] * cs.y; o2[j] = t2[j] * cs.x + t1[j] * cs.y; }
                        u32x2 w1, w2; w1.x = cvt_pk_bf16(o1[0], o1[1]); w1.y = cvt_pk_bf16(o1[2], o1[3]); w2.x = cvt_pk_bf16(o2[0], o2[1]); w2.y = cvt_pk_bf16(o2[2], o2[3]);
                        *(u32x2*)(KR + (size_t)row * 64 + i0) = w1; *(u32x2*)(KR + (size_t)row * 64 + 32 + i0) = w2; }
            }
            return;
        }
        bf16_t* dst; int ldc, cbase = 0; int act = 0;
        float scale = 1.f; int stat = 0; float* stp = nullptr; const float* bias = nullptr;
        if (mode == M_GELU)           { dst = (bf16_t*)(ws + WS_UG); ldc = D; cbase = pn * 256; act = 1; }
        else if (mode == M_GELU_STAT) { dst = (bf16_t*)(ws + WS_VG); ldc = D; cbase = (pn - 8) * 256; act = 1; stat = 2; stp = (float*)(ws + WS_VST) + (size_t)((pn - 8) * 4 + wc) * S * 2; }
        else if (mode == M_SILU)      { act = 2; ldc = D; if (pn < 24) { dst = (bf16_t*)(ws + WS_ZA); cbase = (pn - 16) * 256; } else if (pn < 37) { dst = (bf16_t*)dout; cbase = (pn - 29) * 256; } else { dst = (bf16_t*)dout + (size_t)S * D; cbase = (pn - 45) * 256; } }
        else if (mode == M_RAW_SS)    { ldc = 512; stat = 1; if (pn < 26) { dst = (bf16_t*)(ws + WS_CQ); cbase = (pn - 24) * 256; stp = (float*)(ws + WS_CQST) + (size_t)((pn - 24) * 4 + wc) * S; }
                                        else { dst = (bf16_t*)(ws + WS_CKV); cbase = (pn - 26) * 256; stp = (float*)(ws + WS_CKVST) + (size_t)((pn - 26) * 4 + wc) * S; } }
        else if (mode == M_QM)        { const int t = pn - 37; dst = (bf16_t*)(ws + WS_QMH) + (size_t)(t >> 1) * S * 512; ldc = 512; cbase = (t & 1) * 256; scale = MSCALE; }
        else if (mode == M_GATE)      { dst = (bf16_t*)(ws + WS_G); ldc = 3 * D; cbase = (pn - 53) * 256; act = 3; bias = bgate + cbase; }
        else if (mode == M_MEMK)      { dst = (bf16_t*)(ws + WS_KMH) + (size_t)(pn >> 1) * ML * 512; ldc = 512; cbase = (pn & 1) * 256; }
        else                          { dst = (bf16_t*)(ws + WS_VMT); ldc = ML; cbase = 0; }
#pragma unroll
        for (int ai = 0; ai < 2; ++ai)
#pragma unroll
            for (int m = 0; m < 4; ++m) { const int rt = ai * 128 + wr * 64 + m * 16 + fr; float s1 = 0.f, s2 = 0.f;
#pragma unroll
                for (int bj = 0; bj < 2; ++bj) { const int ct = bj * 128 + wc * 32 + 8 * fq;
                    float v[8] = {acc[ai][bj][m][0][0], acc[ai][bj][m][0][1], acc[ai][bj][m][0][2], acc[ai][bj][m][0][3], acc[ai][bj][m][1][0], acc[ai][bj][m][1][1], acc[ai][bj][m][1][2], acc[ai][bj][m][1][3]};
                    if (act == 1) {
#pragma unroll
                        for (int j = 0; j < 8; ++j) v[j] = act_gelu(v[j]);
                    } else if (act == 2) {
#pragma unroll
                        for (int j = 0; j < 8; ++j) v[j] = act_silu(v[j]);
                    } else if (act == 3) { const f32x4 b0 = *(const f32x4*)(bias + ct), b1 = *(const f32x4*)(bias + ct + 4);
#pragma unroll
                        for (int j = 0; j < 4; ++j) { v[j] = act_sigmoid(v[j] + b0[j]); v[4 + j] = act_sigmoid(v[4 + j] + b1[j]); }
                    } else {
#pragma unroll
                        for (int j = 0; j < 8; ++j) v[j] *= scale;
                    }
                    if (stat) {
#pragma unroll
                        for (int j = 0; j < 8; ++j) { s1 += v[j]; s2 += v[j] * v[j]; }
                    }
                    *(u32x4*)(dst + (size_t)(row0 + rt) * ldc + cbase + ct) = pack8(v);
                }
                if (stat) { s1 += __shfl_xor(s1, 16); s1 += __shfl_xor(s1, 32); s2 += __shfl_xor(s2, 16); s2 += __shfl_xor(s2, 32);
                    if (fq == 0) { if (stat == 2) *(f32x2*)(stp + (size_t)(row0 + rt) * 2) = (f32x2){s1, s2}; else stp[row0 + rt] = s2; } }
            }
    }
};

struct SchedP1 {
    const unsigned char* ws; int G, c;
    __device__ __forceinline__ bool next(int i, Unit& u) const {
        const int L = i * G + c; constexpr int NMAIN = 32 * NT_IN;
        if (L >= NMAIN + 16) return false;
        if (L < NMAIN) { const int wg = (L % 8) * (NMAIN / 8) + L / 8; constexpr int nig = 8 * NT_IN; const int gid = wg / nig, w = wg % nig; const int pm = gid * 8 + (w % 8), pn = w / 8;
            u.pm = pm; u.pn = pn; u.A = (const char*)(ws + WS_H) + (size_t)pm * 256 * D * 2; u.B = (const char*)(ws + WS_WIN) + (size_t)pn * 256 * D * 2;
            u.mode = pn < 8 ? M_GELU : pn < 16 ? M_GELU_STAT : pn < 24 ? M_SILU : pn < 28 ? M_RAW_SS : pn == 28 ? M_KROPE : pn < 37 ? M_SILU : pn < 45 ? M_QM : pn < 53 ? M_SILU : M_GATE; }
        else if (L < NMAIN + 8) { const int pn = L - NMAIN; u.pm = 0; u.pn = pn; u.A = (const char*)(ws + WS_MEMN); u.B = (const char*)(ws + WS_WMEM) + (size_t)pn * 256 * D * 2; u.mode = M_MEMK; }
        else { const int pm = L - NMAIN - 8; u.pm = pm; u.pn = 0; u.A = (const char*)(ws + WS_WMEM) + (size_t)(2048 + pm * 256) * D * 2; u.B = (const char*)(ws + WS_MEMN); u.mode = M_MEMV; }
        return true;
    }
};

struct EpiP2 {
    __device__ __forceinline__ bool keep_acc(const Unit&) const { return false; }
    unsigned char* ws; LAS float* xch;
    __device__ __forceinline__ void operator()(f32x4 (&acc)[2][2][4][2], const Unit& u, int wr, int wc, int fr, int fq) const {
        const int mode = u.mode, row0 = u.pm * 256;
        if (mode == M_MEMS) {
            LAS float* XM = xch; LAS float* XS = xch + 1024;
#pragma unroll
            for (int ai = 0; ai < 2; ++ai)
#pragma unroll
                for (int m = 0; m < 4; ++m) { float t = -1e30f;
#pragma unroll
                    for (int bj = 0; bj < 2; ++bj)
#pragma unroll
                        for (int n = 0; n < 2; ++n) { const f32x4 x = acc[ai][bj][m][n]; t = fmaxf(t, fmaxf(fmaxf(x[0], x[1]), fmaxf(x[2], x[3]))); }
                    t = fmaxf(t, __shfl_xor(t, 16)); t = fmaxf(t, __shfl_xor(t, 32));
                    if (fq == 0) XM[(ai * 128 + wr * 64 + m * 16 + fr) * 4 + wc] = t; }
            asm volatile("s_waitcnt lgkmcnt(0)" ::: "memory"); __builtin_amdgcn_s_barrier(); asm volatile("" ::: "memory");
#pragma unroll
            for (int ai = 0; ai < 2; ++ai)
#pragma unroll
                for (int m = 0; m < 4; ++m) { const int rt = ai * 128 + wr * 64 + m * 16 + fr; const f32x4 q = *(const LAS f32x4*)(XM + rt * 4);
                    const float mxr = fmaxf(fmaxf(q[0], q[1]), fmaxf(q[2], q[3])); float s = 0.f;
#pragma unroll
                    for (int bj = 0; bj < 2; ++bj)
#pragma unroll
                        for (int n = 0; n < 2; ++n)
#pragma unroll
                            for (int e = 0; e < 4; ++e) { const float x = fast_exp2(acc[ai][bj][m][n][e] - mxr); acc[ai][bj][m][n][e] = x; s += x; }
                    s += __shfl_xor(s, 16); s += __shfl_xor(s, 32);
                    if (fq == 0) XS[rt * 4 + wc] = s; }
            asm volatile("s_waitcnt lgkmcnt(0)" ::: "memory"); __builtin_amdgcn_s_barrier(); asm volatile("" ::: "memory");
            bf16_t* P = (bf16_t*)(ws + WS_P) + (size_t)u.pn * S * 256;
#pragma unroll
            for (int ai = 0; ai < 2; ++ai)
#pragma unroll
                for (int m = 0; m < 4; ++m) { const int rt = ai * 128 + wr * 64 + m * 16 + fr; const f32x4 q = *(const LAS f32x4*)(XS + rt * 4);
                    const float iv = fast_rcp((q[0] + q[1]) + (q[2] + q[3]));
#pragma unroll
                    for (int bj = 0; bj < 2; ++bj) { float v[8];
#pragma unroll
                        for (int j = 0; j < 8; ++j) v[j] = acc[ai][bj][m][j >> 2][j & 3] * iv;
                        *(u32x4*)(P + (size_t)(row0 + rt) * 256 + bj * 128 + wc * 32 + 8 * fq) = pack8(v); } }
            return;
        }
        const float* stp = (const float*)(ws + (mode == M_QUP ? WS_CQST : WS_CKVST));
        const f32x2* CS = (const f32x2*)(ws + WS_CS);
        LAS float* RS = xch + 2048 + 64;
        { const int t_ = ((wr * 4 + wc) * 4 + fq) * 16 + fr;
          if (t_ < 256) { float ss = 0.f;
#pragma unroll
              for (int j = 0; j < 8; ++j) ss += stp[(size_t)j * S + row0 + t_];
              RS[t_] = 1.0f / sqrtf(ss * (1.f / 512.f) + EPS); }
          asm volatile("s_waitcnt lgkmcnt(0)" ::: "memory"); __builtin_amdgcn_s_barrier(); asm volatile("" ::: "memory"); }
#pragma unroll
        for (int ai = 0; ai < 2; ++ai)
#pragma unroll
            for (int m = 0; m < 4; ++m) { const int row = row0 + ai * 128 + wr * 64 + m * 16 + fr;
                const float rs = RS[ai * 128 + wr * 64 + m * 16 + fr];
#pragma unroll
                for (int bj = 0; bj < 2; ++bj) { const int ct = bj * 128 + wc * 32 + 8 * fq;
                    float v[8] = {acc[ai][bj][m][0][0], acc[ai][bj][m][0][1], acc[ai][bj][m][0][2], acc[ai][bj][m][0][3], acc[ai][bj][m][1][0], acc[ai][bj][m][1][1], acc[ai][bj][m][1][2], acc[ai][bj][m][1][3]};
#pragma unroll
                    for (int j = 0; j < 8; ++j) v[j] *= rs;
                    if (mode == M_QUP) { const int cg = u.pn * 256 + ct, head = cg / DQK, w = cg - head * DQK;
                        bf16_t* q = (bf16_t*)(ws + WS_QB) + ((size_t)head * S + row) * DQK;
                        if (w < 128) *(u32x4*)(q + w) = pack8(v);
                        else { const int i0 = (w - 128) >> 1; float o1[4], o2[4];
#pragma unroll
                            for (int j = 0; j < 4; ++j) { const f32x2 cs = CS[row * 32 + i0 + j]; const float t1 = v[2 * j], t2 = v[2 * j + 1]; o1[j] = t1 * cs.x - t2 * cs.y; o2[j] = t2 * cs.x + t1 * cs.y; }
                            u32x2 w1, w2; w1.x = cvt_pk_bf16(o1[0], o1[1]); w1.y = cvt_pk_bf16(o1[2], o1[3]); w2.x = cvt_pk_bf16(o2[0], o2[1]); w2.y = cvt_pk_bf16(o2[2], o2[3]);
                            *(u32x2*)(q + 128 + i0) = w1; *(u32x2*)(q + 160 + i0) = w2; } }
                    else { const int head = u.pn;
                        if (bj == 0) *(u32x4*)((bf16_t*)(ws + WS_KB) + ((size_t)head * S + row) * DQK + wc * 32 + 8 * fq) = pack8(v);
                        else *(u32x4*)((bf16_t*)(ws + WS_VB) + ((size_t)head * S + row) * DV + wc * 32 + 8 * fq) = pack8(v); }
                }
                if (mode == M_KVUP && wc < 2) {
                    const u32x4 kr = *(const u32x4*)((const bf16_t*)(ws + WS_KR) + (size_t)row * 64 + (wc * 4 + fq) * 8);
                    *(u32x4*)((bf16_t*)(ws + WS_KB) + ((size_t)u.pn * S + row) * DQK + 128 + (wc * 4 + fq) * 8) = kr; }
            }
    }
};
struct SchedP2 {
    const unsigned char* ws; int G, c;
    __device__ __forceinline__ bool next(int i, Unit& u) const {
        if (i >= 4 || c >= 256) return false;
        const int x = c & 7, l = i * 32 + (c >> 3);
        if (l < 48) { const int pm = 4 * x + (l & 3), pn = l >> 2; u.pm = pm; u.pn = pn; u.mode = M_QUP; u.A = (const char*)(ws + WS_CQ) + (size_t)pm * 256 * 512 * 2; u.B = (const char*)(ws + WS_WUQ) + (size_t)pn * 256 * 512 * 2; }
        else if (l < 112) { const int l2 = l - 48, pm = 4 * x + (l2 & 3), pn = l2 >> 2; u.pm = pm; u.pn = pn; u.mode = M_KVUP; u.A = (const char*)(ws + WS_CKV) + (size_t)pm * 256 * 512 * 2; u.B = (const char*)(ws + WS_WUKV) + (size_t)pn * 256 * 512 * 2; }
        else { const int l2 = l - 112, pm = 4 * x + (l2 & 3), h = l2 >> 2; u.pm = pm; u.pn = h; u.mode = M_MEMS; u.A = (const char*)(ws + WS_QMH) + ((size_t)h * S + pm * 256) * 512 * 2; u.B = (const char*)(ws + WS_KMH) + (size_t)h * ML * 512 * 2; }
        return true;
    }
};

struct EpiMulZ {
    __device__ __forceinline__ bool keep_acc(const Unit&) const { return false; }
    unsigned char* dout;
    __device__ __forceinline__ void operator()(f32x4 (&acc)[2][2][4][2], const Unit& u, int wr, int wc, int fr, int fq) const {
        bf16_t* Z = (bf16_t*)dout + (size_t)S * D; const int row0 = u.pm * 256, cb = u.pn * 256;
        EPI_LOOP_BEGIN
            bf16_t* p = Z + (size_t)(row0 + rt) * D + cb + ct; float z[8]; unpack8(*(const u32x4*)p, z);
#pragma unroll
            for (int j = 0; j < 8; ++j) v[j] *= z[j];
            *(u32x4*)p = pack8(v);
        EPI_LOOP_END
    }
};
struct SchedP3b {
    const unsigned char* ws; int G, c;
    __device__ __forceinline__ bool next(int i, Unit& u) const {
        if (i >= 1 || c >= 256) return false;
        const int l = c >> 3, pm = 4 * (c & 7) + (l & 3), hn = l >> 2, h = hn >> 1; u.pm = pm; u.pn = hn; u.mode = M_MULZ;
        u.A = (const char*)(ws + WS_P) + ((size_t)h * S + pm * 256) * 256 * 2; u.B = (const char*)(ws + WS_VMT) + (size_t)hn * 256 * 256 * 2; return true;
    }
};

struct EpiP4 {
    unsigned char* ws;
    __device__ __forceinline__ bool keep_acc(const Unit& u) const { return u.mode != M_BR2; }
    __device__ __forceinline__ void operator()(f32x4 (&acc)[2][2][4][2], const Unit& u, int wr, int wc, int fr, int fq) const {
        const int n = u.mode - M_BR0, row0 = u.pm * 256, cb = u.pn * 256;
        const bf16_t* G = (const bf16_t*)(ws + WS_G) + (size_t)n * D; bf16_t* MG = (bf16_t*)(ws + WS_MERGED); constexpr float GMIN = 9.094947e-13f;
#pragma unroll
        for (int ai = 0; ai < 2; ++ai) {
            u32x4 ga[4][2], gb[4][2];
#pragma unroll
            for (int m = 0; m < 4; ++m)
#pragma unroll
                for (int bj = 0; bj < 2; ++bj) { const size_t r = (size_t)(row0 + ai * 128 + wr * 64 + m * 16 + fr); const bf16_t* gp = G + r * 3 * D + cb + bj * 128 + wc * 32 + 8 * fq;
                    ga[m][bj] = *(const u32x4*)gp; if (n < 2) gb[m][bj] = *(const u32x4*)(gp + D); }
#pragma unroll
            for (int m = 0; m < 4; ++m)
#pragma unroll
                for (int bj = 0; bj < 2; ++bj) { float g[8]; unpack8(ga[m][bj], g);
                    if (n < 2) { float gn[8]; unpack8(gb[m][bj], gn);
#pragma unroll
                        for (int j = 0; j < 8; ++j) acc[ai][bj][m][j >> 2][j & 3] *= fmaxf(g[j], GMIN) * fast_rcp(fmaxf(gn[j], GMIN)); }
                    else { float v[8]; const size_t r = (size_t)(row0 + ai * 128 + wr * 64 + m * 16 + fr);
#pragma unroll
                        for (int j = 0; j < 8; ++j) v[j] = acc[ai][bj][m][j >> 2][j & 3] * fmaxf(g[j], GMIN);
                        *(u32x4*)(MG + r * D + cb + bj * 128 + wc * 32 + 8 * fq) = pack8(v); } }
        }
    }
};
struct SchedP4 {
    const unsigned char* ws; const unsigned char* dout; int G, c;
    __device__ __forceinline__ bool next(int i, Unit& u) const {
        if (i >= 3 || c >= 256) return false;
        const int vc = (c % 8) * 32 + c / 8, pm = vc / 8, pn = vc % 8; u.pm = pm; u.pn = pn; u.mode = M_BR0 + i;
        const unsigned char* y = i == 0 ? ws + WS_UG : i == 1 ? dout : dout + (size_t)S * D * 2;
        u.A = (const char*)y + (size_t)pm * 256 * D * 2; u.B = (const char*)(ws + WS_WBR) + ((size_t)i * D + pn * 256) * D * 2; return true;
    }
};

struct EpiP5 {
    __device__ __forceinline__ bool keep_acc(const Unit&) const { return false; }
    unsigned char* ws; float* out;
    __device__ __forceinline__ void operator()(f32x4 (&acc)[2][2][4][2], const Unit& u, int wr, int wc, int fr, int fq) const {
        const int row0 = u.pm * 256, cb = u.pn * 256; float* st = (float*)(ws + WS_OST) + (size_t)(u.pn * 4 + wc) * S;
#pragma unroll
        for (int ai = 0; ai < 2; ++ai)
#pragma unroll
            for (int m = 0; m < 4; ++m) { const int rt = ai * 128 + wr * 64 + m * 16 + fr; float s2 = 0.f;
#pragma unroll
                for (int bj = 0; bj < 2; ++bj) { const int ct = bj * 128 + wc * 32 + 8 * fq; const f32x4 a = acc[ai][bj][m][0], b = acc[ai][bj][m][1];
                    s2 += (a[0] * a[0] + a[1] * a[1]) + (a[2] * a[2] + a[3] * a[3]) + (b[0] * b[0] + b[1] * b[1]) + (b[2] * b[2] + b[3] * b[3]);
                    const float v_[8] = {a[0], a[1], a[2], a[3], b[0], b[1], b[2], b[3]}; *(u32x4*)((bf16_t*)(ws + WS_MP) + (size_t)(row0 + rt) * D + cb + ct) = pack8(v_); }
                s2 += __shfl_xor(s2, 16); s2 += __shfl_xor(s2, 32);
                if (fq == 0) st[row0 + rt] = s2; }
    }
};
struct SchedP5 {
    const unsigned char* ws; int G, c;
    __device__ __forceinline__ bool next(int i, Unit& u) const {
        if (i >= 1 || c >= 256) return false;
        const int vc = (c % 8) * 32 + c / 8, pm = vc / 8, pn = vc % 8; u.pm = pm; u.pn = pn; u.mode = M_OUT;
        u.A = (const char*)(ws + WS_MERGED) + (size_t)pm * 256 * D * 2; u.B = (const char*)(ws + WS_WOUT) + (size_t)pn * 256 * D * 2; return true;
    }
};

enum { MAP_ID = 0, MAP_WIN, MAP_UQ };
__device__ __forceinline__ int map_row(int map, int n) {
    if (map == MAP_WIN) { if (n < 7168) return n; if (n < 7232) { const int i = n - 7168; return 7168 + (i < 32 ? 2 * i : 2 * (i - 32) + 1); } return n + 192; }
    if (map == MAP_UQ) { const int h = n / DQK, w = n - h * DQK; if (w < 128) return n; const int i = w - 128; return h * DQK + 128 + (i < 32 ? 2 * i : 2 * (i - 32) + 1); }
    return n;
}
struct WTile { const float* W; bf16_t* WT; const float* kgain; int K, N, row_off, map, k0, n0; float sc; };
struct WSeg { const float* W; bf16_t* WT; const float* kgain; int K, N, row_off, map; float sc; };
__device__ __forceinline__ WTile wtile_of(const WSeg& s, int r) { WTile t; t.W = s.W; t.WT = s.WT; t.kgain = s.kgain; t.K = s.K; t.N = s.N; t.row_off = s.row_off; t.map = s.map; t.sc = s.sc;
    const int nblk = s.N / 64; t.k0 = 64 * (r / nblk); t.n0 = 64 * (r % nblk); return t; }
__device__ __forceinline__ void wtile_issue(const WTile& t, f32x4 (&r)[16], int lane) {
    const float* p = t.W + (size_t)(t.k0 + (lane >> 4)) * t.N + t.n0 + 4 * (lane & 15);
#pragma unroll
    for (int q = 0; q < 16; ++q) r[q] = *(const f32x4*)(p + (size_t)(4 * q) * t.N);
}
__device__ __forceinline__ void wtile_finish(const WTile& t, const f32x4 (&r)[16], LAS float* scr, int lane) {
#pragma unroll
    for (int q = 0; q < 16; ++q) { const int k = 4 * q + (lane >> 4); f32x4 v = r[q] * t.sc; if (t.kgain) v = v * t.kgain[t.k0 + k];
        *(LAS f32x4*)(scr + k * 64 + ((4 * (lane & 15)) ^ (((k >> 3) & 7) << 3))) = v; }
    asm volatile("s_waitcnt lgkmcnt(0)" ::: "memory");
    const int c = lane & 7;
#pragma unroll
    for (int j = 0; j < 8; ++j) { const int n = (lane >> 3) + 8 * j; const LAS float* s = scr + (8 * c) * 64 + (n ^ (c << 3));
        u32x4 o; o.x = cvt_pk_bf16(s[0 * 64], s[1 * 64]); o.y = cvt_pk_bf16(s[2 * 64], s[3 * 64]); o.z = cvt_pk_bf16(s[4 * 64], s[5 * 64]); o.w = cvt_pk_bf16(s[6 * 64], s[7 * 64]);
        *(u32x4*)(t.WT + (size_t)(t.row_off + map_row(t.map, t.n0 + n)) * t.K + t.k0 + 8 * c) = o; }
    asm volatile("s_waitcnt lgkmcnt(0)" ::: "memory");
}
template <int NSEG> __device__ __forceinline__ WTile wtile_decode(const WSeg (&seg)[NSEG], int it) {
    int r = it;
#pragma unroll
    for (int s = 0; s < NSEG - 1; ++s) { const int cnt = (seg[s].K / 64) * (seg[s].N / 64); if (r < cnt) return wtile_of(seg[s], r); r -= cnt; }
    return wtile_of(seg[NSEG - 1], r);
}
template <int NSEG> __device__ __forceinline__ void wconv_run(const WSeg (&seg)[NSEG], int ntiles, int it0, int stride, LAS float* scr, int lane) {
    if (it0 >= ntiles) return;
    f32x4 ra[16], rb[16];
    WTile ta = wtile_decode(seg, it0), tb = ta; wtile_issue(ta, ra, lane);
    for (int it = it0; it < ntiles; it += 2 * stride) {
        const bool hb = it + stride < ntiles; if (hb) { tb = wtile_decode(seg, it + stride); wtile_issue(tb, rb, lane); }
        wtile_finish(ta, ra, scr, lane);
        if (!hb) break;
        const bool ha = it + 2 * stride < ntiles; if (ha) { ta = wtile_decode(seg, it + 2 * stride); wtile_issue(ta, ra, lane); }
        wtile_finish(tb, rb, scr, lane);
    }
}
__device__ __forceinline__ void rms_row_to_bf16(const float* xrow, const float* g, bf16_t* orow, int lane) {
    const f32x4* xr = (const f32x4*)xrow + lane; const f32x4* gr = (const f32x4*)g + lane;
    f32x4 v[8]; float s = 0.f;
#pragma unroll
    for (int j = 0; j < 8; ++j) { v[j] = xr[64 * j]; s += (v[j].x * v[j].x + v[j].y * v[j].y) + (v[j].z * v[j].z + v[j].w * v[j].w); }
    const float rs = 1.0f / sqrtf(wave_sum(s) * (1.f / D) + EPS);
    u32x2* o8 = (u32x2*)orow + lane;
#pragma unroll
    for (int j = 0; j < 8; ++j) { const f32x4 gg = gr[64 * j]; u32x2 w; w.x = cvt_pk_bf16(v[j].x * rs * gg.x, v[j].y * rs * gg.y); w.y = cvt_pk_bf16(v[j].z * rs * gg.z, v[j].w * rs * gg.w); o8[64 * j] = w; }
}
__device__ __forceinline__ void phase0(const Ptrs& P, LAS unsigned char* lds, int vcu, int G, int tid, int lane, int wave) {
    unsigned char* ws = P.ws;
    LAS float* scr = (LAS float*)(lds + wave * 16384);
    const int gw = vcu * NWAVES + wave, NGW = G * NWAVES;
    { const WSeg seg[5] = {
          {P.in[4], (bf16_t*)(ws + WS_WIN), nullptr, D, IN_TOTAL, 0, MAP_WIN, 1.f},
          {P.in[15], (bf16_t*)(ws + WS_WIN), nullptr, D, 6144, 53 * 256, MAP_ID, 1.f},
          {P.in[10], (bf16_t*)(ws + WS_WUQ), P.in[9], 512, 3072, 0, MAP_UQ, QSCALE},
          {P.in[12], (bf16_t*)(ws + WS_WUKV), P.in[11], 512, 4096, 0, MAP_ID, 1.f},
          {P.in[14], (bf16_t*)(ws + WS_WMEM), nullptr, D, 4096, 0, MAP_ID, 1.f}};
      constexpr int NT0 = 32 * (IN_TOTAL / 64) + 32 * 96 + 8 * 48 + 8 * 64 + 32 * 64;
      wconv_run(seg, NT0, gw, NGW, scr, lane); }
    { u32x4* z = (u32x4*)((bf16_t*)(ws + WS_WIN) + (size_t)7232 * D); const int n16 = 192 * D * 2 / 16;
      for (int i = vcu * NTHREADS + tid; i < n16; i += G * NTHREADS) z[i] = (u32x4){0u, 0u, 0u, 0u}; }
    const int gwr = gw >= 416 ? gw - 416 : gw + NGW - 416;
    for (int m = gwr; m < S + ML; m += NGW) {
        if (m < S) rms_row_to_bf16(P.in[0] + (size_t)m * D, P.in[3], (bf16_t*)(ws + WS_H) + (size_t)m * D, lane);
        else rms_row_to_bf16(P.in[1] + (size_t)(m - S) * D, P.in[13], (bf16_t*)(ws + WS_MEMN) + (size_t)(m - S) * D, lane);
    }
    { const int* pos = (const int*)P.in[2]; f32x2* CS = (f32x2*)(ws + WS_CS);
      for (int e = vcu * NTHREADS + tid; e < S * 32; e += G * NTHREADS) { const int row = e >> 5, i = e & 31;
          const double inv = exp2(-(double)i * (13.287712379549449 / 32.0));
          const float invf = (float)inv; const float angf = (float)pos[row] * invf;
          const double a = (double)angf; const double k = rint(a * 0.15915494309189535); const float r = (float)(a - k * 6.283185307179586);
          CS[e] = (f32x2){__cosf(r), __sinf(r)}; } }
    { const float* w = P.in[7]; bf16_t* o = (bf16_t*)(ws + WS_WSM);
      for (int e = vcu * NTHREADS + tid; e < 16 * 128 * 128 / 2; e += G * NTHREADS) { const int idx = e * 2, t = (idx >> 7) & 127, s = idx & 127;
          const float a = s <= t ? w[idx] : 0.f, b = (s + 1) <= t ? w[idx + 1] : 0.f; ((unsigned*)o)[e] = cvt_pk_bf16(a, b); } }
}
__device__ __forceinline__ void phase_wconv2(const Ptrs& P, LAS unsigned char* lds, int vcu, int G, int lane, int wave) {
    unsigned char* ws = P.ws; LAS float* scr = (LAS float*)(lds + wave * 16384);
    const int gw = vcu * NWAVES + wave, NGW = G * NWAVES;
    const WSeg seg[4] = {
        {P.in[17], (bf16_t*)(ws + WS_WBR), nullptr, D, D, 0, MAP_ID, 1.f},
        {P.in[17] + (size_t)D * D, (bf16_t*)(ws + WS_WBR), nullptr, D, D, D, MAP_ID, 1.f},
        {P.in[17] + (size_t)2 * D * D, (bf16_t*)(ws + WS_WBR), nullptr, D, D, 2 * D, MAP_ID, 1.f},
        {P.in[18], (bf16_t*)(ws + WS_WOUT), nullptr, D, D, 0, MAP_ID, 1.f}};
    wconv_run(seg, 4 * 32 * 32, gw, NGW, scr, lane);
}

namespace att {
constexpr int NW = 8, QBLK = 32, KVBLK = 64, QB = 256;
constexpr int SHM_V = KVBLK * DV * 2, SHM_K = KVBLK * DQK * 2;
constexpr float THR = 6.f;
#define SBAR() __builtin_amdgcn_sched_barrier(0)
#define KSWZ(row, colB) ((row) * 384 + ((colB) ^ ((((row) >> 1) & 7) << 4)))
__device__ __forceinline__ int v_st(int k, int c) { const int kk = (k & ~0xC) | ((k & 4) << 1) | ((k & 8) >> 1); return ((kk >> 3) * 4 + (c >> 5)) * 512 + ((kk & 7) * 32 + (c & 31)) * 2; }
__device__ __forceinline__ int v_rd_base(int lane) { return ((lane & 3) << 3) | (((lane >> 2) & 3) << 6) | (((lane >> 4) & 1) << 5) | (((lane >> 5) & 1) << 8); }
constexpr int v_rd_off(int d0, int ks, int half) { return d0 * 512 + ks * 4096 + half * 2048; }
__device__ __forceinline__ int crow(int r, int hi) { return (r & 3) + 8 * (r >> 2) + 4 * hi; }
__device__ __forceinline__ void mask_tile(f32x16& p0, f32x16& p1, int dq) {
    const float NEG = -__builtin_inff();
#pragma unroll
    for (int r = 0; r < 16; ++r) { const int c = (r & 3) + 8 * (r >> 2); if (dq - c < 0) p0[r] = NEG; if (dq - c - 32 < 0) p1[r] = NEG; }
}
__device__ __forceinline__ void partialSM(f32x16& p0, f32x16& p1, float& m_reg, float& mn, float& alpha) {
    float pmax = p0[0];
#pragma unroll
    for (int r = 1; r < 16; ++r) pmax = fmaxf(pmax, p0[r]);
#pragma unroll
    for (int r = 0; r < 16; ++r) pmax = fmaxf(pmax, p1[r]);
    { auto rr = __builtin_amdgcn_permlane32_swap(__float_as_uint(pmax), __float_as_uint(pmax), false, false); pmax = fmaxf(__uint_as_float(rr[0]), __uint_as_float(rr[1])); }
    if (__builtin_expect(__all((pmax - m_reg) <= THR), 1)) { mn = m_reg; alpha = 1.f; }
    else { mn = fmaxf(m_reg, pmax); alpha = fast_exp2(m_reg - mn); m_reg = mn; }
#pragma unroll
    for (int r = 0; r < 16; ++r) p0[r] = p0[r] - mn;
#pragma unroll
    for (int r = 0; r < 16; ++r) p1[r] = p1[r] - mn;
#pragma unroll
    for (int r = 0; r < 16; ++r) p0[r] = fast_exp2(p0[r]);
}
__device__ __forceinline__ void finishSM(f32x16& p0, f32x16& p1, float alpha, float& l_reg, bf16x8& pa0, bf16x8& pa1, bf16x8& pa2, bf16x8& pa3) {
#pragma unroll
    for (int r = 0; r < 16; ++r) p1[r] = fast_exp2(p1[r]);
    float ps = 0;
#pragma unroll
    for (int r = 0; r < 16; ++r) ps += p0[r];
#pragma unroll
    for (int r = 0; r < 16; ++r) ps += p1[r];
    { auto rr = __builtin_amdgcn_permlane32_swap(__float_as_uint(ps), __float_as_uint(ps), false, false); ps = __uint_as_float(rr[0]) + __uint_as_float(rr[1]); }
    l_reg = l_reg * alpha + ps;
#define PK4(P, B_, OUT) do { unsigned a0 = cvt_pk_bf16(P[B_+0], P[B_+1]), a1 = cvt_pk_bf16(P[B_+2], P[B_+3]); unsigned b0 = cvt_pk_bf16(P[B_+4], P[B_+5]), b1 = cvt_pk_bf16(P[B_+6], P[B_+7]); \
        auto r0 = __builtin_amdgcn_permlane32_swap(a0, b0, false, false); auto r1 = __builtin_amdgcn_permlane32_swap(a1, b1, false, false); \
        u32x4 w = {r0[0], r1[0], r0[1], r1[1]}; OUT = *reinterpret_cast<bf16x8*>(&w); } while (0)
    PK4(p0, 0, pa0); PK4(p0, 8, pa1); PK4(p1, 0, pa2); PK4(p1, 8, pa3);
#undef PK4
}
#define TRRD(dst, off) asm volatile("ds_read_b64_tr_b16 %0, %1 offset:%2" : "=&v"(dst) : "v"(vb0), "i"(off) : "memory")
#define PV_D0(OO, VBOFF, d0) do { s16x4 l0, l1, l2, l3, h0, h1, h2, h3; constexpr int b_ = (VBOFF) + v_rd_off(d0, 0, 0); \
        TRRD(l0, b_); TRRD(h0, b_ + 2048); TRRD(l1, b_ + 4096); TRRD(h1, b_ + 6144); TRRD(l2, b_ + 8192); TRRD(h2, b_ + 10240); TRRD(l3, b_ + 12288); TRRD(h3, b_ + 14336); \
        asm volatile("s_waitcnt lgkmcnt(0)" ::: "memory"); SBAR(); \
        OO = __builtin_amdgcn_mfma_f32_32x32x16_bf16(pa0, (bf16x8){l0[0], l0[1], l0[2], l0[3], h0[0], h0[1], h0[2], h0[3]}, OO, 0, 0, 0); \
        OO = __builtin_amdgcn_mfma_f32_32x32x16_bf16(pa1, (bf16x8){l1[0], l1[1], l1[2], l1[3], h1[0], h1[1], h1[2], h1[3]}, OO, 0, 0, 0); \
        OO = __builtin_amdgcn_mfma_f32_32x32x16_bf16(pa2, (bf16x8){l2[0], l2[1], l2[2], l2[3], h2[0], h2[1], h2[2], h2[3]}, OO, 0, 0, 0); \
        OO = __builtin_amdgcn_mfma_f32_32x32x16_bf16(pa3, (bf16x8){l3[0], l3[1], l3[2], l3[3], h3[0], h3[1], h3[2], h3[3]}, OO, 0, 0, 0); } while (0)
__device__ __forceinline__ void glds16(const void* gsrc, unsigned lds_dst) { unsigned keep;
    asm volatile("s_mov_b32 %0, m0\n\ts_mov_b32 m0, %2\n\ts_nop 0\n\tglobal_load_lds_dwordx4 %1, off\n\ts_mov_b32 m0, %0" : "=&s"(keep) : "v"(gsrc), "s"(lds_dst) : "memory"); }
typedef short v4i16_t __attribute__((ext_vector_type(4)));
__device__ __forceinline__ s16x4 vtr(const LAS char* p) { return __builtin_bit_cast(s16x4, __builtin_amdgcn_ds_read_tr16_b64_v4i16((LAS v4i16_t*)p)); }
__device__ __forceinline__ void pv_tile2(f32x16* o, const LAS char* vp, bf16x8 pa0, bf16x8 pa1, bf16x8 pa2, bf16x8 pa3) {
#pragma unroll
    for (int d0 = 0; d0 < 4; ++d0) {
        const s16x4 l0 = vtr(vp + d0 * 512), h0 = vtr(vp + d0 * 512 + 2048), l1 = vtr(vp + d0 * 512 + 4096), h1 = vtr(vp + d0 * 512 + 6144);
        const s16x4 l2 = vtr(vp + d0 * 512 + 8192), h2 = vtr(vp + d0 * 512 + 10240), l3 = vtr(vp + d0 * 512 + 12288), h3 = vtr(vp + d0 * 512 + 14336);
        o[d0] = __builtin_amdgcn_mfma_f32_32x32x16_bf16(pa0, (bf16x8){l0[0], l0[1], l0[2], l0[3], h0[0], h0[1], h0[2], h0[3]}, o[d0], 0, 0, 0);
        o[d0] = __builtin_amdgcn_mfma_f32_32x32x16_bf16(pa1, (bf16x8){l1[0], l1[1], l1[2], l1[3], h1[0], h1[1], h1[2], h1[3]}, o[d0], 0, 0, 0);
        o[d0] = __builtin_amdgcn_mfma_f32_32x32x16_bf16(pa2, (bf16x8){l2[0], l2[1], l2[2], l2[3], h2[0], h2[1], h2[2], h2[3]}, o[d0], 0, 0, 0);
        o[d0] = __builtin_amdgcn_mfma_f32_32x32x16_bf16(pa3, (bf16x8){l3[0], l3[1], l3[2], l3[3], h3[0], h3[1], h3[2], h3[3]}, o[d0], 0, 0, 0); }
}
constexpr int OFF3_V = 0, OFF3_K = 4 * SHM_V, OFF3_WS = OFF3_K + 3 * SHM_K + 256;
__device__ __forceinline__ void attn_block3(const bf16_t* Qh, const bf16_t* Kh, const bf16_t* Vh, bf16_t* ZY, int P0, char* lds, const int tid) {
    const int wid = __builtin_amdgcn_readfirstlane(tid >> 6), lane = tid & 63, r32 = lane & 31, hi = lane >> 5;
    const bool lag = wid >= 4;
    const int NT = (P0 + QB) / KVBLK;
    const int qlo = P0 + wid * QBLK, qm = qlo + r32 - 4 * hi;
    char* K_lds = lds + OFF3_K;
    float* wsf = (float*)(lds + OFF3_WS) + wid * 64; float* li_l = wsf, * al_l = wsf + 32;
    float m_reg = -1e30f, l_reg = 0; f32x16 o[4] = {};
    const unsigned lds0 = (unsigned)(uintptr_t)lds;
    int kso[3], vso[2];
#pragma unroll
    for (int j = 0; j < 3; ++j) { const int q = (wid * 3 + j) * 1024 + lane * 16, row = q / 384, pos = q - row * 384; kso[j] = row * 384 + (pos ^ (((row >> 1) & 7) << 4)); }
#pragma unroll
    for (int j = 0; j < 2; ++j) { const int q = (wid * 2 + j) * 1024 + lane * 16, sub = q >> 9, within = q & 511, kk = (sub >> 2) * 8 + (within >> 6), cc = (within & 63) >> 1;
        const int k = (kk & ~0xC) | ((kk & 4) << 1) | ((kk & 8) >> 1), c = (sub & 3) * 32 + cc; vso[j] = k * (DV * 2) + c * 2; }
    int kis = 0, vis = 0, kq = 0, vp = 0;
#define ROTK(x) ((x) == 2 * SHM_K ? 0 : (x) + SHM_K)
#define ROTV(x) ((x) == 3 * SHM_V ? 0 : (x) + SHM_V)
#define DMA_TILE(t) do { const char* kt_ = (const char*)Kh + (size_t)(t) * SHM_K; const char* vt_ = (const char*)Vh + (size_t)(t) * SHM_V; \
        _Pragma("unroll") for (int j_ = 0; j_ < 3; ++j_) glds16(kt_ + kso[j_], (unsigned)__builtin_amdgcn_readfirstlane(lds0 + OFF3_K + kis + (wid * 3 + j_) * 1024)); \
        _Pragma("unroll") for (int j_ = 0; j_ < 2; ++j_) glds16(vt_ + vso[j_], (unsigned)__builtin_amdgcn_readfirstlane(lds0 + OFF3_V + vis + (wid * 2 + j_) * 1024)); \
        kis = ROTK(kis); vis = ROTV(vis); } while (0)
#define END_M() asm volatile("s_waitcnt vmcnt(0) lgkmcnt(0)\n\ts_barrier" ::: "memory")
#define END_V() asm volatile("s_waitcnt lgkmcnt(0)\n\ts_barrier" ::: "memory")
    int ko[4];
#pragma unroll
    for (int dd = 0; dd < 4; ++dd) ko[dd] = KSWZ(r32, (dd * 16 + hi * 8) * 2);
    const LAS char* vbb = (const LAS char*)lds + OFF3_V + v_rd_base(lane);
    DMA_TILE(0); DMA_TILE(1);
    bf16x8 qr[12];
#pragma unroll
    for (int d0 = 0; d0 < 12; ++d0) qr[d0] = *reinterpret_cast<const bf16x8*>(Qh + (size_t)(P0 + wid * QBLK + r32) * DQK + d0 * 16 + hi * 8);
#define RESC(a) do { if (__any((a) < 1.f)) { if (hi == 0) al_l[r32] = (a); asm volatile("s_waitcnt lgkmcnt(0)" ::: "memory"); \
        _Pragma("unroll") for (int d_ = 0; d_ < 4; ++d_) _Pragma("unroll") for (int r = 0; r < 16; ++r) o[d_][r] *= al_l[crow(r, hi)]; } } while (0)
    f32x16 p0, p1; float mn, al; bf16x8 pa0, pa1, pa2, pa3;
    END_M();
    if (lag) END_V();
    for (int i = 0; i < NT; ++i) {
        const char* kb_ = K_lds + kq; bf16x8 ka[8], kb2[8];
#define KLOAD(dst, blk) do { _Pragma("unroll") for (int dd = 0; dd < 4; ++dd) { const char* a = kb_ + ko[dd] + (blk) * 128; dst[2 * dd] = *reinterpret_cast<const bf16x8*>(a); dst[2 * dd + 1] = *reinterpret_cast<const bf16x8*>(a + 32 * 384); } } while (0)
#define KMMA(srcf, blk) do { _Pragma("unroll") for (int dd = 0; dd < 4; ++dd) { p0 = __builtin_amdgcn_mfma_f32_32x32x16_bf16(srcf[2 * dd], qr[(blk) * 4 + dd], p0, 0, 0, 0); p1 = __builtin_amdgcn_mfma_f32_32x32x16_bf16(srcf[2 * dd + 1], qr[(blk) * 4 + dd], p1, 0, 0, 0); } } while (0)
        SBAR();
        { _Pragma("unroll") for (int dd = 0; dd < 2; ++dd) { const char* a = kb_ + ko[dd]; ka[2 * dd] = *reinterpret_cast<const bf16x8*>(a); ka[2 * dd + 1] = *reinterpret_cast<const bf16x8*>(a + 32 * 384); } }
        SBAR();
        if (i >= 1) { pv_tile2(o, vbb + vp, pa0, pa1, pa2, pa3); vp = ROTV(vp); }
        SBAR();
        { p0 = f32x16{}; p1 = f32x16{};
          { _Pragma("unroll") for (int dd = 2; dd < 4; ++dd) { const char* a = kb_ + ko[dd]; ka[2 * dd] = *reinterpret_cast<const bf16x8*>(a); ka[2 * dd + 1] = *reinterpret_cast<const bf16x8*>(a + 32 * 384); } }
          KLOAD(kb2, 1); SBAR(); KMMA(ka, 0); SBAR(); KLOAD(ka, 2); SBAR(); KMMA(kb2, 1); SBAR(); KMMA(ka, 2);
#undef KLOAD
#undef KMMA
          kq = ROTK(kq); }
        END_M();
        if (i + 2 < NT) DMA_TILE(i + 2);
        SBAR();
        { const int kb_ = i * KVBLK; if (kb_ + KVBLK - 1 > qlo) mask_tile(p0, p1, qm - kb_); }
        partialSM(p0, p1, m_reg, mn, al); RESC(al);
        finishSM(p0, p1, al, l_reg, pa0, pa1, pa2, pa3);
        END_V();
    }
    SBAR(); pv_tile2(o, vbb + vp, pa0, pa1, pa2, pa3);
    if (!lag) END_V();
    if (hi == 0) li_l[r32] = l_reg; asm volatile("s_waitcnt lgkmcnt(0)" ::: "memory");
    float rli[16];
#pragma unroll
    for (int r = 0; r < 16; ++r) rli[r] = fast_rcp(li_l[crow(r, hi)]);
    __syncthreads();
    bf16_t* stg = (bf16_t*)lds + wid * 4096;
#pragma unroll
    for (int r = 0; r < 16; ++r) { const int orow = crow(r, hi);
#pragma unroll
        for (int d0 = 0; d0 < 4; ++d0) { const float v = o[d0][r] * rli[r]; const float vn = __shfl_xor(v, 1);
            if ((r32 & 1) == 0) *(unsigned*)(stg + orow * 128 + d0 * 32 + r32) = cvt_pk_bf16(v, vn); } }
    asm volatile("s_waitcnt lgkmcnt(0)" ::: "memory");
    bf16_t* zy = ZY + (size_t)(P0 + wid * QBLK) * D;
#pragma unroll
    for (int i = 0; i < 8; ++i) { const int id = lane + 64 * i, row = id >> 4, ch = id & 15; float a[8], z[8];
        unpack8(*(const u32x4*)(stg + row * 128 + ch * 8), a); bf16_t* p = zy + (size_t)row * D + ch * 8; unpack8(*(const u32x4*)p, z);
#pragma unroll
        for (int j = 0; j < 8; ++j) a[j] *= z[j];
        *(u32x4*)p = pack8(a); }
    __syncthreads();
#undef ROTK
#undef ROTV
#undef DMA_TILE
#undef END_M
#undef END_V
#undef RESC
}

__device__ __forceinline__ void mixer_block(unsigned char* ws, const float* ln_g, const float* ln_b, const float* b_s, int chunk, int g, char* lds, const int tid) {
    const int wid = __builtin_amdgcn_readfirstlane(tid >> 6), lane = tid & 63, r32 = lane & 31, hi = lane >> 5;
    const int rb = wid & 3, dh = wid >> 2;
    const bf16_t* Vg = (const bf16_t*)(ws + WS_VG); const f32x2* VMR = (const f32x2*)(ws + WS_VMR);
    const int sr = tid >> 4, sc = (tid & 15) * 8; const int row0 = chunk * 128, col0 = g * 128;
    bf16_t* Ug = (bf16_t*)(ws + WS_UG); const bf16_t* Za = (const bf16_t*)(ws + WS_ZA);
    u32x4 vq[4]; f32x2 mrq[4]; u32x4 uq[4], zq[4]; float bsq[4];
#pragma unroll
    for (int q = 0; q < 4; ++q) { const int s = q * 32 + sr; vq[q] = *(const u32x4*)(Vg + (size_t)(row0 + s) * D + col0 + sc); mrq[q] = VMR[row0 + s]; }
#pragma unroll
    for (int i = 0; i < 4; ++i) { const int id = lane + 64 * i, tr = id >> 3, ch = id & 7, t = rb * 32 + tr; const size_t off = (size_t)(row0 + t) * D + col0 + dh * 64 + ch * 8;
        uq[i] = *(const u32x4*)(Ug + off); zq[i] = *(const u32x4*)(Za + off); bsq[i] = b_s[g * 128 + t]; }
    float lg[8], lb[8];
#pragma unroll
    for (int j = 0; j < 8; ++j) { lg[j] = ln_g[col0 + sc + j]; lb[j] = ln_b[col0 + sc + j]; }
#pragma unroll
    for (int q = 0; q < 4; ++q) { const int s = q * 32 + sr; const f32x2 mr = mrq[q]; float v[8];
        unpack8(vq[q], v);
#pragma unroll
        for (int j = 0; j < 8; ++j) v[j] = (v[j] - mr.x) * mr.y * lg[j] + lb[j];
        *(u32x4*)(lds + (q >> 1) * SHM_V + v_st((q & 1) * 32 + sr, sc)) = pack8(v); }
    const bf16_t* Wm = (const bf16_t*)(ws + WS_WSM) + ((size_t)g * 128 + rb * 32 + r32) * 128;
    bf16x8 wa[2][4];
#pragma unroll
    for (int kt = 0; kt < 2; ++kt)
#pragma unroll
        for (int ks = 0; ks < 4; ++ks) wa[kt][ks] = *(const bf16x8*)(Wm + kt * 64 + ks * 16 + hi * 8);
    __syncthreads();
    const int vb0 = (int)(uintptr_t)lds + v_rd_base(lane);
    f32x16 o0 = {}, o1 = {};
    if (dh == 0) {
        { bf16x8 pa0 = wa[0][0], pa1 = wa[0][1], pa2 = wa[0][2], pa3 = wa[0][3]; PV_D0(o0, 0, 0); PV_D0(o1, 0, 1); }
        if (rb >= 2) { bf16x8 pa0 = wa[1][0], pa1 = wa[1][1], pa2 = wa[1][2], pa3 = wa[1][3]; PV_D0(o0, SHM_V, 0); PV_D0(o1, SHM_V, 1); }
    } else {
        { bf16x8 pa0 = wa[0][0], pa1 = wa[0][1], pa2 = wa[0][2], pa3 = wa[0][3]; PV_D0(o0, 0, 2); PV_D0(o1, 0, 3); }
        if (rb >= 2) { bf16x8 pa0 = wa[1][0], pa1 = wa[1][1], pa2 = wa[1][2], pa3 = wa[1][3]; PV_D0(o0, SHM_V, 2); PV_D0(o1, SHM_V, 3); }
    }
    float* stg = (float*)(lds + 2 * SHM_V) + wid * 2048;
#pragma unroll
    for (int r = 0; r < 16; ++r) { const int tr = crow(r, hi); stg[tr * 64 + r32] = o0[r]; stg[tr * 64 + 32 + r32] = o1[r]; }
    asm volatile("s_waitcnt lgkmcnt(0)" ::: "memory");
#pragma unroll
    for (int i = 0; i < 4; ++i) { const int id = lane + 64 * i, tr = id >> 3, ch = id & 7, t = rb * 32 + tr; const float bs = bsq[i];
        const size_t off = (size_t)(row0 + t) * D + col0 + dh * 64 + ch * 8;
        const f32x4 s0 = *(const f32x4*)(stg + tr * 64 + ch * 8), s1 = *(const f32x4*)(stg + tr * 64 + ch * 8 + 4);
        float u[8], z[8], y[8]; unpack8(uq[i], u); unpack8(zq[i], z);
#pragma unroll
        for (int j = 0; j < 4; ++j) { y[j] = u[j] * (s0[j] + bs) * z[j]; y[4 + j] = u[4 + j] * (s1[j] + bs) * z[4 + j]; }
        *(u32x4*)(Ug + off) = pack8(y); }
    __syncthreads();
}
#undef SBAR
}


#define XB_TMO      128
#define XB_XCNT(j)  (256  + 64 * (j))
#define XB_XSUB(j)  (1280 + 64 * (j))
#define XB_XGEN(j)  (2304 + 64 * (j))
#define XB_TOP      3328
#define XB_TOPGEN   3392
#define XCD_BAR_WORDS 3456
#define XB_SPIN_CAP (1u << 22)
__device__ __forceinline__ unsigned xb_ld(unsigned* p)              { return __hip_atomic_load(p, __ATOMIC_RELAXED, __HIP_MEMORY_SCOPE_AGENT); }
__device__ __forceinline__ unsigned xb_add(unsigned* p, unsigned v) { return __hip_atomic_fetch_add(p, v, __ATOMIC_RELAXED, __HIP_MEMORY_SCOPE_AGENT); }
__device__ __forceinline__ unsigned xb_xcc_id() { return (unsigned)__builtin_amdgcn_s_getreg((3 << 11) | 20) & 0xFu; }
#define XB_SPIN(cond, bar) do { unsigned _sp = 0; while (cond) { __builtin_amdgcn_s_sleep(1); \
    if ((++_sp & 255u) == 0u) { if (xb_ld(&(bar)[XB_TMO])) break; if (_sp > XB_SPIN_CAP) { atomicAdd(&(bar)[XB_TMO], 1u); break; } } } } while (0)
__device__ __forceinline__ void xcd_barrier_complete(unsigned* bar, unsigned x, unsigned& nloc, unsigned& nx) {
    const unsigned G = gridDim.x;
    unsigned sum, cnt, mine, sp = 0u;
    for (;;) {
        sum = 0u; cnt = 0u; mine = 0u;
#pragma unroll
        for (unsigned j = 0; j < 16; ++j) { const unsigned c = xb_ld(&bar[XB_XCNT(j)]); sum += c; cnt += (c > 0u) ? 1u : 0u; mine = (j == x) ? c : mine; }
        if (sum == G) break;
        __builtin_amdgcn_s_sleep(1);
        if ((++sp & 255u) == 0u) { if (xb_ld(&bar[XB_TMO])) break; if (sp > XB_SPIN_CAP) { atomicAdd(&bar[XB_TMO], 1u); break; } }
    }
    nloc = mine > 0u ? mine : 1u; nx = cnt > 0u ? cnt : 1u;
}
__device__ __forceinline__ void xcd_barrier(unsigned* bar, volatile LAS unsigned* st, const int tid) {
    asm volatile("s_waitcnt vmcnt(0)" ::: "memory");
    __syncthreads();
    if (tid == 0) {
        const unsigned x = xb_xcc_id();
        __builtin_amdgcn_s_waitcnt(0);
        unsigned nloc = st[0], nx = st[1];
        if (nloc == 0u) { xcd_barrier_complete(bar, x, nloc, nx); st[0] = nloc; st[1] = nx; }
        const unsigned old = xb_add(&bar[XB_XSUB(x)], 1u);
        const unsigned gen = old / nloc;
        if (old + 1u == (gen + 1u) * nloc) {
            __builtin_amdgcn_fence(__ATOMIC_RELEASE, "agent");
            asm volatile("s_waitcnt vmcnt(0)" ::: "memory");
            const unsigned og = xb_add(&bar[XB_TOP], 1u);
            const unsigned tg = og / nx;
            if (og + 1u == (tg + 1u) * nx) xb_add(&bar[XB_TOPGEN], 1u);
            else XB_SPIN(xb_ld(&bar[XB_TOPGEN]) == tg, bar);
            __builtin_amdgcn_fence(__ATOMIC_ACQUIRE, "agent");
            xb_add(&bar[XB_XGEN(x)], 1u);
            asm volatile("s_waitcnt vmcnt(0)" ::: "memory");
        } else {
            XB_SPIN(xb_ld(&bar[XB_XGEN(x)]) == gen, bar);
            __builtin_amdgcn_fence(__ATOMIC_ACQUIRE, "agent");
            asm volatile("s_waitcnt vmcnt(0)" ::: "memory");
        }
    }
    __syncthreads();
}

typedef const __attribute__((address_space(4))) Ptrs* KargPtr;
#define PHASE_ENV() KargPtr kp_ = (KargPtr)__builtin_amdgcn_kernarg_segment_ptr(); asm volatile("" : "+s"(kp_)); \
    const int wave = wave0_; int lane = (int)__builtin_amdgcn_mbcnt_hi(~0u, __builtin_amdgcn_mbcnt_lo(~0u, 0u)); asm volatile("" : "+v"(lane)); const int tid = wave * 64 + lane; \
    int G = gridDim.x, c = blockIdx.x; asm volatile("" : "+s"(G), "+s"(c)); const int vcu = (G % 8 == 0) ? (c % 8) * (G / 8) + c / 8 : c; \
    unsigned char* ws = kp_->ws; unsigned char* dout = (unsigned char*)kp_->out; (void)lane; (void)wave; (void)vcu; (void)ws; (void)dout
__global__ void __launch_bounds__(NTHREADS, 2) hybrid_fwd(Ptrs Punused) {
    extern __shared__ __attribute__((aligned(16))) unsigned char lds_raw[];
    LAS unsigned char* lds = (LAS unsigned char*)lds_raw;
    const int wave0_ = __builtin_amdgcn_readfirstlane((int)threadIdx.x >> 6);
    int lo, hi; { KargPtr k0 = (KargPtr)__builtin_amdgcn_kernarg_segment_ptr(); lo = k0->ph_lo; hi = k0->ph_hi; }
#define IN(k) (lo <= (k) && (k) < hi)
#if MK_SINGLE
    volatile LAS unsigned* bst_ = (volatile LAS unsigned*)(lds + BARST_OFF);
    { if ((int)threadIdx.x == 0) { bst_[0] = 0u; bst_[1] = 0u; KargPtr k0 = (KargPtr)__builtin_amdgcn_kernarg_segment_ptr(); (void)xb_add(&((unsigned*)k0->ws)[XB_XCNT(xb_xcc_id())], 1u); } __syncthreads(); }
#define SEAM(k) do { if (IN(k) && IN((k) + 1)) { PHASE_ENV(); if (kp_->use_cg) cg::this_grid().sync(); else xcd_barrier((unsigned*)ws, bst_, tid); } } while (0)
#else
#define SEAM(k) do { } while (0)
#endif
    if (IN(0)) { PHASE_ENV(); Ptrs P; { const __attribute__((address_space(4))) unsigned long long* s_ = (const __attribute__((address_space(4))) unsigned long long*)kp_; unsigned long long* d_ = (unsigned long long*)&P; _Pragma("unroll") for (int i_ = 0; i_ < (int)(sizeof(Ptrs) / 8); ++i_) d_[i_] = s_[i_]; } phase0(P, lds, vcu, G, tid, lane, wave); }
    SEAM(0);
    if (IN(1)) { PHASE_ENV(); SchedP1 Sc{ws, G, c}; EpiP1 E{ws, dout, kp_->in[16]}; pg8::gemm_phase<2048>(lds, Sc, E, tid); }
    SEAM(1);
    if (IN(2)) { PHASE_ENV();
        { const f32x2* st = (const f32x2*)(ws + WS_VST); f32x2* mr = (f32x2*)(ws + WS_VMR);
          for (int row = c * 32 + (tid >> 4); row < S; row += G * 32) { const int sub = tid & 15;
              const f32x2 p0 = st[(size_t)sub * S + row], p1 = st[(size_t)(sub + 16) * S + row]; float s1 = p0.x + p1.x, s2 = p0.y + p1.y;
#pragma unroll
              for (int o = 1; o < 16; o <<= 1) { s1 += __shfl_xor(s1, o); s2 += __shfl_xor(s2, o); }
              const float mean = s1 * (1.f / D); const float var = fmaxf(s2 * (1.f / D) - mean * mean, 0.f); if (sub == 0) mr[row] = (f32x2){mean, 1.0f / sqrtf(var + EPS)}; } }
        SchedP2 Sc{ws, G, c}; EpiP2 E{ws, (LAS float*)(lds + XCH_OFF)}; pg8::gemm_phase<512>(lds, Sc, E, tid);
    }
    SEAM(2);
    if (IN(3)) {
        { PHASE_ENV(); if (vcu < 256) { const int h = vcu >> 4, x = vcu & 15;
            const bf16_t* Qh = (const bf16_t*)(ws + WS_QB) + (size_t)h * S * DQK; const bf16_t* Kh = (const bf16_t*)(ws + WS_KB) + (size_t)h * S * DQK; const bf16_t* Vh = (const bf16_t*)(ws + WS_VB) + (size_t)h * S * DV;
            bf16_t* ZY = (bf16_t*)dout + h * DV;
            att::attn_block3(Qh, Kh, Vh, ZY, (31 - x) * 256, (char*)lds_raw, tid); att::attn_block3(Qh, Kh, Vh, ZY, x * 256, (char*)lds_raw, tid); } }
        { PHASE_ENV(); SchedP3b Sc{ws, G, c}; EpiMulZ E{dout}; pg8::gemm_phase<256>(lds, Sc, E, tid); }
        { PHASE_ENV(); const float* lng = kp_->in[5]; const float* lnb = kp_->in[6]; const float* bs = kp_->in[8];
            for (int it = vcu; it < 1024; it += G) att::mixer_block(ws, lng, lnb, bs, it >> 4, it & 15, (char*)lds_raw, tid); }
        { PHASE_ENV(); Ptrs P; { const __attribute__((address_space(4))) unsigned long long* s_ = (const __attribute__((address_space(4))) unsigned long long*)kp_; unsigned long long* d_ = (unsigned long long*)&P; _Pragma("unroll") for (int i_ = 0; i_ < (int)(sizeof(Ptrs) / 8); ++i_) d_[i_] = s_[i_]; } phase_wconv2(P, lds, vcu, G, lane, wave); }
    }
    SEAM(3);
    if (IN(4)) { PHASE_ENV(); SchedP4 Sc{ws, dout, G, c}; EpiP4 E{ws}; pg8::gemm_phase<2048>(lds, Sc, E, tid); }
    SEAM(4);
    if (IN(5)) { PHASE_ENV(); SchedP5 Sc{ws, G, c}; EpiP5 E{ws, (float*)dout}; pg8::gemm_phase<2048>(lds, Sc, E, tid); }
    SEAM(5);
    if (IN(6)) { PHASE_ENV();
        const float* st = (const float*)(ws + WS_OST); const float* x = kp_->in[0]; const float* gp = kp_->in[19]; float* outp = (float*)dout;
        for (int row = vcu * NWAVES + wave; row < S; row += G * NWAVES) {
            float s = lane < 32 ? st[(size_t)lane * S + row] : 0.f; s = wave_sum(s);
            const float rs = 1.0f / sqrtf(s * (1.f / D) + EPS);
            const f32x4* xr = (const f32x4*)(x + (size_t)row * D); f32x4* orow = (f32x4*)(outp + (size_t)row * D); const f32x4* gr = (const f32x4*)gp; const u32x4* ob = (const u32x4*)((const bf16_t*)(ws + WS_MP) + (size_t)row * D);
#pragma unroll
            for (int j = 0; j < 4; ++j) { const int q = 64 * j + lane; float a[8]; unpack8(ob[q], a); const f32x4 x0 = xr[2 * q], x1 = xr[2 * q + 1], g0 = gr[2 * q], g1 = gr[2 * q + 1];
                orow[2 * q] = x0 + (f32x4){a[0], a[1], a[2], a[3]} * rs * g0; orow[2 * q + 1] = x1 + (f32x4){a[4], a[5], a[6], a[7]} * rs * g1; }
        }
    }
#undef IN
#undef SEAM
}

extern "C" void kernel_launch(void* const* d_in, const int* in_sizes, int n_in, void* d_out, int out_size, void* d_ws, size_t ws_size, hipStream_t stream) {
    static int grid = 0;
    if (grid == 0) {
        if (n_in != 20 || out_size != S * D || ws_size < WS_END) { fprintf(stderr, "kernel_launch: unexpected shapes (n_in %d out %d ws %zu)\n", n_in, out_size, ws_size); grid = -1; return; }
        int dev = 0, cus = 0, per_cu = 0;
        (void)hipGetDevice(&dev); (void)hipDeviceGetAttribute(&cus, hipDeviceAttributeMultiprocessorCount, dev);
        (void)hipFuncSetAttribute((const void*)hybrid_fwd, hipFuncAttributeMaxDynamicSharedMemorySize, LDS_BYTES);
        (void)hipOccupancyMaxActiveBlocksPerMultiprocessor(&per_cu, (const void*)hybrid_fwd, NTHREADS, LDS_BYTES);
        if (per_cu < 1) { fprintf(stderr, "kernel_launch: occupancy query reports %d blocks per CU\n", per_cu); }
        grid = cus;
        (void)hipGetLastError();
    }
    if (grid < 0) return;
    Ptrs p{};
    for (int i = 0; i < 20; ++i) p.in[i] = (const float*)d_in[i];
    p.out = (float*)d_out; p.ws = (unsigned char*)d_ws;
#if MK_SINGLE
    (void)hipMemsetAsync(d_ws, 0, CTL_ZERO_BYTES, stream);
    p.ph_lo = 0; p.ph_hi = 7;
    void* args[] = {&p};
    hipError_t e = hipLaunchCooperativeKernel((const void*)hybrid_fwd, dim3(grid), dim3(NTHREADS), args, LDS_BYTES, stream);
    if (e != hipSuccess) fprintf(stderr, "cooperative launch failed: %s (grid %d)\n", hipGetErrorString(e), grid);
#else
    for (int k = 0; k < 7; ++k) { p.ph_lo = k; p.ph_hi = k + 1; hipLaunchKernelGGL(hybrid_fwd, dim3(grid), dim3(NTHREADS), LDS_BYTES, stream, p); }
#endif
}
```

```cpp
#include <hip/hip_runtime.h>
#include <hip/hip_cooperative_groups.h>
#include <cstdio>
#include <cstdint>
namespace cg = cooperative_groups;

#ifndef MK_SINGLE
#define MK_SINGLE 1
#endif

#define LAS __attribute__((address_space(3)))
typedef unsigned short bf16_t;
typedef short bf16x8 __attribute__((ext_vector_type(8)));
typedef short s16x4 __attribute__((ext_vector_type(4)));
typedef float f32x4 __attribute__((ext_vector_type(4)));
typedef float f32x2 __attribute__((ext_vector_type(2)));
typedef float f32x16 __attribute__((ext_vector_type(16)));
typedef unsigned u32x4 __attribute__((ext_vector_type(4)));
typedef unsigned u32x2 __attribute__((ext_vector_type(2)));

constexpr int S = 8192, D = 2048, ML = 256, NH = 16, DQK = 192, DV = 128;
constexpr int IN_TOTAL = 13376, NT_IN = 77;
constexpr float EPS = 1e-6f, LOG2E = 1.4426950408889634f;
constexpr float QSCALE = 0.07216878364870322f * 1.4426950408889634f;
constexpr float MSCALE = 0.04419417382415922f * 1.4426950408889634f;
constexpr int NTHREADS = 512, NWAVES = 8;
constexpr int RING_BYTES = 131072, XCH_OFF = RING_BYTES, BARST_OFF = XCH_OFF + 8192, LDS_BYTES = 147456;
constexpr size_t CTL_ZERO_BYTES = 16384;

constexpr size_t MiB = 1u << 20;
constexpr size_t WS_CS = 1 * MiB;
constexpr size_t WS_VST = 3 * MiB;
constexpr size_t WS_CQST = 5 * MiB;
constexpr size_t WS_CKVST = 5 * MiB + 256 * 1024;
constexpr size_t WS_VMR = 5 * MiB + 512 * 1024;
constexpr size_t WS_OST = 6 * MiB;
constexpr size_t WS_WSM = 7 * MiB;
constexpr size_t WS_KR = 8 * MiB;
constexpr size_t WS_KMH = 9 * MiB;
constexpr size_t WS_VMT = 10 * MiB;
constexpr size_t WS_WUQ = 11 * MiB;
constexpr size_t WS_WUKV = 14 * MiB;
constexpr size_t WS_WIN = 18 * MiB;
constexpr size_t WS_WMEM = 95 * MiB;
constexpr size_t WS_H = 111 * MiB;
constexpr size_t WS_MEMN = 143 * MiB;
constexpr size_t WS_UG = 144 * MiB;
constexpr size_t WS_VG = 176 * MiB;
constexpr size_t WS_ZA = 208 * MiB;
constexpr size_t WS_CQ = 240 * MiB;
constexpr size_t WS_CKV = 248 * MiB;
constexpr size_t WS_QMH = 256 * MiB;
constexpr size_t WS_G = 288 * MiB;
constexpr size_t WS_VB = 384 * MiB;
constexpr size_t WS_QB = 18 * MiB;
constexpr size_t WS_KB = 66 * MiB;
constexpr size_t WS_P = 114 * MiB;
constexpr size_t WS_WBR = 240 * MiB;
constexpr size_t WS_WOUT = 264 * MiB;
constexpr size_t WS_MP = 18 * MiB;
constexpr size_t WS_MERGED = 82 * MiB;
constexpr size_t WS_END = 416 * MiB;

typedef __bf16 bf16x2_t __attribute__((ext_vector_type(2)));
__device__ __forceinline__ unsigned cvt_pk_bf16(float lo, float hi) { const f32x2 v = {lo, hi}; const bf16x2_t b = __builtin_convertvector(v, bf16x2_t); return __builtin_bit_cast(unsigned, b); }
__device__ __forceinline__ float bf_lo(unsigned w) { return __uint_as_float(w << 16); }
__device__ __forceinline__ float bf_hi(unsigned w) { return __uint_as_float(w & 0xffff0000u); }
__device__ __forceinline__ u32x4 pack8(const float* v) { u32x4 w; w.x = cvt_pk_bf16(v[0], v[1]); w.y = cvt_pk_bf16(v[2], v[3]); w.z = cvt_pk_bf16(v[4], v[5]); w.w = cvt_pk_bf16(v[6], v[7]); return w; }
__device__ __forceinline__ void unpack8(u32x4 w, float* v) { v[0] = bf_lo(w.x); v[1] = bf_hi(w.x); v[2] = bf_lo(w.y); v[3] = bf_hi(w.y); v[4] = bf_lo(w.z); v[5] = bf_hi(w.z); v[6] = bf_lo(w.w); v[7] = bf_hi(w.w); }
__device__ __forceinline__ float fast_rcp(float x) { return __builtin_amdgcn_rcpf(x); }
__device__ __forceinline__ float fast_exp2(float x) { return __builtin_amdgcn_exp2f(x); }
__device__ __forceinline__ float act_gelu(float x) { const float u = x * (1.f + 0.044715f * x * x); return x * fast_rcp(1.f + fast_exp2(-2.3022081983f * u)); }
__device__ __forceinline__ float act_silu(float x) { return x * fast_rcp(1.f + fast_exp2(-LOG2E * x)); }
__device__ __forceinline__ float act_sigmoid(float x) { return fast_rcp(1.f + fast_exp2(-LOG2E * x)); }
__device__ __forceinline__ float wave_sum(float v) {
#pragma unroll
    for (int o = 1; o < 64; o <<= 1) v += __shfl_xor(v, o);
    return v;
}

namespace pg8 {
constexpr int BM = 256, BK = 64, HALF = 128, HTB = HALF * BK * 2, STAGE_BYTES = 8 * HTB;
__host__ __device__ __forceinline__ int lds_byte(int r, int c) { const int st = (r >> 4) * 2 + (c >> 5), rr = r & 15, cc = c & 31, ob = rr * 64 + cc * 2; return st * 1024 + (ob ^ (((ob >> 9) & 1) << 5)); }
__host__ __device__ __forceinline__ void stage_rc(int b, int& R, int& C) { const int st = b / 1024, sb = b % 1024, swz = sb ^ (((sb >> 9) & 1) << 5); R = (st >> 1) * 16 + swz / 64; C = (st & 1) * 32 + (swz % 64) / 2; }
__host__ __device__ __forceinline__ int perm32(int rho) { const int n = rho >> 4, i = rho & 15; return 8 * (i >> 2) + 4 * n + (i & 3); }

struct Unit { const char* A; const char* B; int pm, pn, mode; };

template <int K, class Sched, class Epi>
__device__ __forceinline__ void gemm_phase(LAS unsigned char* lds, const Sched& S, const Epi& E, const int tid) {
    const int wid = __builtin_amdgcn_readfirstlane(tid >> 6), lane = tid & 63, wr = wid >> 2, wc = wid & 3, fr = lane & 15, fq = lane >> 4;
    constexpr int nt = K / BK;
    unsigned voffA[2], voffB[2];
#pragma unroll
    for (int i = 0; i < 2; ++i) { int R, C; stage_rc(tid * 16 + i * 8192, R, C); const int Rb = (R & ~31) + perm32(R & 31);
        voffA[i] = (unsigned)(R * K + C) * 2u; voffB[i] = (unsigned)(Rb * K + C) * 2u; }
    constexpr size_t kstep = (size_t)(BK * 2);
    constexpr size_t hstep = (size_t)HALF * K * 2;
    const unsigned ldsw = (unsigned)wid * 1024u;
    const int aoff = lds_byte(wr * 64 + fr, fq * 8), boff = lds_byte(wc * 32 + fr, fq * 8);
#define PG8_SA(b, h) (((b) * 2 + (h)) * HTB)
#define PG8_SB(b, h) ((4 + (b) * 2 + (h)) * HTB)
#define PG8_STAGE(bufoff, gbase, voff) do { _Pragma("unroll") for (int _i = 0; _i < 2; ++_i) \
        __builtin_amdgcn_global_load_lds((const unsigned*)((const char*)(gbase) + (voff)[_i]), (LAS unsigned*)(lds + (bufoff) + ldsw + _i * 8192), 16, 0, 0); } while (0)
#define PG8_LDA(dst, b, h) do { _Pragma("unroll") for (int m = 0; m < 4; ++m) _Pragma("unroll") for (int k = 0; k < 2; ++k) dst[m][k] = *(const LAS bf16x8*)(lds + PG8_SA(b, h) + aoff + m * 2048 + k * 1024); } while (0)
#define PG8_LDB(dst, b, h) do { _Pragma("unroll") for (int n = 0; n < 2; ++n) _Pragma("unroll") for (int k = 0; k < 2; ++k) dst[n][k] = *(const LAS bf16x8*)(lds + PG8_SB(b, h) + boff + n * 2048 + k * 1024); } while (0)
#define PG8_MMA(ai, bj, At, Bt) do { __builtin_amdgcn_s_setprio(1); _Pragma("unroll") for (int m = 0; m < 4; ++m) _Pragma("unroll") for (int n = 0; n < 2; ++n) _Pragma("unroll") for (int k = 0; k < 2; ++k) \
        acc[ai][bj][m][n] = __builtin_amdgcn_mfma_f32_16x16x32_bf16(Bt[n][k], At[m][k], acc[ai][bj][m][n], 0, 0, 0); __builtin_amdgcn_s_setprio(0); } while (0)
#define PG8_WAIT_V(n) asm volatile("s_waitcnt vmcnt(" #n ")" ::: "memory")
#define PG8_WAIT_L(n) asm volatile("s_waitcnt lgkmcnt(" #n ")" ::: "memory")
#define PG8_BAR __builtin_amdgcn_s_barrier()
#define PG8_SCHED __builtin_amdgcn_sched_barrier(0)
    Unit cur, nxt; int ui = 0;
    if (!S.next(0, cur)) return;
    f32x4 acc[2][2][4][2];
#pragma unroll
    for (int a = 0; a < 2; ++a)
#pragma unroll
        for (int b = 0; b < 2; ++b)
#pragma unroll
            for (int m = 0; m < 4; ++m)
#pragma unroll
                for (int n = 0; n < 2; ++n) acc[a][b][m][n] = (f32x4){0.f, 0.f, 0.f, 0.f};
    bf16x8 At[4][2], B0[2][2], B1[2][2];
    const char* cA = cur.A; const char* cB = cur.B;
#define PG8_KT(t) ((size_t)((t) & (nt - 1)) * kstep)
    PG8_STAGE(PG8_SB(0, 0), cB + PG8_KT(0), voffB); PG8_STAGE(PG8_SB(0, 1), cB + hstep + PG8_KT(0), voffB); PG8_STAGE(PG8_SA(0, 0), cA + PG8_KT(0), voffA); PG8_STAGE(PG8_SA(0, 1), cA + hstep + PG8_KT(0), voffA);
    if (wr == 1) PG8_BAR;
    PG8_WAIT_V(2); PG8_BAR;
    PG8_STAGE(PG8_SB(1, 0), cB + PG8_KT(1), voffB); PG8_STAGE(PG8_SA(1, 0), cA + PG8_KT(1), voffA); PG8_STAGE(PG8_SB(1, 1), cB + hstep + PG8_KT(1), voffB);
    PG8_WAIT_V(6); PG8_BAR;
    for (;;) {
        const bool has_next = S.next(ui + 1, nxt);
        const char* nA = has_next ? nxt.A : cA; const char* nB = has_next ? nxt.B : cB;
        for (int t = 0; t < nt; t += 2) {
            const bool last = (t == nt - 2);
            const char* a1 = cA + PG8_KT(t + 1);
            const char* a2 = (last ? nA : cA) + PG8_KT(t + 2); const char* b2 = (last ? nB : cB) + PG8_KT(t + 2);
            const char* a3 = (last ? nA : cA) + PG8_KT(t + 3); const char* b3 = (last ? nB : cB) + PG8_KT(t + 3);
            PG8_LDB(B0, 0, 0); PG8_LDB(B1, 0, 1); PG8_SCHED; PG8_LDA(At, 0, 0); PG8_STAGE(PG8_SA(1, 1), a1 + hstep, voffA);
            PG8_WAIT_V(8); PG8_WAIT_L(0); PG8_BAR; PG8_MMA(0, 0, At, B0); PG8_MMA(0, 1, At, B1); PG8_BAR; PG8_SCHED;
            PG8_LDA(At, 0, 1); PG8_STAGE(PG8_SB(0, 0), b2, voffB); PG8_STAGE(PG8_SB(0, 1), b2 + hstep, voffB); PG8_STAGE(PG8_SA(0, 0), a2, voffA);
            PG8_WAIT_V(8); PG8_WAIT_L(0); PG8_BAR; PG8_MMA(1, 0, At, B0); PG8_MMA(1, 1, At, B1); PG8_BAR; PG8_SCHED;
            PG8_LDB(B0, 1, 0); PG8_LDB(B1, 1, 1); PG8_SCHED; PG8_LDA(At, 1, 0); PG8_STAGE(PG8_SA(0, 1), a2 + hstep, voffA);
            PG8_WAIT_V(8); PG8_WAIT_L(0); PG8_BAR; PG8_MMA(0, 0, At, B0); PG8_MMA(0, 1, At, B1); PG8_BAR; PG8_SCHED;
            PG8_LDA(At, 1, 1); PG8_STAGE(PG8_SB(1, 0), b3, voffB); PG8_STAGE(PG8_SB(1, 1), b3 + hstep, voffB); PG8_STAGE(PG8_SA(1, 0), a3, voffA);
            PG8_WAIT_V(8); PG8_WAIT_L(0); PG8_BAR; PG8_MMA(1, 0, At, B0); PG8_MMA(1, 1, At, B1); PG8_BAR; PG8_SCHED;
        }
        if (wr == 0) PG8_BAR;
        E(acc, cur, wr, wc, fr, fq);
        if (!has_next) break;
        if (!E.keep_acc(cur)) {
#pragma unroll
        for (int a = 0; a < 2; ++a)
#pragma unroll
            for (int b = 0; b < 2; ++b)
#pragma unroll
                for (int m = 0; m < 4; ++m)
#pragma unroll
                    for (int n = 0; n < 2; ++n) acc[a][b][m][n] = (f32x4){0.f, 0.f, 0.f, 0.f};
        }
        cur = nxt; cA = nA; cB = nB; ++ui;
        if (wr == 1) PG8_BAR;
    }
    PG8_WAIT_V(0);
    PG8_BAR;
#undef PG8_KT
#undef PG8_SA
#undef PG8_SB
#undef PG8_STAGE
#undef PG8_LDA
#undef PG8_LDB
#undef PG8_MMA
#undef PG8_WAIT_V
#undef PG8_WAIT_L
#undef PG8_BAR
#undef PG8_SCHED
}
}
using pg8::Unit;

#define EPI_LOOP_BEGIN \
    _Pragma("unroll") for (int ai = 0; ai < 2; ++ai) _Pragma("unroll") for (int m = 0; m < 4; ++m) { const int rt = ai * 128 + wr * 64 + m * 16 + fr; \
    _Pragma("unroll") for (int bj = 0; bj < 2; ++bj) { const int ct = bj * 128 + wc * 32 + 8 * fq; \
        float v[8] = {acc[ai][bj][m][0][0], acc[ai][bj][m][0][1], acc[ai][bj][m][0][2], acc[ai][bj][m][0][3], acc[ai][bj][m][1][0], acc[ai][bj][m][1][1], acc[ai][bj][m][1][2], acc[ai][bj][m][1][3]};
#define EPI_LOOP_END } }

enum { M_GELU = 0, M_GELU_STAT, M_SILU, M_RAW_SS, M_KROPE, M_QM, M_GATE, M_MEMK, M_MEMV,
       M_QUP, M_KVUP, M_MEMS,
       M_MULZ, M_BR0, M_BR1, M_BR2, M_OUT };

struct Ptrs {
    const float* in[20]; float* out; unsigned char* ws; int ph_lo, ph_hi; int use_cg, pad;
};

struct EpiP1 {
    __device__ __forceinline__ bool keep_acc(const Unit&) const { return false; }
    unsigned char* ws; unsigned char* dout; const float* bgate;
    __device__ __forceinline__ void operator()(f32x4 (&acc)[2][2][4][2], const Unit& u, int wr, int wc, int fr, int fq) const {
        const int mode = u.mode, pn = u.pn, row0 = u.pm * 256;
        if (mode == M_KROPE) {
            if (wc < 2) {
                const f32x2* CS = (const f32x2*)(ws + WS_CS); bf16_t* KR = (bf16_t*)(ws + WS_KR);
#pragma unroll
                for (int ai = 0; ai < 2; ++ai)
#pragma unroll
                    for (int m = 0; m < 4; ++m) { const int row = row0 + ai * 128 + wr * 64 + m * 16 + fr; const int i0 = (wc * 32 + 8 * fq) >> 1;
                        const f32x4 a = acc[ai][0][m][0], b = acc[ai][0][m][1]; const float t1[4] = {a[0], a[2], b[0], b[2]}, t2[4] = {a[1], a[3], b[1], b[3]};
                        float o1[4], o2[4];
#pragma unroll
                        for (int j = 0; j < 4; ++j) { const f32x2 cs = CS[row * 32 + i0 + j]; o1[j] = t1[j] * cs.x - t2[j] * cs.y; o2[j] = t2[j] * cs.x + t1[j] * cs.y; }
                        u32x2 w1, w2; w1.x = cvt_pk_bf16(o1[0], o1[1]); w1.y = cvt_pk_bf16(o1[2], o1[3]); w2.x = cvt_pk_bf16(o2[0], o2[1]); w2.y = cvt_pk_bf16(o2[2], o2[3]);
                        *(u32x2*)(KR + (size_t)row * 64 + i0) = w1; *(u32x2*)(KR + (size_t)row * 64 + 32 + i0) = w2; }
            }
            return;
        }
        bf16_t* dst; int ldc, cbase = 0; int act = 0;
        float scale = 1.f; int stat = 0; float* stp = nullptr; const float* bias = nullptr;
        if (mode == M_GELU)           { dst = (bf16_t*)(ws + WS_UG); ldc = D; cbase = pn * 256; act = 1; }
        else if (mode == M_GELU_STAT) { dst = (bf16_t*)(ws + WS_VG); ldc = D; cbase = (pn - 8) * 256; act = 1; stat = 2; stp = (float*)(ws + WS_VST) + (size_t)((pn - 8) * 4 + wc) * S * 2; }
        else if (mode == M_SILU)      { act = 2; ldc = D; if (pn < 24) { dst = (bf16_t*)(ws + WS_ZA); cbase = (pn - 16) * 256; } else if (pn < 37) { dst = (bf16_t*)dout; cbase = (pn - 29) * 256; } else { dst = (bf16_t*)dout + (size_t)S * D; cbase = (pn - 45) * 256; } }
        else if (mode == M_RAW_SS)    { ldc = 512; stat = 1; if (pn < 26) { dst = (bf16_t*)(ws + WS_CQ); cbase = (pn - 24) * 256; stp = (float*)(ws + WS_CQST) + (size_t)((pn - 24) * 4 + wc) * S; }
                                        else { dst = (bf16_t*)(ws + WS_CKV); cbase = (pn - 26) * 256; stp = (float*)(ws + WS_CKVST) + (size_t)((pn - 26) * 4 + wc) * S; } }
        else if (mode == M_QM)        { const int t = pn - 37; dst = (bf16_t*)(ws + WS_QMH) + (size_t)(t >> 1) * S * 512; ldc = 512; cbase = (t & 1) * 256; scale = MSCALE; }
        else if (mode == M_GATE)      { dst = (bf16_t*)(ws + WS_G); ldc = 3 * D; cbase = (pn - 53) * 256; act = 3; bias = bgate + cbase; }
        else if (mode == M_MEMK)      { dst = (bf16_t*)(ws + WS_KMH) + (size_t)(pn >> 1) * ML * 512; ldc = 512; cbase = (pn & 1) * 256; }
        else                          { dst = (bf16_t*)(ws + WS_VMT); ldc = ML; cbase = 0; }
#pragma unroll
        for (int ai = 0; ai < 2; ++ai)
#pragma unroll
            for (int m = 0; m < 4; ++m) { const int rt = ai * 128 + wr * 64 + m * 16 + fr; float s1 = 0.f, s2 = 0.f;
#pragma unroll
                for (int bj = 0; bj < 2; ++bj) { const int ct = bj * 128 + wc * 32 + 8 * fq;
                    float v[8] = {acc[ai][bj][m][0][0], acc[ai][bj][m][0][1], acc[ai][bj][m][0][2], acc[ai][bj][m][0][3], acc[ai][bj][m][1][0], acc[ai][bj][m][1][1], acc[ai][bj][m][1][2], acc[ai][bj][m][1][3]};
                    if (act == 1) {
#pragma unroll
                        for (int j = 0; j < 8; ++j) v[j] = act_gelu(v[j]);
                    } else if (act == 2) {
#pragma unroll
                        for (int j = 0; j < 8; ++j) v[j] = act_silu(v[j]);
                    } else if (act == 3) { const f32x4 b0 = *(const f32x4*)(bias + ct), b1 = *(const f32x4*)(bias + ct + 4);
#pragma unroll
                        for (int j = 0; j < 4; ++j) { v[j] = act_sigmoid(v[j] + b0[j]); v[4 + j] = act_sigmoid(v[4 + j] + b1[j]); }
                    } else {
#pragma unroll
                        for (int j = 0; j < 8; ++j) v[j] *= scale;
                    }
                    if (stat) {
#pragma unroll
                        for (int j = 0; j < 8; ++j) { s1 += v[j]; s2 += v[j] * v[j]; }
                    }
                    *(u32x4*)(dst + (size_t)(row0 + rt) * ldc + cbase + ct) = pack8(v);
                }
                if (stat) { s1 += __shfl_xor(s1, 16); s1 += __shfl_xor(s1, 32); s2 += __shfl_xor(s2, 16); s2 += __shfl_xor(s2, 32);
                    if (fq == 0) { if (stat == 2) *(f32x2*)(stp + (size_t)(row0 + rt) * 2) = (f32x2){s1, s2}; else stp[row0 + rt] = s2; } }
            }
    }
};

struct SchedP1 {
    const unsigned char* ws; int G, c;
    __device__ __forceinline__ bool next(int i, Unit& u) const {
        const int L = i * G + c; constexpr int NMAIN = 32 * NT_IN;
        if (L >= NMAIN + 16) return false;
        if (L < NMAIN) { const int wg = (L % 8) * (NMAIN / 8) + L / 8; constexpr int nig = 8 * NT_IN; const int gid = wg / nig, w = wg % nig; const int pm = gid * 8 + (w % 8), pn = w / 8;
            u.pm = pm; u.pn = pn; u.A = (const char*)(ws + WS_H) + (size_t)pm * 256 * D * 2; u.B = (const char*)(ws + WS_WIN) + (size_t)pn * 256 * D * 2;
            u.mode = pn < 8 ? M_GELU : pn < 16 ? M_GELU_STAT : pn < 24 ? M_SILU : pn < 28 ? M_RAW_SS : pn == 28 ? M_KROPE : pn < 37 ? M_SILU : pn < 45 ? M_QM : pn < 53 ? M_SILU : M_GATE; }
        else if (L < NMAIN + 8) { const int pn = L - NMAIN; u.pm = 0; u.pn = pn; u.A = (const char*)(ws + WS_MEMN); u.B = (const char*)(ws + WS_WMEM) + (size_t)pn * 256 * D * 2; u.mode = M_MEMK; }
        else { const int pm = L - NMAIN - 8; u.pm = pm; u.pn = 0; u.A = (const char*)(ws + WS_WMEM) + (size_t)(2048 + pm * 256) * D * 2; u.B = (const char*)(ws + WS_MEMN); u.mode = M_MEMV; }
        return true;
    }
};

struct EpiP2 {
    __device__ __forceinline__ bool keep_acc(const Unit&) const { return false; }
    unsigned char* ws; LAS float* xch;
    __device__ __forceinline__ void operator()(f32x4 (&acc)[2][2][4][2], const Unit& u, int wr, int wc, int fr, int fq) const {
        const int mode = u.mode, row0 = u.pm * 256;
        if (mode == M_MEMS) {
            LAS float* XM = xch; LAS float* XS = xch + 1024;
#pragma unroll
            for (int ai = 0; ai < 2; ++ai)
#pragma unroll
                for (int m = 0; m < 4; ++m) { float t = -1e30f;
#pragma unroll
                    for (int bj = 0; bj < 2; ++bj)
#pragma unroll
                        for (int n = 0; n < 2; ++n) { const f32x4 x = acc[ai][bj][m][n]; t = fmaxf(t, fmaxf(fmaxf(x[0], x[1]), fmaxf(x[2], x[3]))); }
                    t = fmaxf(t, __shfl_xor(t, 16)); t = fmaxf(t, __shfl_xor(t, 32));
                    if (fq == 0) XM[(ai * 128 + wr * 64 + m * 16 + fr) * 4 + wc] = t; }
            asm volatile("s_waitcnt lgkmcnt(0)" ::: "memory"); __builtin_amdgcn_s_barrier(); asm volatile("" ::: "memory");
#pragma unroll
            for (int ai = 0; ai < 2; ++ai)
#pragma unroll
                for (int m = 0; m < 4; ++m) { const int rt = ai * 128 + wr * 64 + m * 16 + fr; const f32x4 q = *(const LAS f32x4*)(XM + rt * 4);
                    const float mxr = fmaxf(fmaxf(q[0], q[1]), fmaxf(q[2], q[3])); float s = 0.f;
#pragma unroll
                    for (int bj = 0; bj < 2; ++bj)
#pragma unroll
                        for (int n = 0; n < 2; ++n)
#pragma unroll
                            for (int e = 0; e < 4; ++e) { const float x = fast_exp2(acc[ai][bj][m][n][e] - mxr); acc[ai][bj][m][n][e] = x; s += x; }
                    s += __shfl_xor(s, 16); s += __shfl_xor(s, 32);
                    if (fq == 0) XS[rt * 4 + wc] = s; }
            asm volatile("s_waitcnt lgkmcnt(0)" ::: "memory"); __builtin_amdgcn_s_barrier(); asm volatile("" ::: "memory");
            bf16_t* P = (bf16_t*)(ws + WS_P) + (size_t)u.pn * S * 256;
#pragma unroll
            for (int ai = 0; ai < 2; ++ai)
#pragma unroll
                for (int m = 0; m < 4; ++m) { const int rt = ai * 128 + wr * 64 + m * 16 + fr; const f32x4 q = *(const LAS f32x4*)(XS + rt * 4);
                    const float iv = fast_rcp((q[0] + q[1]) + (q[2] + q[3]));
#pragma unroll
                    for (int bj = 0; bj < 2; ++bj) { float v[8];
#pragma unroll
                        for (int j = 0; j < 8; ++j) v[j] = acc[ai][bj][m][j >> 2][j & 3] * iv;
                        *(u32x4*)(P + (size_t)(row0 + rt) * 256 + bj * 128 + wc * 32 + 8 * fq) = pack8(v); } }
            return;
        }
        const float* stp = (const float*)(ws + (mode == M_QUP ? WS_CQST : WS_CKVST));
        const f32x2* CS = (const f32x2*)(ws + WS_CS);
        LAS float* RS = xch + 2048 + 64;
        { const int t_ = ((wr * 4 + wc) * 4 + fq) * 16 + fr;
          if (t_ < 256) { float ss = 0.f;
#pragma unroll
              for (int j = 0; j < 8; ++j) ss += stp[(size_t)j * S + row0 + t_];
              RS[t_] = 1.0f / sqrtf(ss * (1.f / 512.f) + EPS); }
          asm volatile("s_waitcnt lgkmcnt(0)" ::: "memory"); __builtin_amdgcn_s_barrier(); asm volatile("" ::: "memory"); }
#pragma unroll
        for (int ai = 0; ai < 2; ++ai)
#pragma unroll
            for (int m = 0; m < 4; ++m) { const int row = row0 + ai * 128 + wr * 64 + m * 16 + fr;
                const float rs = RS[ai * 128 + wr * 64 + m * 16 + fr];
#pragma unroll
                for (int bj = 0; bj < 2; ++bj) { const int ct = bj * 128 + wc * 32 + 8 * fq;
                    float v[8] = {acc[ai][bj][m][0][0], acc[ai][bj][m][0][1], acc[ai][bj][m][0][2], acc[ai][bj][m][0][3], acc[ai][bj][m][1][0], acc[ai][bj][m][1][1], acc[ai][bj][m][1][2], acc[ai][bj][m][1][3]};
#pragma unroll
                    for (int j = 0; j < 8; ++j) v[j] *= rs;
                    if (mode == M_QUP) { const int cg = u.pn * 256 + ct, head = cg / DQK, w = cg - head * DQK;
                        bf16_t* q = (bf16_t*)(ws + WS_QB) + ((size_t)head * S + row) * DQK;
                        if (w < 128) *(u32x4*)(q + w) = pack8(v);
                        else { const int i0 = (w - 128) >> 1; float o1[4], o2[4];
#pragma unroll
                            for (int j = 0; j < 4; ++j) { const f32x2 cs = CS[row * 32 + i0 + j]; const float t1 = v[2 * j], t2 = v[2 * j + 1]; o1[j] = t1 * cs.x - t2 * cs.y; o2[j] = t2 * cs.x + t1 * cs.y; }
                            u32x2 w1, w2; w1.x = cvt_pk_bf16(o1[0], o1[1]); w1.y = cvt_pk_bf16(o1[2], o1[3]); w2.x = cvt_pk_bf16(o2[0], o2[1]); w2.y = cvt_pk_bf16(o2[2], o2[3]);
                            *(u32x2*)(q + 128 + i0) = w1; *(u32x2*)(q + 160 + i0) = w2; } }
                    else { const int head = u.pn;
                        if (bj == 0) *(u32x4*)((bf16_t*)(ws + WS_KB) + ((size_t)head * S + row) * DQK + wc * 32 + 8 * fq) = pack8(v);
                        else *(u32x4*)((bf16_t*)(ws + WS_VB) + ((size_t)head * S + row) * DV + wc * 32 + 8 * fq) = pack8(v); }
                }
                if (mode == M_KVUP && wc < 2) {
                    const u32x4 kr = *(const u32x4*)((const bf16_t*)(ws + WS_KR) + (size_t)row * 64 + (wc * 4 + fq) * 8);
                    *(u32x4*)((bf16_t*)(ws + WS_KB) + ((size_t)u.pn * S + row) * DQK + 128 + (wc * 4 + fq) * 8) = kr; }
            }
    }
};
struct SchedP2 {
    const unsigned char* ws; int G, c;
    __device__ __forceinline__ bool next(int i, Unit& u) const {
        if (i >= 4 || c >= 256) return false;
        const int x = c & 7, l = i * 32 + (c >> 3);
        if (l < 48) { const int pm = 4 * x + (l & 3), pn = l >> 2; u.pm = pm; u.pn = pn; u.mode = M_QUP; u.A = (const char*)(ws + WS_CQ) + (size_t)pm * 256 * 512 * 2; u.B = (const char*)(ws + WS_WUQ) + (size_t)pn * 256 * 512 * 2; }
        else if (l < 112) { const int l2 = l - 48, pm = 4 * x + (l2 & 3), pn = l2 >> 2; u.pm = pm; u.pn = pn; u.mode = M_KVUP; u.A = (const char*)(ws + WS_CKV) + (size_t)pm * 256 * 512 * 2; u.B = (const char*)(ws + WS_WUKV) + (size_t)pn * 256 * 512 * 2; }
        else { const int l2 = l - 112, pm = 4 * x + (l2 & 3), h = l2 >> 2; u.pm = pm; u.pn = h; u.mode = M_MEMS; u.A = (const char*)(ws + WS_QMH) + ((size_t)h * S + pm * 256) * 512 * 2; u.B = (const char*)(ws + WS_KMH) + (size_t)h * ML * 512 * 2; }
        return true;
    }
};

struct EpiMulZ {
    __device__ __forceinline__ bool keep_acc(const Unit&) const { return false; }
    unsigned char* dout;
    __device__ __forceinline__ void operator()(f32x4 (&acc)[2][2][4][2], const Unit& u, int wr, int wc, int fr, int fq) const {
        bf16_t* Z = (bf16_t*)dout + (size_t)S * D; const int row0 = u.pm * 256, cb = u.pn * 256;
        EPI_LOOP_BEGIN
            bf16_t* p = Z + (size_t)(row0 + rt) * D + cb + ct; float z[8]; unpack8(*(const u32x4*)p, z);
#pragma unroll
            for (int j = 0; j < 8; ++j) v[j] *= z[j];
            *(u32x4*)p = pack8(v);
        EPI_LOOP_END
    }
};
struct SchedP3b {
    const unsigned char* ws; int G, c;
    __device__ __forceinline__ bool next(int i, Unit& u) const {
        if (i >= 1 || c >= 256) return false;
        const int l = c >> 3, pm = 4 * (c & 7) + (l & 3), hn = l >> 2, h = hn >> 1; u.pm = pm; u.pn = hn; u.mode = M_MULZ;
        u.A = (const char*)(ws + WS_P) + ((size_t)h * S + pm * 256) * 256 * 2; u.B = (const char*)(ws + WS_VMT) + (size_t)hn * 256 * 256 * 2; return true;
    }
};

struct EpiP4 {
    unsigned char* ws;
    __device__ __forceinline__ bool keep_acc(const Unit& u) const { return u.mode != M_BR2; }
    __device__ __forceinline__ void operator()(f32x4 (&acc)[2][2][4][2], const Unit& u, int wr, int wc, int fr, int fq) const {
        const int n = u.mode - M_BR0, row0 = u.pm * 256, cb = u.pn * 256;
        const bf16_t* G = (const bf16_t*)(ws + WS_G) + (size_t)n * D; bf16_t* MG = (bf16_t*)(ws + WS_MERGED); constexpr float GMIN = 9.094947e-13f;
#pragma unroll
        for (int ai = 0; ai < 2; ++ai) {
            u32x4 ga[4][2], gb[4][2];
#pragma unroll
            for (int m = 0; m < 4; ++m)
#pragma unroll
                for (int bj = 0; bj < 2; ++bj) { const size_t r = (size_t)(row0 + ai * 128 + wr * 64 + m * 16 + fr); const bf16_t* gp = G + r * 3 * D + cb + bj * 128 + wc * 32 + 8 * fq;
                    ga[m][bj] = *(const u32x4*)gp; if (n < 2) gb[m][bj] = *(const u32x4*)(gp + D); }
#pragma unroll
            for (int m = 0; m < 4; ++m)
#pragma unroll
                for (int bj = 0; bj < 2; ++bj) { float g[8]; unpack8(ga[m][bj], g);
                    if (n < 2) { float gn[8]; unpack8(gb[m][bj], gn);
#pragma unroll
                        for (int j = 0; j < 8; ++j) acc[ai][bj][m][j >> 2][j & 3] *= fmaxf(g[j], GMIN) * fast_rcp(fmaxf(gn[j], GMIN)); }
                    else { float v[8]; const size_t r = (size_t)(row0 + ai * 128 + wr * 64 + m * 16 + fr);
#pragma unroll
                        for (int j = 0; j < 8; ++j) v[j] = acc[ai][bj][m][j >> 2][j & 3] * fmaxf(g[j], GMIN);
                        *(u32x4*)(MG + r * D + cb + bj * 128 + wc * 32 + 8 * fq) = pack8(v); } }
        }
    }
};
struct SchedP4 {
    const unsigned char* ws; const unsigned char* dout; int G, c;
    __device__ __forceinline__ bool next(int i, Unit& u) const {
        if (i >= 3 || c >= 256) return false;
        const int vc = (c % 8) * 32 + c / 8, pm = vc / 8, pn = vc % 8; u.pm = pm; u.pn = pn; u.mode = M_BR0 + i;
        const unsigned char* y = i == 0 ? ws + WS_UG : i == 1 ? dout : dout + (size_t)S * D * 2;
        u.A = (const char*)y + (size_t)pm * 256 * D * 2; u.B = (const char*)(ws + WS_WBR) + ((size_t)i * D + pn * 256) * D * 2; return true;
    }
};

struct EpiP5 {
    __device__ __forceinline__ bool keep_acc(const Unit&) const { return false; }
    unsigned char* ws; float* out;
    __device__ __forceinline__ void operator()(f32x4 (&acc)[2][2][4][2], const Unit& u, int wr, int wc, int fr, int fq) const {
        const int row0 = u.pm * 256, cb = u.pn * 256; float* st = (float*)(ws + WS_OST) + (size_t)(u.pn * 4 + wc) * S;
#pragma unroll
        for (int ai = 0; ai < 2; ++ai)
#pragma unroll
            for (int m = 0; m < 4; ++m) { const int rt = ai * 128 + wr * 64 + m * 16 + fr; float s2 = 0.f;
#pragma unroll
                for (int bj = 0; bj < 2; ++bj) { const int ct = bj * 128 + wc * 32 + 8 * fq; const f32x4 a = acc[ai][bj][m][0], b = acc[ai][bj][m][1];
                    s2 += (a[0] * a[0] + a[1] * a[1]) + (a[2] * a[2] + a[3] * a[3]) + (b[0] * b[0] + b[1] * b[1]) + (b[2] * b[2] + b[3] * b[3]);
                    const float v_[8] = {a[0], a[1], a[2], a[3], b[0], b[1], b[2], b[3]}; *(u32x4*)((bf16_t*)(ws + WS_MP) + (size_t)(row0 + rt) * D + cb + ct) = pack8(v_); }
                s2 += __shfl_xor(s2, 16); s2 += __shfl_xor(s2, 32);
                if (fq == 0) st[row0 + rt] = s2; }
    }
};
struct SchedP5 {
    const unsigned char* ws; int G, c;
    __device__ __forceinline__ bool next(int i, Unit& u) const {
        if (i >= 1 || c >= 256) return false;
        const int vc = (c % 8) * 32 + c / 8, pm = vc / 8, pn = vc % 8; u.pm = pm; u.pn = pn; u.mode = M_OUT;
        u.A = (const char*)(ws + WS_MERGED) + (size_t)pm * 256 * D * 2; u.B = (const char*)(ws + WS_WOUT) + (size_t)pn * 256 * D * 2; return true;
    }
};

enum { MAP_ID = 0, MAP_WIN, MAP_UQ };
__device__ __forceinline__ int map_row(int map, int n) {
    if (map == MAP_WIN) { if (n < 7168) return n; if (n < 7232) { const int i = n - 7168; return 7168 + (i < 32 ? 2 * i : 2 * (i - 32) + 1); } return n + 192; }
    if (map == MAP_UQ) { const int h = n / DQK, w = n - h * DQK; if (w < 128) return n; const int i = w - 128; return h * DQK + 128 + (i < 32 ? 2 * i : 2 * (i - 32) + 1); }
    return n;
}
struct WTile { const float* W; bf16_t* WT; const float* kgain; int K, N, row_off, map, k0, n0; float sc; };
struct WSeg { const float* W; bf16_t* WT; const float* kgain; int K, N, row_off, map; float sc; };
__device__ __forceinline__ WTile wtile_of(const WSeg& s, int r) { WTile t; t.W = s.W; t.WT = s.WT; t.kgain = s.kgain; t.K = s.K; t.N = s.N; t.row_off = s.row_off; t.map = s.map; t.sc = s.sc;
    const int nblk = s.N / 64; t.k0 = 64 * (r / nblk); t.n0 = 64 * (r % nblk); return t; }
__device__ __forceinline__ void wtile_issue(const WTile& t, f32x4 (&r)[16], int lane) {
    const float* p = t.W + (size_t)(t.k0 + (lane >> 4)) * t.N + t.n0 + 4 * (lane & 15);
#pragma unroll
    for (int q = 0; q < 16; ++q) r[q] = *(const f32x4*)(p + (size_t)(4 * q) * t.N);
}
__device__ __forceinline__ void wtile_finish(const WTile& t, const f32x4 (&r)[16], LAS float* scr, int lane) {
#pragma unroll
    for (int q = 0; q < 16; ++q) { const int k = 4 * q + (lane >> 4); f32x4 v = r[q] * t.sc; if (t.kgain) v = v * t.kgain[t.k0 + k];
        *(LAS f32x4*)(scr + k * 64 + ((4 * (lane & 15)) ^ (((k >> 3) & 7) << 3))) = v; }
    asm volatile("s_waitcnt lgkmcnt(0)" ::: "memory");
    const int c = lane & 7;
#pragma unroll
    for (int j = 0; j < 8; ++j) { const int n = (lane >> 3) + 8 * j; const LAS float* s = scr + (8 * c) * 64 + (n ^ (c << 3));
        u32x4 o; o.x = cvt_pk_bf16(s[0 * 64], s[1 * 64]); o.y = cvt_pk_bf16(s[2 * 64], s[3 * 64]); o.z = cvt_pk_bf16(s[4 * 64], s[5 * 64]); o.w = cvt_pk_bf16(s[6 * 64], s[7 * 64]);
        *(u32x4*)(t.WT + (size_t)(t.row_off + map_row(t.map, t.n0 + n)) * t.K + t.k0 + 8 * c) = o; }
    asm volatile("s_waitcnt lgkmcnt(0)" ::: "memory");
}
template <int NSEG> __device__ __forceinline__ WTile wtile_decode(const WSeg (&seg)[NSEG], int it) {
    int r = it;
#pragma unroll
    for (int s = 0; s < NSEG - 1; ++s) { const int cnt = (seg[s].K / 64) * (seg[s].N / 64); if (r < cnt) return wtile_of(seg[s], r); r -= cnt; }
    return wtile_of(seg[NSEG - 1], r);
}
template <int NSEG> __device__ __forceinline__ void wconv_run(const WSeg (&seg)[NSEG], int ntiles, int it0, int stride, LAS float* scr, int lane) {
    if (it0 >= ntiles) return;
    f32x4 ra[16], rb[16];
    WTile ta = wtile_decode(seg, it0), tb = ta; wtile_issue(ta, ra, lane);
    for (int it = it0; it < ntiles; it += 2 * stride) {
        const bool hb = it + stride < ntiles; if (hb) { tb = wtile_decode(seg, it + stride); wtile_issue(tb, rb, lane); }
        wtile_finish(ta, ra, scr, lane);
        if (!hb) break;
        const bool ha = it + 2 * stride < ntiles; if (ha) { ta = wtile_decode(seg, it + 2 * stride); wtile_issue(ta, ra, lane); }
        wtile_finish(tb, rb, scr, lane);
    }
}
__device__ __forceinline__ void rms_row_to_bf16(const float* xrow, const float* g, bf16_t* orow, int lane) {
    const f32x4* xr = (const f32x4*)xrow + lane; const f32x4* gr = (const f32x4*)g + lane;
    f32x4 v[8]; float s = 0.f;
#pragma unroll
    for (int j = 0; j < 8; ++j) { v[j] = xr[64 * j]; s += (v[j].x * v[j].x + v[j].y * v[j].y) + (v[j].z * v[j].z + v[j].w * v[j].w); }
    const float rs = 1.0f / sqrtf(wave_sum(s) * (1.f / D) + EPS);
    u32x2* o8 = (u32x2*)orow + lane;
#pragma unroll
    for (int j = 0; j < 8; ++j) { const f32x4 gg = gr[64 * j]; u32x2 w; w.x = cvt_pk_bf16(v[j].x * rs * gg.x, v[j].y * rs * gg.y); w.y = cvt_pk_bf16(v[j].z * rs * gg.z, v[j].w * rs * gg.w); o8[64 * j] = w; }
}
__device__ __forceinline__ void phase0(const Ptrs& P, LAS unsigned char* lds, int vcu, int G, int tid, int lane, int wave) {
    unsigned char* ws = P.ws;
    LAS float* scr = (LAS float*)(lds + wave * 16384);
    const int gw = vcu * NWAVES + wave, NGW = G * NWAVES;
    { const WSeg seg[5] = {
          {P.in[4], (bf16_t*)(ws + WS_WIN), nullptr, D, IN_TOTAL, 0, MAP_WIN, 1.f},
          {P.in[15], (bf16_t*)(ws + WS_WIN), nullptr, D, 6144, 53 * 256, MAP_ID, 1.f},
          {P.in[10], (bf16_t*)(ws + WS_WUQ), P.in[9], 512, 3072, 0, MAP_UQ, QSCALE},
          {P.in[12], (bf16_t*)(ws + WS_WUKV), P.in[11], 512, 4096, 0, MAP_ID, 1.f},
          {P.in[14], (bf16_t*)(ws + WS_WMEM), nullptr, D, 4096, 0, MAP_ID, 1.f}};
      constexpr int NT0 = 32 * (IN_TOTAL / 64) + 32 * 96 + 8 * 48 + 8 * 64 + 32 * 64;
      wconv_run(seg, NT0, gw, NGW, scr, lane); }
    { u32x4* z = (u32x4*)((bf16_t*)(ws + WS_WIN) + (size_t)7232 * D); const int n16 = 192 * D * 2 / 16;
      for (int i = vcu * NTHREADS + tid; i < n16; i += G * NTHREADS) z[i] = (u32x4){0u, 0u, 0u, 0u}; }
    const int gwr = gw >= 416 ? gw - 416 : gw + NGW - 416;
    for (int m = gwr; m < S + ML; m += NGW) {
        if (m < S) rms_row_to_bf16(P.in[0] + (size_t)m * D, P.in[3], (bf16_t*)(ws + WS_H) + (size_t)m * D, lane);
        else rms_row_to_bf16(P.in[1] + (size_t)(m - S) * D, P.in[13], (bf16_t*)(ws + WS_MEMN) + (size_t)(m - S) * D, lane);
    }
    { const int* pos = (const int*)P.in[2]; f32x2* CS = (f32x2*)(ws + WS_CS);
      for (int e = vcu * NTHREADS + tid; e < S * 32; e += G * NTHREADS) { const int row = e >> 5, i = e & 31;
          const double inv = exp2(-(double)i * (13.287712379549449 / 32.0));
          const float invf = (float)inv; const float angf = (float)pos[row] * invf;
          const double a = (double)angf; const double k = rint(a * 0.15915494309189535); const float r = (float)(a - k * 6.283185307179586);
          CS[e] = (f32x2){__cosf(r), __sinf(r)}; } }
    { const float* w = P.in[7]; bf16_t* o = (bf16_t*)(ws + WS_WSM);
      for (int e = vcu * NTHREADS + tid; e < 16 * 128 * 128 / 2; e += G * NTHREADS) { const int idx = e * 2, t = (idx >> 7) & 127, s = idx & 127;
          const float a = s <= t ? w[idx] : 0.f, b = (s + 1) <= t ? w[idx + 1] : 0.f; ((unsigned*)o)[e] = cvt_pk_bf16(a, b); } }
}
__device__ __forceinline__ void phase_wconv2(const Ptrs& P, LAS unsigned char* lds, int vcu, int G, int lane, int wave) {
    unsigned char* ws = P.ws; LAS float* scr = (LAS float*)(lds + wave * 16384);
    const int gw = vcu * NWAVES + wave, NGW = G * NWAVES;
    const WSeg seg[4] = {
        {P.in[17], (bf16_t*)(ws + WS_WBR), nullptr, D, D, 0, MAP_ID, 1.f},
        {P.in[17] + (size_t)D * D, (bf16_t*)(ws + WS_WBR), nullptr, D, D, D, MAP_ID, 1.f},
        {P.in[17] + (size_t)2 * D * D, (bf16_t*)(ws + WS_WBR), nullptr, D, D, 2 * D, MAP_ID, 1.f},
        {P.in[18], (bf16_t*)(ws + WS_WOUT), nullptr, D, D, 0, MAP_ID, 1.f}};
    wconv_run(seg, 4 * 32 * 32, gw, NGW, scr, lane);
}

namespace att {
constexpr int NW = 8, QBLK = 32, KVBLK = 64, QB = 256;
constexpr int SHM_V = KVBLK * DV * 2, SHM_K = KVBLK * DQK * 2;
constexpr float THR = 6.f;
#define SBAR() __builtin_amdgcn_sched_barrier(0)
#define KSWZ(row, colB) ((row) * 384 + ((colB) ^ ((((row) >> 1) & 7) << 4)))
__device__ __forceinline__ int v_st(int k, int c) { const int kk = (k & ~0xC) | ((k & 4) << 1) | ((k & 8) >> 1); return ((kk >> 3) * 4 + (c >> 5)) * 512 + ((kk & 7) * 32 + (c & 31)) * 2; }
__device__ __forceinline__ int v_rd_base(int lane) { return ((lane & 3) << 3) | (((lane >> 2) & 3) << 6) | (((lane >> 4) & 1) << 5) | (((lane >> 5) & 1) << 8); }
constexpr int v_rd_off(int d0, int ks, int half) { return d0 * 512 + ks * 4096 + half * 2048; }
__device__ __forceinline__ int crow(int r, int hi) { return (r & 3) + 8 * (r >> 2) + 4 * hi; }
__device__ __forceinline__ void mask_tile(f32x16& p0, f32x16& p1, int dq) {
    const float NEG = -__builtin_inff();
#pragma unroll
    for (int r = 0; r < 16; ++r) { const int c = (r & 3) + 8 * (r >> 2); if (dq - c < 0) p0[r] = NEG; if (dq - c - 32 < 0) p1[r] = NEG; }
}
__device__ __forceinline__ void partialSM(f32x16& p0, f32x16& p1, float& m_reg, float& mn, float& alpha) {
    float pmax = p0[0];
#pragma unroll
    for (int r = 1; r < 16; ++r) pmax = fmaxf(pmax, p0[r]);
#pragma unroll
    for (int r = 0; r < 16; ++r) pmax = fmaxf(pmax, p1[r]);
    { auto rr = __builtin_amdgcn_permlane32_swap(__float_as_uint(pmax), __float_as_uint(pmax), false, false); pmax = fmaxf(__uint_as_float(rr[0]), __uint_as_float(rr[1])); }
    if (__builtin_expect(__all((pmax - m_reg) <= THR), 1)) { mn = m_reg; alpha = 1.f; }
    else { mn = fmaxf(m_reg, pmax); alpha = fast_exp2(m_reg - mn); m_reg = mn; }
#pragma unroll
    for (int r = 0; r < 16; ++r) p0[r] = p0[r] - mn;
#pragma unroll
    for (int r = 0; r < 16; ++r) p1[r] = p1[r] - mn;
#pragma unroll
    for (int r = 0; r < 16; ++r) p0[r] = fast_exp2(p0[r]);
}
__device__ __forceinline__ void finishSM(f32x16& p0, f32x16& p1, float alpha, float& l_reg, bf16x8& pa0, bf16x8& pa1, bf16x8& pa2, bf16x8& pa3) {
#pragma unroll
    for (int r = 0; r < 16; ++r) p1[r] = fast_exp2(p1[r]);
    float ps = 0;
#pragma unroll
    for (int r = 0; r < 16; ++r) ps += p0[r];
#pragma unroll
    for (int r = 0; r < 16; ++r) ps += p1[r];
    { auto rr = __builtin_amdgcn_permlane32_swap(__float_as_uint(ps), __float_as_uint(ps), false, false); ps = __uint_as_float(rr[0]) + __uint_as_float(rr[1]); }
    l_reg = l_reg * alpha + ps;
#define PK4(P, B_, OUT) do { unsigned a0 = cvt_pk_bf16(P[B_+0], P[B_+1]), a1 = cvt_pk_bf16(P[B_+2], P[B_+3]); unsigned b0 = cvt_pk_bf16(P[B_+4], P[B_+5]), b1 = cvt_pk_bf16(P[B_+6], P[B_+7]); \
        auto r0 = __builtin_amdgcn_permlane32_swap(a0, b0, false, false); auto r1 = __builtin_amdgcn_permlane32_swap(a1, b1, false, false); \
        u32x4 w = {r0[0], r1[0], r0[1], r1[1]}; OUT = *reinterpret_cast<bf16x8*>(&w); } while (0)
    PK4(p0, 0, pa0); PK4(p0, 8, pa1); PK4(p1, 0, pa2); PK4(p1, 8, pa3);
#undef PK4
}
#define TRRD(dst, off) asm volatile("ds_read_b64_tr_b16 %0, %1 offset:%2" : "=&v"(dst) : "v"(vb0), "i"(off) : "memory")
#define PV_D0(OO, VBOFF, d0) do { s16x4 l0, l1, l2, l3, h0, h1, h2, h3; constexpr int b_ = (VBOFF) + v_rd_off(d0, 0, 0); \
        TRRD(l0, b_); TRRD(h0, b_ + 2048); TRRD(l1, b_ + 4096); TRRD(h1, b_ + 6144); TRRD(l2, b_ + 8192); TRRD(h2, b_ + 10240); TRRD(l3, b_ + 12288); TRRD(h3, b_ + 14336); \
        asm volatile("s_waitcnt lgkmcnt(0)" ::: "memory"); SBAR(); \
        OO = __builtin_amdgcn_mfma_f32_32x32x16_bf16(pa0, (bf16x8){l0[0], l0[1], l0[2], l0[3], h0[0], h0[1], h0[2], h0[3]}, OO, 0, 0, 0); \
        OO = __builtin_amdgcn_mfma_f32_32x32x16_bf16(pa1, (bf16x8){l1[0], l1[1], l1[2], l1[3], h1[0], h1[1], h1[2], h1[3]}, OO, 0, 0, 0); \
        OO = __builtin_amdgcn_mfma_f32_32x32x16_bf16(pa2, (bf16x8){l2[0], l2[1], l2[2], l2[3], h2[0], h2[1], h2[2], h2[3]}, OO, 0, 0, 0); \
        OO = __builtin_amdgcn_mfma_f32_32x32x16_bf16(pa3, (bf16x8){l3[0], l3[1], l3[2], l3[3], h3[0], h3[1], h3[2], h3[3]}, OO, 0, 0, 0); } while (0)
__device__ __forceinline__ void glds16(const void* gsrc, unsigned lds_dst) { unsigned keep;
    asm volatile("s_mov_b32 %0, m0\n\ts_mov_b32 m0, %2\n\ts_nop 0\n\tglobal_load_lds_dwordx4 %1, off\n\ts_mov_b32 m0, %0" : "=&s"(keep) : "v"(gsrc), "s"(lds_dst) : "memory"); }
typedef short v4i16_t __attribute__((ext_vector_type(4)));
__device__ __forceinline__ s16x4 vtr(const LAS char* p) { return __builtin_bit_cast(s16x4, __builtin_amdgcn_ds_read_tr16_b64_v4i16((LAS v4i16_t*)p)); }
__device__ __forceinline__ void pv_tile2(f32x16* o, const LAS char* vp, bf16x8 pa0, bf16x8 pa1, bf16x8 pa2, bf16x8 pa3) {
#pragma unroll
    for (int d0 = 0; d0 < 4; ++d0) {
        const s16x4 l0 = vtr(vp + d0 * 512), h0 = vtr(vp + d0 * 512 + 2048), l1 = vtr(vp + d0 * 512 + 4096), h1 = vtr(vp + d0 * 512 + 6144);
        const s16x4 l2 = vtr(vp + d0 * 512 + 8192), h2 = vtr(vp + d0 * 512 + 10240), l3 = vtr(vp + d0 * 512 + 12288), h3 = vtr(vp + d0 * 512 + 14336);
        o[d0] = __builtin_amdgcn_mfma_f32_32x32x16_bf16(pa0, (bf16x8){l0[0], l0[1], l0[2], l0[3], h0[0], h0[1], h0[2], h0[3]}, o[d0], 0, 0, 0);
        o[d0] = __builtin_amdgcn_mfma_f32_32x32x16_bf16(pa1, (bf16x8){l1[0], l1[1], l1[2], l1[3], h1[0], h1[1], h1[2], h1[3]}, o[d0], 0, 0, 0);
        o[d0] = __builtin_amdgcn_mfma_f32_32x32x16_bf16(pa2, (bf16x8){l2[0], l2[1], l2[2], l2[3], h2[0], h2[1], h2[2], h2[3]}, o[d0], 0, 0, 0);
        o[d0] = __builtin_amdgcn_mfma_f32_32x32x16_bf16(pa3, (bf16x8){l3[0], l3[1], l3[2], l3[3], h3[0], h3[1], h3[2], h3[3]}, o[d0], 0, 0, 0); }
}
constexpr int OFF3_V = 0, OFF3_K = 4 * SHM_V, OFF3_WS = OFF3_K + 3 * SHM_K + 256;
__device__ __forceinline__ void attn_block3(const bf16_t* Qh, const bf16_t* Kh, const bf16_t* Vh, bf16_t* ZY, int P0, char* lds, const int tid) {
    const int wid = __builtin_amdgcn_readfirstlane(tid >> 6), lane = tid & 63, r32 = lane & 31, hi = lane >> 5;
    const bool lag = wid >= 4;
    const int NT = (P0 + QB) / KVBLK;
    const int qlo = P0 + wid * QBLK, qm = qlo + r32 - 4 * hi;
    char* K_lds = lds + OFF3_K;
    float* wsf = (float*)(lds + OFF3_WS) + wid * 64; float* li_l = wsf, * al_l = wsf + 32;
    float m_reg = -1e30f, l_reg = 0; f32x16 o[4] = {};
    const unsigned lds0 = (unsigned)(uintptr_t)lds;
    int kso[3], vso[2];
#pragma unroll
    for (int j = 0; j < 3; ++j) { const int q = (wid * 3 + j) * 1024 + lane * 16, row = q / 384, pos = q - row * 384; kso[j] = row * 384 + (pos ^ (((row >> 1) & 7) << 4)); }
#pragma unroll
    for (int j = 0; j < 2; ++j) { const int q = (wid * 2 + j) * 1024 + lane * 16, sub = q >> 9, within = q & 511, kk = (sub >> 2) * 8 + (within >> 6), cc = (within & 63) >> 1;
        const int k = (kk & ~0xC) | ((kk & 4) << 1) | ((kk & 8) >> 1), c = (sub & 3) * 32 + cc; vso[j] = k * (DV * 2) + c * 2; }
    int kis = 0, vis = 0, kq = 0, vp = 0;
#define ROTK(x) ((x) == 2 * SHM_K ? 0 : (x) + SHM_K)
#define ROTV(x) ((x) == 3 * SHM_V ? 0 : (x) + SHM_V)
#define DMA_TILE(t) do { const char* kt_ = (const char*)Kh + (size_t)(t) * SHM_K; const char* vt_ = (const char*)Vh + (size_t)(t) * SHM_V; \
        _Pragma("unroll") for (int j_ = 0; j_ < 3; ++j_) glds16(kt_ + kso[j_], (unsigned)__builtin_amdgcn_readfirstlane(lds0 + OFF3_K + kis + (wid * 3 + j_) * 1024)); \
        _Pragma("unroll") for (int j_ = 0; j_ < 2; ++j_) glds16(vt_ + vso[j_], (unsigned)__builtin_amdgcn_readfirstlane(lds0 + OFF3_V + vis + (wid * 2 + j_) * 1024)); \
        kis = ROTK(kis); vis = ROTV(vis); } while (0)
#define END_M() asm volatile("s_waitcnt vmcnt(0) lgkmcnt(0)\n\ts_barrier" ::: "memory")
#define END_V() asm volatile("s_waitcnt lgkmcnt(0)\n\ts_barrier" ::: "memory")
    int ko[4];
#pragma unroll
    for (int dd = 0; dd < 4; ++dd) ko[dd] = KSWZ(r32, (dd * 16 + hi * 8) * 2);
    const LAS char* vbb = (const LAS char*)lds + OFF3_V + v_rd_base(lane);
    DMA_TILE(0); DMA_TILE(1);
    bf16x8 qr[12];
#pragma unroll
    for (int d0 = 0; d0 < 12; ++d0) qr[d0] = *reinterpret_cast<const bf16x8*>(Qh + (size_t)(P0 + wid * QBLK + r32) * DQK + d0 * 16 + hi * 8);
#define RESC(a) do { if (__any((a) < 1.f)) { if (hi == 0) al_l[r32] = (a); asm volatile("s_waitcnt lgkmcnt(0)" ::: "memory"); \
        _Pragma("unroll") for (int d_ = 0; d_ < 4; ++d_) _Pragma("unroll") for (int r = 0; r < 16; ++r) o[d_][r] *= al_l[crow(r, hi)]; } } while (0)
    f32x16 p0, p1; float mn, al; bf16x8 pa0, pa1, pa2, pa3;
    END_M();
    if (lag) END_V();
    for (int i = 0; i < NT; ++i) {
        const char* kb_ = K_lds + kq; bf16x8 ka[8], kb2[8];
#define KLOAD(dst, blk) do { _Pragma("unroll") for (int dd = 0; dd < 4; ++dd) { const char* a = kb_ + ko[dd] + (blk) * 128; dst[2 * dd] = *reinterpret_cast<const bf16x8*>(a); dst[2 * dd + 1] = *reinterpret_cast<const bf16x8*>(a + 32 * 384); } } while (0)
#define KMMA(srcf, blk) do { _Pragma("unroll") for (int dd = 0; dd < 4; ++dd) { p0 = __builtin_amdgcn_mfma_f32_32x32x16_bf16(srcf[2 * dd], qr[(blk) * 4 + dd], p0, 0, 0, 0); p1 = __builtin_amdgcn_mfma_f32_32x32x16_bf16(srcf[2 * dd + 1], qr[(blk) * 4 + dd], p1, 0, 0, 0); } } while (0)
        SBAR();
        { _Pragma("unroll") for (int dd = 0; dd < 2; ++dd) { const char* a = kb_ + ko[dd]; ka[2 * dd] = *reinterpret_cast<const bf16x8*>(a); ka[2 * dd + 1] = *reinterpret_cast<const bf16x8*>(a + 32 * 384); } }
        SBAR();
        if (i >= 1) { pv_tile2(o, vbb + vp, pa0, pa1, pa2, pa3); vp = ROTV(vp); }
        SBAR();
        { p0 = f32x16{}; p1 = f32x16{};
          { _Pragma("unroll") for (int dd = 2; dd < 4; ++dd) { const char* a = kb_ + ko[dd]; ka[2 * dd] = *reinterpret_cast<const bf16x8*>(a); ka[2 * dd + 1] = *reinterpret_cast<const bf16x8*>(a + 32 * 384); } }
          KLOAD(kb2, 1); SBAR(); KMMA(ka, 0); SBAR(); KLOAD(ka, 2); SBAR(); KMMA(kb2, 1); SBAR(); KMMA(ka, 2);
#undef KLOAD
#undef KMMA
          kq = ROTK(kq); }
        END_M();
        if (i + 2 < NT) DMA_TILE(i + 2);
        SBAR();
        { const int kb_ = i * KVBLK; if (kb_ + KVBLK - 1 > qlo) mask_tile(p0, p1, qm - kb_); }
        partialSM(p0, p1, m_reg, mn, al); RESC(al);
        finishSM(p0, p1, al, l_reg, pa0, pa1, pa2, pa3);
        END_V();
    }
    SBAR(); pv_tile2(o, vbb + vp, pa0, pa1, pa2, pa3);
    if (!lag) END_V();
    if (hi == 0) li_l[r32] = l_reg; asm volatile("s_waitcnt lgkmcnt(0)" ::: "memory");
    float rli[16];
#pragma unroll
    for (int r = 0; r < 16; ++r) rli[r] = fast_rcp(li_l[crow(r, hi)]);
    __syncthreads();
    bf16_t* stg = (bf16_t*)lds + wid * 4096;
#pragma unroll
    for (int r = 0; r < 16; ++r) { const int orow = crow(r, hi);
#pragma unroll
        for (int d0 = 0; d0 < 4; ++d0) { const float v = o[d0][r] * rli[r]; const float vn = __shfl_xor(v, 1);
            if ((r32 & 1) == 0) *(unsigned*)(stg + orow * 128 + d0 * 32 + r32) = cvt_pk_bf16(v, vn); } }
    asm volatile("s_waitcnt lgkmcnt(0)" ::: "memory");
    bf16_t* zy = ZY + (size_t)(P0 + wid * QBLK) * D;
#pragma unroll
    for (int i = 0; i < 8; ++i) { const int id = lane + 64 * i, row = id >> 4, ch = id & 15; float a[8], z[8];
        unpack8(*(const u32x4*)(stg + row * 128 + ch * 8), a); bf16_t* p = zy + (size_t)row * D + ch * 8; unpack8(*(const u32x4*)p, z);
#pragma unroll
        for (int j = 0; j < 8; ++j) a[j] *= z[j];
        *(u32x4*)p = pack8(a); }
    __syncthreads();
#undef ROTK
#undef ROTV
#undef DMA_TILE
#undef END_M
#undef END_V
#undef RESC
}

struct MixRegs { u32x4 vq[4]; f32x2 mrq[4]; u32x4 uq[4], zq[4]; };
__device__ __forceinline__ void mixer_issue(unsigned char* ws, int chunk, int g, const int tid, MixRegs& R) {
    const int wid = __builtin_amdgcn_readfirstlane(tid >> 6), lane = tid & 63; const int rb = wid & 3, dh = wid >> 2;
    const bf16_t* Vg = (const bf16_t*)(ws + WS_VG); const f32x2* VMR = (const f32x2*)(ws + WS_VMR); const bf16_t* Ug = (const bf16_t*)(ws + WS_UG); const bf16_t* Za = (const bf16_t*)(ws + WS_ZA);
    const int sr = tid >> 4, sc = (tid & 15) * 8; const int row0 = chunk * 128, col0 = g * 128;
#pragma unroll
    for (int q = 0; q < 4; ++q) { const int s = q * 32 + sr; R.vq[q] = *(const u32x4*)(Vg + (size_t)(row0 + s) * D + col0 + sc); R.mrq[q] = VMR[row0 + s]; }
#pragma unroll
    for (int i = 0; i < 4; ++i) { const int id = lane + 64 * i, tr = id >> 3, ch = id & 7, t = rb * 32 + tr; const size_t off = (size_t)(row0 + t) * D + col0 + dh * 64 + ch * 8;
        R.uq[i] = *(const u32x4*)(Ug + off); R.zq[i] = *(const u32x4*)(Za + off); }
}
__device__ __forceinline__ void mixer_block(unsigned char* ws, const float* ln_g, const float* ln_b, const float* b_s, int chunk, int g, char* lds, const int tid, const MixRegs& R) {
    const int wid = __builtin_amdgcn_readfirstlane(tid >> 6), lane = tid & 63, r32 = lane & 31, hi = lane >> 5;
    const int rb = wid & 3, dh = wid >> 2;
    const int sr = tid >> 4, sc = (tid & 15) * 8; const int row0 = chunk * 128, col0 = g * 128;
    bf16_t* Ug = (bf16_t*)(ws + WS_UG); float bsq[4];
#pragma unroll
    for (int i = 0; i < 4; ++i) { const int id = lane + 64 * i, tr = id >> 3; bsq[i] = b_s[g * 128 + rb * 32 + tr]; }
    float lg[8], lb[8];
#pragma unroll
    for (int j = 0; j < 8; ++j) { lg[j] = ln_g[col0 + sc + j]; lb[j] = ln_b[col0 + sc + j]; }
#pragma unroll
    for (int q = 0; q < 4; ++q) { const f32x2 mr = R.mrq[q]; float v[8];
        unpack8(R.vq[q], v);
#pragma unroll
        for (int j = 0; j < 8; ++j) v[j] = (v[j] - mr.x) * mr.y * lg[j] + lb[j];
        *(u32x4*)(lds + (q >> 1) * SHM_V + v_st((q & 1) * 32 + sr, sc)) = pack8(v); }
    const bf16_t* Wm = (const bf16_t*)(ws + WS_WSM) + ((size_t)g * 128 + rb * 32 + r32) * 128;
    bf16x8 wa[2][4];
#pragma unroll
    for (int kt = 0; kt < 2; ++kt)
#pragma unroll
        for (int ks = 0; ks < 4; ++ks) wa[kt][ks] = *(const bf16x8*)(Wm + kt * 64 + ks * 16 + hi * 8);
    __syncthreads();
    const int vb0 = (int)(uintptr_t)lds + v_rd_base(lane);
    f32x16 o0 = {}, o1 = {};
    if (dh == 0) {
        { bf16x8 pa0 = wa[0][0], pa1 = wa[0][1], pa2 = wa[0][2], pa3 = wa[0][3]; PV_D0(o0, 0, 0); PV_D0(o1, 0, 1); }
        if (rb >= 2) { bf16x8 pa0 = wa[1][0], pa1 = wa[1][1], pa2 = wa[1][2], pa3 = wa[1][3]; PV_D0(o0, SHM_V, 0); PV_D0(o1, SHM_V, 1); }
    } else {
        { bf16x8 pa0 = wa[0][0], pa1 = wa[0][1], pa2 = wa[0][2], pa3 = wa[0][3]; PV_D0(o0, 0, 2); PV_D0(o1, 0, 3); }
        if (rb >= 2) { bf16x8 pa0 = wa[1][0], pa1 = wa[1][1], pa2 = wa[1][2], pa3 = wa[1][3]; PV_D0(o0, SHM_V, 2); PV_D0(o1, SHM_V, 3); }
    }
    float* stg = (float*)(lds + 2 * SHM_V) + wid * 2048;
#pragma unroll
    for (int r = 0; r < 16; ++r) { const int tr = crow(r, hi); stg[tr * 64 + r32] = o0[r]; stg[tr * 64 + 32 + r32] = o1[r]; }
    asm volatile("s_waitcnt lgkmcnt(0)" ::: "memory");
#pragma unroll
    for (int i = 0; i < 4; ++i) { const int id = lane + 64 * i, tr = id >> 3, ch = id & 7, t = rb * 32 + tr; const float bs = bsq[i];
        const size_t off = (size_t)(row0 + t) * D + col0 + dh * 64 + ch * 8;
        const f32x4 s0 = *(const f32x4*)(stg + tr * 64 + ch * 8), s1 = *(const f32x4*)(stg + tr * 64 + ch * 8 + 4);
        float u[8], z[8], y[8]; unpack8(R.uq[i], u); unpack8(R.zq[i], z);
#pragma unroll
        for (int j = 0; j < 4; ++j) { y[j] = u[j] * (s0[j] + bs) * z[j]; y[4 + j] = u[4 + j] * (s1[j] + bs) * z[4 + j]; }
        *(u32x4*)(Ug + off) = pack8(y); }
    __syncthreads();
}
#undef SBAR
}


#define XB_TMO      128
#define XB_XCNT(j)  (256  + 64 * (j))
#define XB_XSUB(j)  (1280 + 64 * (j))
#define XB_XGEN(j)  (2304 + 64 * (j))
#define XB_TOP      3328
#define XB_TOPGEN   3392
#define XCD_BAR_WORDS 3456
#define XB_SPIN_CAP (1u << 22)
__device__ __forceinline__ unsigned xb_ld(unsigned* p)              { return __hip_atomic_load(p, __ATOMIC_RELAXED, __HIP_MEMORY_SCOPE_AGENT); }
__device__ __forceinline__ unsigned xb_add(unsigned* p, unsigned v) { return __hip_atomic_fetch_add(p, v, __ATOMIC_RELAXED, __HIP_MEMORY_SCOPE_AGENT); }
__device__ __forceinline__ unsigned xb_xcc_id() { return (unsigned)__builtin_amdgcn_s_getreg((3 << 11) | 20) & 0xFu; }
#define XB_SPIN(cond, bar) do { unsigned _sp = 0; while (cond) { __builtin_amdgcn_s_sleep(1); \
    if ((++_sp & 255u) == 0u) { if (xb_ld(&(bar)[XB_TMO])) break; if (_sp > XB_SPIN_CAP) { atomicAdd(&(bar)[XB_TMO], 1u); break; } } } } while (0)
__device__ __forceinline__ void xcd_barrier_complete(unsigned* bar, unsigned x, unsigned& nloc, unsigned& nx) {
    const unsigned G = gridDim.x;
    unsigned sum, cnt, mine, sp = 0u;
    for (;;) {
        sum = 0u; cnt = 0u; mine = 0u;
#pragma unroll
        for (unsigned j = 0; j < 16; ++j) { const unsigned c = xb_ld(&bar[XB_XCNT(j)]); sum += c; cnt += (c > 0u) ? 1u : 0u; mine = (j == x) ? c : mine; }
        if (sum == G) break;
        __builtin_amdgcn_s_sleep(1);
        if ((++sp & 255u) == 0u) { if (xb_ld(&bar[XB_TMO])) break; if (sp > XB_SPIN_CAP) { atomicAdd(&bar[XB_TMO], 1u); break; } }
    }
    nloc = mine > 0u ? mine : 1u; nx = cnt > 0u ? cnt : 1u;
}
__device__ __forceinline__ void xcd_barrier(unsigned* bar, volatile LAS unsigned* st, const int tid) {
    asm volatile("s_waitcnt vmcnt(0)" ::: "memory");
    __syncthreads();
    if (tid == 0) {
        const unsigned x = xb_xcc_id();
        __builtin_amdgcn_s_waitcnt(0);
        unsigned nloc = st[0], nx = st[1];
        if (nloc == 0u) { xcd_barrier_complete(bar, x, nloc, nx); st[0] = nloc; st[1] = nx; }
        const unsigned old = xb_add(&bar[XB_XSUB(x)], 1u);
        const unsigned gen = old / nloc;
        if (old + 1u == (gen + 1u) * nloc) {
            __builtin_amdgcn_fence(__ATOMIC_RELEASE, "agent");
            asm volatile("s_waitcnt vmcnt(0)" ::: "memory");
            const unsigned og = xb_add(&bar[XB_TOP], 1u);
            const unsigned tg = og / nx;
            if (og + 1u == (tg + 1u) * nx) xb_add(&bar[XB_TOPGEN], 1u);
            else XB_SPIN(xb_ld(&bar[XB_TOPGEN]) == tg, bar);
            __builtin_amdgcn_fence(__ATOMIC_ACQUIRE, "agent");
            xb_add(&bar[XB_XGEN(x)], 1u);
            asm volatile("s_waitcnt vmcnt(0)" ::: "memory");
        } else {
            XB_SPIN(xb_ld(&bar[XB_XGEN(x)]) == gen, bar);
            __builtin_amdgcn_fence(__ATOMIC_ACQUIRE, "agent");
            asm volatile("s_waitcnt vmcnt(0)" ::: "memory");
        }
    }
    __syncthreads();
}

typedef const __attribute__((address_space(4))) Ptrs* KargPtr;
#define PHASE_ENV() KargPtr kp_ = (KargPtr)__builtin_amdgcn_kernarg_segment_ptr(); asm volatile("" : "+s"(kp_)); \
    const int wave = wave0_; int lane = (int)__builtin_amdgcn_mbcnt_hi(~0u, __builtin_amdgcn_mbcnt_lo(~0u, 0u)); asm volatile("" : "+v"(lane)); const int tid = wave * 64 + lane; \
    int G = gridDim.x, c = blockIdx.x; asm volatile("" : "+s"(G), "+s"(c)); const int vcu = (G % 8 == 0) ? (c % 8) * (G / 8) + c / 8 : c; \
    unsigned char* ws = kp_->ws; unsigned char* dout = (unsigned char*)kp_->out; (void)lane; (void)wave; (void)vcu; (void)ws; (void)dout
__global__ void __launch_bounds__(NTHREADS, 2) hybrid_fwd(Ptrs Punused) {
    extern __shared__ __attribute__((aligned(16))) unsigned char lds_raw[];
    LAS unsigned char* lds = (LAS unsigned char*)lds_raw;
    const int wave0_ = __builtin_amdgcn_readfirstlane((int)threadIdx.x >> 6);
    int lo, hi; { KargPtr k0 = (KargPtr)__builtin_amdgcn_kernarg_segment_ptr(); lo = k0->ph_lo; hi = k0->ph_hi; }
#define IN(k) (lo <= (k) && (k) < hi)
#if MK_SINGLE
    volatile LAS unsigned* bst_ = (volatile LAS unsigned*)(lds + BARST_OFF);
    { if ((int)threadIdx.x == 0) { bst_[0] = 0u; bst_[1] = 0u; KargPtr k0 = (KargPtr)__builtin_amdgcn_kernarg_segment_ptr(); (void)xb_add(&((unsigned*)k0->ws)[XB_XCNT(xb_xcc_id())], 1u); } __syncthreads(); }
#define SEAM(k) do { if (IN(k) && IN((k) + 1)) { PHASE_ENV(); if (kp_->use_cg) cg::this_grid().sync(); else xcd_barrier((unsigned*)ws, bst_, tid); } } while (0)
#else
#define SEAM(k) do { } while (0)
#endif
    if (IN(0)) { PHASE_ENV(); Ptrs P; { const __attribute__((address_space(4))) unsigned long long* s_ = (const __attribute__((address_space(4))) unsigned long long*)kp_; unsigned long long* d_ = (unsigned long long*)&P; _Pragma("unroll") for (int i_ = 0; i_ < (int)(sizeof(Ptrs) / 8); ++i_) d_[i_] = s_[i_]; } phase0(P, lds, vcu, G, tid, lane, wave); }
    SEAM(0);
    if (IN(1)) { PHASE_ENV(); SchedP1 Sc{ws, G, c}; EpiP1 E{ws, dout, kp_->in[16]}; pg8::gemm_phase<2048>(lds, Sc, E, tid); }
    SEAM(1);
    if (IN(2)) { PHASE_ENV();
        { const f32x2* st = (const f32x2*)(ws + WS_VST); f32x2* mr = (f32x2*)(ws + WS_VMR);
          for (int row = c * 32 + (tid >> 4); row < S; row += G * 32) { const int sub = tid & 15;
              const f32x2 p0 = st[(size_t)sub * S + row], p1 = st[(size_t)(sub + 16) * S + row]; float s1 = p0.x + p1.x, s2 = p0.y + p1.y;
#pragma unroll
              for (int o = 1; o < 16; o <<= 1) { s1 += __shfl_xor(s1, o); s2 += __shfl_xor(s2, o); }
              const float mean = s1 * (1.f / D); const float var = fmaxf(s2 * (1.f / D) - mean * mean, 0.f); if (sub == 0) mr[row] = (f32x2){mean, 1.0f / sqrtf(var + EPS)}; } }
        SchedP2 Sc{ws, G, c}; EpiP2 E{ws, (LAS float*)(lds + XCH_OFF)}; pg8::gemm_phase<512>(lds, Sc, E, tid);
    }
    SEAM(2);
    if (IN(3)) {
        { PHASE_ENV(); if (vcu < 256) { const int h = vcu >> 4, x = vcu & 15;
            const bf16_t* Qh = (const bf16_t*)(ws + WS_QB) + (size_t)h * S * DQK; const bf16_t* Kh = (const bf16_t*)(ws + WS_KB) + (size_t)h * S * DQK; const bf16_t* Vh = (const bf16_t*)(ws + WS_VB) + (size_t)h * S * DV;
            bf16_t* ZY = (bf16_t*)dout + h * DV;
            att::attn_block3(Qh, Kh, Vh, ZY, (31 - x) * 256, (char*)lds_raw, tid); att::attn_block3(Qh, Kh, Vh, ZY, x * 256, (char*)lds_raw, tid); } }
        { PHASE_ENV(); SchedP3b Sc{ws, G, c}; EpiMulZ E{dout}; pg8::gemm_phase<256>(lds, Sc, E, tid); }
        { PHASE_ENV(); const float* lng = kp_->in[5]; const float* lnb = kp_->in[6]; const float* bs = kp_->in[8];
            att::MixRegs ra, rb;
            if (vcu < 1024) att::mixer_issue(ws, vcu >> 4, vcu & 15, tid, ra);
            for (int it = vcu; it < 1024; it += 2 * G) {
                const int it1 = it + G, it2 = it + 2 * G;
                if (it1 < 1024) att::mixer_issue(ws, it1 >> 4, it1 & 15, tid, rb);
                att::mixer_block(ws, lng, lnb, bs, it >> 4, it & 15, (char*)lds_raw, tid, ra);
                if (it1 >= 1024) break;
                if (it2 < 1024) att::mixer_issue(ws, it2 >> 4, it2 & 15, tid, ra);
                att::mixer_block(ws, lng, lnb, bs, it1 >> 4, it1 & 15, (char*)lds_raw, tid, rb);
            } }
        { PHASE_ENV(); Ptrs P; { const __attribute__((address_space(4))) unsigned long long* s_ = (const __attribute__((address_space(4))) unsigned long long*)kp_; unsigned long long* d_ = (unsigned long long*)&P; _Pragma("unroll") for (int i_ = 0; i_ < (int)(sizeof(Ptrs) / 8); ++i_) d_[i_] = s_[i_]; } phase_wconv2(P, lds, vcu, G, lane, wave); }
    }
    SEAM(3);
    if (IN(4)) { PHASE_ENV(); SchedP4 Sc{ws, dout, G, c}; EpiP4 E{ws}; pg8::gemm_phase<2048>(lds, Sc, E, tid); }
    SEAM(4);
    if (IN(5)) { PHASE_ENV(); SchedP5 Sc{ws, G, c}; EpiP5 E{ws, (float*)dout}; pg8::gemm_phase<2048>(lds, Sc, E, tid); }
    SEAM(5);
    if (IN(6)) { PHASE_ENV();
        const float* st = (const float*)(ws + WS_OST); const float* x = kp_->in[0]; const float* gp = kp_->in[19]; float* outp = (float*)dout;
        for (int row = vcu * NWAVES + wave; row < S; row += G * NWAVES) {
            float s = lane < 32 ? st[(size_t)lane * S + row] : 0.f; s = wave_sum(s);
            const float rs = 1.0f / sqrtf(s * (1.f / D) + EPS);
            const f32x4* xr = (const f32x4*)(x + (size_t)row * D); f32x4* orow = (f32x4*)(outp + (size_t)row * D); const f32x4* gr = (const f32x4*)gp; const u32x4* ob = (const u32x4*)((const bf16_t*)(ws + WS_MP) + (size_t)row * D);
#pragma unroll
            for (int j = 0; j < 4; ++j) { const int q = 64 * j + lane; float a[8]; unpack8(ob[q], a); const f32x4 x0 = xr[2 * q], x1 = xr[2 * q + 1], g0 = gr[2 * q], g1 = gr[2 * q + 1];
                orow[2 * q] = x0 + (f32x4){a[0], a[1], a[2], a[3]} * rs * g0; orow[2 * q + 1] = x1 + (f32x4){a[4], a[5], a[6], a[7]} * rs * g1; }
        }
    }
#undef IN
#undef SEAM
}

extern "C" void kernel_launch(void* const* d_in, const int* in_sizes, int n_in, void* d_out, int out_size, void* d_ws, size_t ws_size, hipStream_t stream) {
    static int grid = 0;
    if (grid == 0) {
        if (n_in != 20 || out_size != S * D || ws_size < WS_END) { fprintf(stderr, "kernel_launch: unexpected shapes (n_in %d out %d ws %zu)\n", n_in, out_size, ws_size); grid = -1; return; }
        int dev = 0, cus = 0, per_cu = 0;
        (void)hipGetDevice(&dev); (void)hipDeviceGetAttribute(&cus, hipDeviceAttributeMultiprocessorCount, dev);
        (void)hipFuncSetAttribute((const void*)hybrid_fwd, hipFuncAttributeMaxDynamicSharedMemorySize, LDS_BYTES);
        (void)hipOccupancyMaxActiveBlocksPerMultiprocessor(&per_cu, (const void*)hybrid_fwd, NTHREADS, LDS_BYTES);
        if (per_cu < 1) { fprintf(stderr, "kernel_launch: occupancy query reports %d blocks per CU\n", per_cu); }
        grid = cus;
        (void)hipGetLastError();
    }
    if (grid < 0) return;
    Ptrs p{};
    for (int i = 0; i < 20; ++i) p.in[i] = (const float*)d_in[i];
    p.out = (float*)d_out; p.ws = (unsigned char*)d_ws;
#if MK_SINGLE
    (void)hipMemsetAsync(d_ws, 0, CTL_ZERO_BYTES, stream);
    p.ph_lo = 0; p.ph_hi = 7;
    void* args[] = {&p};
    hipError_t e = hipLaunchCooperativeKernel((const void*)hybrid_fwd, dim3(grid), dim3(NTHREADS), args, LDS_BYTES, stream);
    if (e != hipSuccess) fprintf(stderr, "cooperative launch failed: %s (grid %d)\n", hipGetErrorString(e), grid);
#else
    for (int k = 0; k < 7; ++k) { p.ph_lo = k; p.ph_hi = k + 1; hipLaunchKernelGGL(hybrid_fwd, dim3(grid), dim3(NTHREADS), LDS_BYTES, stream, p); }
#endif
}
```

```cpp
#include <hip/hip_runtime.h>
#include <hip/hip_cooperative_groups.h>
#include <cstdio>
#include <cstdint>
namespace cg = cooperative_groups;

#ifndef MK_SINGLE
#define MK_SINGLE 1
#endif

#define LAS __attribute__((address_space(3)))
typedef unsigned short bf16_t;
typedef short bf16x8 __attribute__((ext_vector_type(8)));
typedef short s16x4 __attribute__((ext_vector_type(4)));
typedef float f32x4 __attribute__((ext_vector_type(4)));
typedef float f32x2 __attribute__((ext_vector_type(2)));
typedef float f32x16 __attribute__((ext_vector_type(16)));
typedef unsigned u32x4 __attribute__((ext_vector_type(4)));
typedef unsigned u32x2 __attribute__((ext_vector_type(2)));

constexpr int S = 8192, D = 2048, ML = 256, NH = 16, DQK = 192, DV = 128;
constexpr int IN_TOTAL = 13376, NT_IN = 77;
constexpr float EPS = 1e-6f, LOG2E = 1.4426950408889634f;
constexpr float QSCALE = 0.07216878364870322f * 1.4426950408889634f;
constexpr float MSCALE = 0.04419417382415922f * 1.4426950408889634f;
constexpr int NTHREADS = 512, NWAVES = 8;
constexpr int RING_BYTES = 131072, XCH_OFF = RING_BYTES, BARST_OFF = XCH_OFF + 8192, LDS_BYTES = 147456;
constexpr size_t CTL_ZERO_BYTES = 16384;

constexpr size_t MiB = 1u << 20;
constexpr size_t WS_CS = 1 * MiB;
constexpr size_t WS_VST = 3 * MiB;
constexpr size_t WS_CQST = 5 * MiB;
constexpr size_t WS_CKVST = 5 * MiB + 256 * 1024;
constexpr size_t WS_VMR = 5 * MiB + 512 * 1024;
constexpr size_t WS_OST = 6 * MiB;
constexpr size_t WS_WSM = 7 * MiB;
constexpr size_t WS_KR = 8 * MiB;
constexpr size_t WS_KMH = 9 * MiB;
constexpr size_t WS_VMT = 10 * MiB;
constexpr size_t WS_WUQ = 11 * MiB;
constexpr size_t WS_WUKV = 14 * MiB;
constexpr size_t WS_WIN = 18 * MiB;
constexpr size_t WS_WMEM = 95 * MiB;
constexpr size_t WS_H = 111 * MiB;
constexpr size_t WS_MEMN = 143 * MiB;
constexpr size_t WS_UG = 144 * MiB;
constexpr size_t WS_VG = 176 * MiB;
constexpr size_t WS_ZA = 208 * MiB;
constexpr size_t WS_CQ = 240 * MiB;
constexpr size_t WS_CKV = 248 * MiB;
constexpr size_t WS_QMH = 256 * MiB;
constexpr size_t WS_G = 288 * MiB;
constexpr size_t WS_VB = 384 * MiB;
constexpr size_t WS_QB = 18 * MiB;
constexpr size_t WS_KB = 66 * MiB;
constexpr size_t WS_P = 114 * MiB;
constexpr size_t WS_WBR = 240 * MiB;
constexpr size_t WS_WOUT = 264 * MiB;
constexpr size_t WS_MP = 18 * MiB;
constexpr size_t WS_MERGED = 82 * MiB;
constexpr size_t WS_END = 416 * MiB;

typedef __bf16 bf16x2_t __attribute__((ext_vector_type(2)));
__device__ __forceinline__ unsigned cvt_pk_bf16(float lo, float hi) { const f32x2 v = {lo, hi}; const bf16x2_t b = __builtin_convertvector(v, bf16x2_t); return __builtin_bit_cast(unsigned, b); }
__device__ __forceinline__ float bf_lo(unsigned w) { return __uint_as_float(w << 16); }
__device__ __forceinline__ float bf_hi(unsigned w) { return __uint_as_float(w & 0xffff0000u); }
__device__ __forceinline__ u32x4 pack8(const float* v) { u32x4 w; w.x = cvt_pk_bf16(v[0], v[1]); w.y = cvt_pk_bf16(v[2], v[3]); w.z = cvt_pk_bf16(v[4], v[5]); w.w = cvt_pk_bf16(v[6], v[7]); return w; }
__device__ __forceinline__ void unpack8(u32x4 w, float* v) { v[0] = bf_lo(w.x); v[1] = bf_hi(w.x); v[2] = bf_lo(w.y); v[3] = bf_hi(w.y); v[4] = bf_lo(w.z); v[5] = bf_hi(w.z); v[6] = bf_lo(w.w); v[7] = bf_hi(w.w); }
__device__ __forceinline__ float fast_rcp(float x) { return __builtin_amdgcn_rcpf(x); }
__device__ __forceinline__ float fast_exp2(float x) { return __builtin_amdgcn_exp2f(x); }
__device__ __forceinline__ float act_gelu(float x) { const float u = x * (1.f + 0.044715f * x * x); return x * fast_rcp(1.f + fast_exp2(-2.3022081983f * u)); }
__device__ __forceinline__ float act_silu(float x) { return x * fast_rcp(1.f + fast_exp2(-LOG2E * x)); }
__device__ __forceinline__ float act_sigmoid(float x) { return fast_rcp(1.f + fast_exp2(-LOG2E * x)); }
__device__ __forceinline__ float wave_sum(float v) {
#pragma unroll
    for (int o = 1; o < 64; o <<= 1) v += __shfl_xor(v, o);
    return v;
}

namespace pg8 {
constexpr int BM = 256, BK = 64, HALF = 128, HTB = HALF * BK * 2, STAGE_BYTES = 8 * HTB;
__host__ __device__ __forceinline__ int lds_byte(int r, int c) { const int st = (r >> 4) * 2 + (c >> 5), rr = r & 15, cc = c & 31, ob = rr * 64 + cc * 2; return st * 1024 + (ob ^ (((ob >> 9) & 1) << 5)); }
__host__ __device__ __forceinline__ void stage_rc(int b, int& R, int& C) { const int st = b / 1024, sb = b % 1024, swz = sb ^ (((sb >> 9) & 1) << 5); R = (st >> 1) * 16 + swz / 64; C = (st & 1) * 32 + (swz % 64) / 2; }
__host__ __device__ __forceinline__ int perm32(int rho) { const int n = rho >> 4, i = rho & 15; return 8 * (i >> 2) + 4 * n + (i & 3); }

struct Unit { const char* A; const char* B; int pm, pn, mode; };

template <int K, class Sched, class Epi>
__device__ __forceinline__ void gemm_phase(LAS unsigned char* lds, const Sched& S, const Epi& E, const int tid) {
    const int wid = __builtin_amdgcn_readfirstlane(tid >> 6), lane = tid & 63, wr = wid >> 2, wc = wid & 3, fr = lane & 15, fq = lane >> 4;
    constexpr int nt = K / BK;
    unsigned voffA[2], voffB[2];
#pragma unroll
    for (int i = 0; i < 2; ++i) { int R, C; stage_rc(tid * 16 + i * 8192, R, C); const int Rb = (R & ~31) + perm32(R & 31);
        voffA[i] = (unsigned)(R * K + C) * 2u; voffB[i] = (unsigned)(Rb * K + C) * 2u; }
    constexpr size_t kstep = (size_t)(BK * 2);
    constexpr size_t hstep = (size_t)HALF * K * 2;
    const unsigned ldsw = (unsigned)wid * 1024u;
    const int aoff = lds_byte(wr * 64 + fr, fq * 8), boff = lds_byte(wc * 32 + fr, fq * 8);
#define PG8_SA(b, h) (((b) * 2 + (h)) * HTB)
#define PG8_SB(b, h) ((4 + (b) * 2 + (h)) * HTB)
#define PG8_STAGE(bufoff, gbase, voff) do { _Pragma("unroll") for (int _i = 0; _i < 2; ++_i) \
        __builtin_amdgcn_global_load_lds((const unsigned*)((const char*)(gbase) + (voff)[_i]), (LAS unsigned*)(lds + (bufoff) + ldsw + _i * 8192), 16, 0, 0); } while (0)
#define PG8_LDA(dst, b, h) do { _Pragma("unroll") for (int m = 0; m < 4; ++m) _Pragma("unroll") for (int k = 0; k < 2; ++k) dst[m][k] = *(const LAS bf16x8*)(lds + PG8_SA(b, h) + aoff + m * 2048 + k * 1024); } while (0)
#define PG8_LDB(dst, b, h) do { _Pragma("unroll") for (int n = 0; n < 2; ++n) _Pragma("unroll") for (int k = 0; k < 2; ++k) dst[n][k] = *(const LAS bf16x8*)(lds + PG8_SB(b, h) + boff + n * 2048 + k * 1024); } while (0)
#define PG8_MMA(ai, bj, At, Bt) do { __builtin_amdgcn_s_setprio(1); _Pragma("unroll") for (int m = 0; m < 4; ++m) _Pragma("unroll") for (int n = 0; n < 2; ++n) _Pragma("unroll") for (int k = 0; k < 2; ++k) \
        acc[ai][bj][m][n] = __builtin_amdgcn_mfma_f32_16x16x32_bf16(Bt[n][k], At[m][k], acc[ai][bj][m][n], 0, 0, 0); __builtin_amdgcn_s_setprio(0); } while (0)
#define PG8_WAIT_V(n) asm volatile("s_waitcnt vmcnt(" #n ")" ::: "memory")
#define PG8_WAIT_L(n) asm volatile("s_waitcnt lgkmcnt(" #n ")" ::: "memory")
#define PG8_BAR __builtin_amdgcn_s_barrier()
#define PG8_SCHED __builtin_amdgcn_sched_barrier(0)
    Unit cur, nxt; int ui = 0;
    if (!S.next(0, cur)) return;
    f32x4 acc[2][2][4][2];
#pragma unroll
    for (int a = 0; a < 2; ++a)
#pragma unroll
        for (int b = 0; b < 2; ++b)
#pragma unroll
            for (int m = 0; m < 4; ++m)
#pragma unroll
                for (int n = 0; n < 2; ++n) acc[a][b][m][n] = (f32x4){0.f, 0.f, 0.f, 0.f};
    bf16x8 At[4][2], B0[2][2], B1[2][2];
    const char* cA = cur.A; const char* cB = cur.B;
#define PG8_KT(t) ((size_t)((t) & (nt - 1)) * kstep)
    PG8_STAGE(PG8_SB(0, 0), cB + PG8_KT(0), voffB); PG8_STAGE(PG8_SB(0, 1), cB + hstep + PG8_KT(0), voffB); PG8_STAGE(PG8_SA(0, 0), cA + PG8_KT(0), voffA); PG8_STAGE(PG8_SA(0, 1), cA + hstep + PG8_KT(0), voffA);
    if (wr == 1) PG8_BAR;
    PG8_WAIT_V(2); PG8_BAR;
    PG8_STAGE(PG8_SB(1, 0), cB + PG8_KT(1), voffB); PG8_STAGE(PG8_SA(1, 0), cA + PG8_KT(1), voffA); PG8_STAGE(PG8_SB(1, 1), cB + hstep + PG8_KT(1), voffB);
    PG8_WAIT_V(6); PG8_BAR;
    for (;;) {
        const bool has_next = S.next(ui + 1, nxt);
        const char* nA = has_next ? nxt.A : cA; const char* nB = has_next ? nxt.B : cB;
#pragma unroll 1
        for (int t = 0; t < nt; t += 2) {
            const bool last = (t == nt - 2);
            const char* a1 = cA + PG8_KT(t + 1);
            const char* a2 = (last ? nA : cA) + PG8_KT(t + 2); const char* b2 = (last ? nB : cB) + PG8_KT(t + 2);
            const char* a3 = (last ? nA : cA) + PG8_KT(t + 3); const char* b3 = (last ? nB : cB) + PG8_KT(t + 3);
            PG8_LDB(B0, 0, 0); PG8_LDB(B1, 0, 1); PG8_SCHED; PG8_LDA(At, 0, 0); PG8_STAGE(PG8_SA(1, 1), a1 + hstep, voffA);
            PG8_WAIT_V(8); PG8_WAIT_L(0); PG8_BAR; PG8_MMA(0, 0, At, B0); PG8_MMA(0, 1, At, B1); PG8_BAR; PG8_SCHED;
            PG8_LDA(At, 0, 1); PG8_STAGE(PG8_SB(0, 0), b2, voffB); PG8_STAGE(PG8_SB(0, 1), b2 + hstep, voffB); PG8_STAGE(PG8_SA(0, 0), a2, voffA);
            PG8_WAIT_V(8); PG8_WAIT_L(0); PG8_BAR; PG8_MMA(1, 0, At, B0); PG8_MMA(1, 1, At, B1); PG8_BAR; PG8_SCHED;
            PG8_LDB(B0, 1, 0); PG8_LDB(B1, 1, 1); PG8_SCHED; PG8_LDA(At, 1, 0); PG8_STAGE(PG8_SA(0, 1), a2 + hstep, voffA);
            PG8_WAIT_V(8); PG8_WAIT_L(0); PG8_BAR; PG8_MMA(0, 0, At, B0); PG8_MMA(0, 1, At, B1); PG8_BAR; PG8_SCHED;
            PG8_LDA(At, 1, 1); PG8_STAGE(PG8_SB(1, 0), b3, voffB); PG8_STAGE(PG8_SB(1, 1), b3 + hstep, voffB); PG8_STAGE(PG8_SA(1, 0), a3, voffA);
            PG8_WAIT_V(8); PG8_WAIT_L(0); PG8_BAR; PG8_MMA(1, 0, At, B0); PG8_MMA(1, 1, At, B1); PG8_BAR; PG8_SCHED;
        }
        if (wr == 0) PG8_BAR;
        E(acc, cur, wr, wc, fr, fq);
        if (!has_next) break;
        if (!E.keep_acc(cur)) {
#pragma unroll
        for (int a = 0; a < 2; ++a)
#pragma unroll
            for (int b = 0; b < 2; ++b)
#pragma unroll
                for (int m = 0; m < 4; ++m)
#pragma unroll
                    for (int n = 0; n < 2; ++n) acc[a][b][m][n] = (f32x4){0.f, 0.f, 0.f, 0.f};
        }
        cur = nxt; cA = nA; cB = nB; ++ui;
        if (wr == 1) PG8_BAR;
    }
    PG8_WAIT_V(0);
    PG8_BAR;
#undef PG8_KT
#undef PG8_SA
#undef PG8_SB
#undef PG8_STAGE
#undef PG8_LDA
#undef PG8_LDB
#undef PG8_MMA
#undef PG8_WAIT_V
#undef PG8_WAIT_L
#undef PG8_BAR
#undef PG8_SCHED
}
}
using pg8::Unit;

#define EPI_LOOP_BEGIN \
    _Pragma("unroll") for (int ai = 0; ai < 2; ++ai) _Pragma("unroll") for (int m = 0; m < 4; ++m) { const int rt = ai * 128 + wr * 64 + m * 16 + fr; \
    _Pragma("unroll") for (int bj = 0; bj < 2; ++bj) { const int ct = bj * 128 + wc * 32 + 8 * fq; \
        float v[8] = {acc[ai][bj][m][0][0], acc[ai][bj][m][0][1], acc[ai][bj][m][0][2], acc[ai][bj][m][0][3], acc[ai][bj][m][1][0], acc[ai][bj][m][1][1], acc[ai][bj][m][1][2], acc[ai][bj][m][1][3]};
#define EPI_LOOP_END } }

enum { M_GELU = 0, M_GELU_STAT, M_SILU, M_RAW_SS, M_KROPE, M_QM, M_GATE, M_MEMK, M_MEMV,
       M_QUP, M_KVUP, M_MEMS,
       M_MULZ, M_BR0, M_BR1, M_BR2, M_OUT };

struct Ptrs {
    const float* in[20]; float* out; unsigned char* ws; int ph_lo, ph_hi; int use_cg, pad;
};

struct EpiP1 {
    __device__ __forceinline__ bool keep_acc(const Unit&) const { return false; }
    unsigned char* ws; unsigned char* dout; const float* bgate;
    __device__ __forceinline__ void operator()(f32x4 (&acc)[2][2][4][2], const Unit& u, int wr, int wc, int fr, int fq) const {
        const int mode = u.mode, pn = u.pn, row0 = u.pm * 256;
        if (mode == M_KROPE) {
            if (wc < 2) {
                const f32x2* CS = (const f32x2*)(ws + WS_CS); bf16_t* KR = (bf16_t*)(ws + WS_KR);
#pragma unroll
                for (int ai = 0; ai < 2; ++ai)
#pragma unroll
                    for (int m = 0; m < 4; ++m) { const int row = row0 + ai * 128 + wr * 64 + m * 16 + fr; const int i0 = (wc * 32 + 8 * fq) >> 1;
                        const f32x4 a = acc[ai][0][m][0], b = acc[ai][0][m][1]; const float t1[4] = {a[0], a[2], b[0], b[2]}, t2[4] = {a[1], a[3], b[1], b[3]};
                        float o1[4], o2[4];
#pragma unroll
                        for (int j = 0; j < 4; ++j) { const f32x2 cs = CS[row * 32 + i0 + j]; o1[j] = t1[j] * cs.x - t2[j] * cs.y; o2[j] = t2[j] * cs.x + t1[j] * cs.y; }
                        u32x2 w1, w2; w1.x = cvt_pk_bf16(o1[0], o1[1]); w1.y = cvt_pk_bf16(o1[2], o1[3]); w2.x = cvt_pk_bf16(o2[0], o2[1]); w2.y = cvt_pk_bf16(o2[2], o2[3]);
                        *(u32x2*)(KR + (size_t)row * 64 + i0) = w1; *(u32x2*)(KR + (size_t)row * 64 + 32 + i0) = w2; }
            }
            return;
        }
        bf16_t* dst; int ldc, cbase = 0; int act = 0;
        float scale = 1.f; int stat = 0; float* stp = nullptr; const float* bias = nullptr;
        if (mode == M_GELU)           { dst = (bf16_t*)(ws + WS_UG); ldc = D; cbase = pn * 256; act = 1; }
        else if (mode == M_GELU_STAT) { dst = (bf16_t*)(ws + WS_VG); ldc = D; cbase = (pn - 8) * 256; act = 1; stat = 2; stp = (float*)(ws + WS_VST) + (size_t)((pn - 8) * 4 + wc) * S * 2; }
        else if (mode == M_SILU)      { act = 2; ldc = D; if (pn < 24) { dst = (bf16_t*)(ws + WS_ZA); cbase = (pn - 16) * 256; } else if (pn < 37) { dst = (bf16_t*)dout; cbase = (pn - 29) * 256; } else { dst = (bf16_t*)dout + (size_t)S * D; cbase = (pn - 45) * 256; } }
        else if (mode == M_RAW_SS)    { ldc = 512; stat = 1; if (pn < 26) { dst = (bf16_t*)(ws + WS_CQ); cbase = (pn - 24) * 256; stp = (float*)(ws + WS_CQST) + (size_t)((pn - 24) * 4 + wc) * S; }
                                        else { dst = (bf16_t*)(ws + WS_CKV); cbase = (pn - 26) * 256; stp = (float*)(ws + WS_CKVST) + (size_t)((pn - 26) * 4 + wc) * S; } }
        else if (mode == M_QM)        { const int t = pn - 37; dst = (bf16_t*)(ws + WS_QMH) + (size_t)(t >> 1) * S * 512; ldc = 512; cbase = (t & 1) * 256; scale = MSCALE; }
        else if (mode == M_GATE)      { dst = (bf16_t*)(ws + WS_G); ldc = 3 * D; cbase = (pn - 53) * 256; act = 3; bias = bgate + cbase; }
        else if (mode == M_MEMK)      { dst = (bf16_t*)(ws + WS_KMH) + (size_t)(pn >> 1) * ML * 512; ldc = 512; cbase = (pn & 1) * 256; }
        else                          { dst = (bf16_t*)(ws + WS_VMT); ldc = ML; cbase = 0; }
#pragma unroll
        for (int ai = 0; ai < 2; ++ai)
#pragma unroll
            for (int m = 0; m < 4; ++m) { const int rt = ai * 128 + wr * 64 + m * 16 + fr; float s1 = 0.f, s2 = 0.f;
#pragma unroll
                for (int bj = 0; bj < 2; ++bj) { const int ct = bj * 128 + wc * 32 + 8 * fq;
                    float v[8] = {acc[ai][bj][m][0][0], acc[ai][bj][m][0][1], acc[ai][bj][m][0][2], acc[ai][bj][m][0][3], acc[ai][bj][m][1][0], acc[ai][bj][m][1][1], acc[ai][bj][m][1][2], acc[ai][bj][m][1][3]};
                    if (act == 1) {
#pragma unroll
                        for (int j = 0; j < 8; ++j) v[j] = act_gelu(v[j]);
                    } else if (act == 2) {
#pragma unroll
                        for (int j = 0; j < 8; ++j) v[j] = act_silu(v[j]);
                    } else if (act == 3) { const f32x4 b0 = *(const f32x4*)(bias + ct), b1 = *(const f32x4*)(bias + ct + 4);
#pragma unroll
                        for (int j = 0; j < 4; ++j) { v[j] = act_sigmoid(v[j] + b0[j]); v[4 + j] = act_sigmoid(v[4 + j] + b1[j]); }
                    } else {
#pragma unroll
                        for (int j = 0; j < 8; ++j) v[j] *= scale;
                    }
                    if (stat) {
#pragma unroll
                        for (int j = 0; j < 8; ++j) { s1 += v[j]; s2 += v[j] * v[j]; }
                    }
                    *(u32x4*)(dst + (size_t)(row0 + rt) * ldc + cbase + ct) = pack8(v);
                }
                if (stat) { s1 += __shfl_xor(s1, 16); s1 += __shfl_xor(s1, 32); s2 += __shfl_xor(s2, 16); s2 += __shfl_xor(s2, 32);
                    if (fq == 0) { if (stat == 2) *(f32x2*)(stp + (size_t)(row0 + rt) * 2) = (f32x2){s1, s2}; else stp[row0 + rt] = s2; } }
            }
    }
};

struct SchedP1 {
    const unsigned char* ws; int G, c;
    __device__ __forceinline__ bool next(int i, Unit& u) const {
        const int L = i * G + c; constexpr int NMAIN = 32 * NT_IN;
        if (L >= NMAIN + 16) return false;
        if (L < NMAIN) { const int wg = (L % 8) * (NMAIN / 8) + L / 8; constexpr int nig = 8 * NT_IN; const int gid = wg / nig, w = wg % nig; const int pm = gid * 8 + (w % 8), pn = w / 8;
            u.pm = pm; u.pn = pn; u.A = (const char*)(ws + WS_H) + (size_t)pm * 256 * D * 2; u.B = (const char*)(ws + WS_WIN) + (size_t)pn * 256 * D * 2;
            u.mode = pn < 8 ? M_GELU : pn < 16 ? M_GELU_STAT : pn < 24 ? M_SILU : pn < 28 ? M_RAW_SS : pn == 28 ? M_KROPE : pn < 37 ? M_SILU : pn < 45 ? M_QM : pn < 53 ? M_SILU : M_GATE; }
        else if (L < NMAIN + 8) { const int pn = L - NMAIN; u.pm = 0; u.pn = pn; u.A = (const char*)(ws + WS_MEMN); u.B = (const char*)(ws + WS_WMEM) + (size_t)pn * 256 * D * 2; u.mode = M_MEMK; }
        else { const int pm = L - NMAIN - 8; u.pm = pm; u.pn = 0; u.A = (const char*)(ws + WS_WMEM) + (size_t)(2048 + pm * 256) * D * 2; u.B = (const char*)(ws + WS_MEMN); u.mode = M_MEMV; }
        return true;
    }
};

struct EpiP2 {
    __device__ __forceinline__ bool keep_acc(const Unit&) const { return false; }
    unsigned char* ws; LAS float* xch;
    __device__ __forceinline__ void operator()(f32x4 (&acc)[2][2][4][2], const Unit& u, int wr, int wc, int fr, int fq) const {
        const int mode = u.mode, row0 = u.pm * 256;
        if (mode == M_MEMS) {
            LAS float* XM = xch; LAS float* XS = xch + 1024;
#pragma unroll
            for (int ai = 0; ai < 2; ++ai)
#pragma unroll
                for (int m = 0; m < 4; ++m) { float t = -1e30f;
#pragma unroll
                    for (int bj = 0; bj < 2; ++bj)
#pragma unroll
                        for (int n = 0; n < 2; ++n) { const f32x4 x = acc[ai][bj][m][n]; t = fmaxf(t, fmaxf(fmaxf(x[0], x[1]), fmaxf(x[2], x[3]))); }
                    t = fmaxf(t, __shfl_xor(t, 16)); t = fmaxf(t, __shfl_xor(t, 32));
                    if (fq == 0) XM[(ai * 128 + wr * 64 + m * 16 + fr) * 4 + wc] = t; }
            asm volatile("s_waitcnt lgkmcnt(0)" ::: "memory"); __builtin_amdgcn_s_barrier(); asm volatile("" ::: "memory");
#pragma unroll
            for (int ai = 0; ai < 2; ++ai)
#pragma unroll
                for (int m = 0; m < 4; ++m) { const int rt = ai * 128 + wr * 64 + m * 16 + fr; const f32x4 q = *(const LAS f32x4*)(XM + rt * 4);
                    const float mxr = fmaxf(fmaxf(q[0], q[1]), fmaxf(q[2], q[3])); float s = 0.f;
#pragma unroll
                    for (int bj = 0; bj < 2; ++bj)
#pragma unroll
                        for (int n = 0; n < 2; ++n)
#pragma unroll
                            for (int e = 0; e < 4; ++e) { const float x = fast_exp2(acc[ai][bj][m][n][e] - mxr); acc[ai][bj][m][n][e] = x; s += x; }
                    s += __shfl_xor(s, 16); s += __shfl_xor(s, 32);
                    if (fq == 0) XS[rt * 4 + wc] = s; }
            asm volatile("s_waitcnt lgkmcnt(0)" ::: "memory"); __builtin_amdgcn_s_barrier(); asm volatile("" ::: "memory");
            bf16_t* P = (bf16_t*)(ws + WS_P) + (size_t)u.pn * S * 256;
#pragma unroll
            for (int ai = 0; ai < 2; ++ai)
#pragma unroll
                for (int m = 0; m < 4; ++m) { const int rt = ai * 128 + wr * 64 + m * 16 + fr; const f32x4 q = *(const LAS f32x4*)(XS + rt * 4);
                    const float iv = fast_rcp((q[0] + q[1]) + (q[2] + q[3]));
#pragma unroll
                    for (int bj = 0; bj < 2; ++bj) { float v[8];
#pragma unroll
                        for (int j = 0; j < 8; ++j) v[j] = acc[ai][bj][m][j >> 2][j & 3] * iv;
                        *(u32x4*)(P + (size_t)(row0 + rt) * 256 + bj * 128 + wc * 32 + 8 * fq) = pack8(v); } }
            return;
        }
        const float* stp = (const float*)(ws + (mode == M_QUP ? WS_CQST : WS_CKVST));
        const f32x2* CS = (const f32x2*)(ws + WS_CS);
        LAS float* RS = xch + 2048 + 64;
        { const int t_ = ((wr * 4 + wc) * 4 + fq) * 16 + fr;
          if (t_ < 256) { float ss = 0.f;
#pragma unroll
              for (int j = 0; j < 8; ++j) ss += stp[(size_t)j * S + row0 + t_];
              RS[t_] = 1.0f / sqrtf(ss * (1.f / 512.f) + EPS); }
          asm volatile("s_waitcnt lgkmcnt(0)" ::: "memory"); __builtin_amdgcn_s_barrier(); asm volatile("" ::: "memory"); }
#pragma unroll
        for (int ai = 0; ai < 2; ++ai)
#pragma unroll
            for (int m = 0; m < 4; ++m) { const int row = row0 + ai * 128 + wr * 64 + m * 16 + fr;
                const float rs = RS[ai * 128 + wr * 64 + m * 16 + fr];
#pragma unroll
                for (int bj = 0; bj < 2; ++bj) { const int ct = bj * 128 + wc * 32 + 8 * fq;
                    float v[8] = {acc[ai][bj][m][0][0], acc[ai][bj][m][0][1], acc[ai][bj][m][0][2], acc[ai][bj][m][0][3], acc[ai][bj][m][1][0], acc[ai][bj][m][1][1], acc[ai][bj][m][1][2], acc[ai][bj][m][1][3]};
#pragma unroll
                    for (int j = 0; j < 8; ++j) v[j] *= rs;
                    if (mode == M_QUP) { const int cg = u.pn * 256 + ct, head = cg / DQK, w = cg - head * DQK;
                        bf16_t* q = (bf16_t*)(ws + WS_QB) + ((size_t)head * S + row) * DQK;
                        if (w < 128) *(u32x4*)(q + w) = pack8(v);
                        else { const int i0 = (w - 128) >> 1; float o1[4], o2[4];
#pragma unroll
                            for (int j = 0; j < 4; ++j) { const f32x2 cs = CS[row * 32 + i0 + j]; const float t1 = v[2 * j], t2 = v[2 * j + 1]; o1[j] = t1 * cs.x - t2 * cs.y; o2[j] = t2 * cs.x + t1 * cs.y; }
                            u32x2 w1, w2; w1.x = cvt_pk_bf16(o1[0], o1[1]); w1.y = cvt_pk_bf16(o1[2], o1[3]); w2.x = cvt_pk_bf16(o2[0], o2[1]); w2.y = cvt_pk_bf16(o2[2], o2[3]);
                            *(u32x2*)(q + 128 + i0) = w1; *(u32x2*)(q + 160 + i0) = w2; } }
                    else { const int head = u.pn;
                        if (bj == 0) *(u32x4*)((bf16_t*)(ws + WS_KB) + ((size_t)head * S + row) * DQK + wc * 32 + 8 * fq) = pack8(v);
                        else *(u32x4*)((bf16_t*)(ws + WS_VB) + ((size_t)head * S + row) * DV + wc * 32 + 8 * fq) = pack8(v); }
                }
                if (mode == M_KVUP && wc < 2) {
                    const u32x4 kr = *(const u32x4*)((const bf16_t*)(ws + WS_KR) + (size_t)row * 64 + (wc * 4 + fq) * 8);
                    *(u32x4*)((bf16_t*)(ws + WS_KB) + ((size_t)u.pn * S + row) * DQK + 128 + (wc * 4 + fq) * 8) = kr; }
            }
    }
};
struct SchedP2 {
    const unsigned char* ws; int G, c;
    __device__ __forceinline__ bool next(int i, Unit& u) const {
        if (i >= 4 || c >= 256) return false;
        const int x = c & 7, l = i * 32 + (c >> 3);
        if (l < 48) { const int pm = 4 * x + (l & 3), pn = l >> 2; u.pm = pm; u.pn = pn; u.mode = M_QUP; u.A = (const char*)(ws + WS_CQ) + (size_t)pm * 256 * 512 * 2; u.B = (const char*)(ws + WS_WUQ) + (size_t)pn * 256 * 512 * 2; }
        else if (l < 112) { const int l2 = l - 48, pm = 4 * x + (l2 & 3), pn = l2 >> 2; u.pm = pm; u.pn = pn; u.mode = M_KVUP; u.A = (const char*)(ws + WS_CKV) + (size_t)pm * 256 * 512 * 2; u.B = (const char*)(ws + WS_WUKV) + (size_t)pn * 256 * 512 * 2; }
        else { const int l2 = l - 112, pm = 4 * x + (l2 & 3), h = l2 >> 2; u.pm = pm; u.pn = h; u.mode = M_MEMS; u.A = (const char*)(ws + WS_QMH) + ((size_t)h * S + pm * 256) * 512 * 2; u.B = (const char*)(ws + WS_KMH) + (size_t)h * ML * 512 * 2; }
        return true;
    }
};

struct EpiMulZ {
    __device__ __forceinline__ bool keep_acc(const Unit&) const { return false; }
    unsigned char* dout;
    __device__ __forceinline__ void operator()(f32x4 (&acc)[2][2][4][2], const Unit& u, int wr, int wc, int fr, int fq) const {
        bf16_t* Z = (bf16_t*)dout + (size_t)S * D; const int row0 = u.pm * 256, cb = u.pn * 256;
        EPI_LOOP_BEGIN
            bf16_t* p = Z + (size_t)(row0 + rt) * D + cb + ct; float z[8]; unpack8(*(const u32x4*)p, z);
#pragma unroll
            for (int j = 0; j < 8; ++j) v[j] *= z[j];
            *(u32x4*)p = pack8(v);
        EPI_LOOP_END
    }
};
struct SchedP3b {
    const unsigned char* ws; int G, c;
    __device__ __forceinline__ bool next(int i, Unit& u) const {
        const int L = i * G + c; if (L >= 256) return false;
        const int pm = L >> 3, hn = L & 7, h = hn >> 1; u.pm = pm; u.pn = hn; u.mode = M_MULZ;
        u.A = (const char*)(ws + WS_P) + ((size_t)h * S + pm * 256) * 256 * 2; u.B = (const char*)(ws + WS_VMT) + (size_t)hn * 256 * 256 * 2; return true;
    }
};

struct EpiP4 {
    unsigned char* ws;
    __device__ __forceinline__ bool keep_acc(const Unit& u) const { return u.mode != M_BR2; }
    __device__ __forceinline__ void operator()(f32x4 (&acc)[2][2][4][2], const Unit& u, int wr, int wc, int fr, int fq) const {
        const int n = u.mode - M_BR0, row0 = u.pm * 256, cb = u.pn * 256;
        const bf16_t* G = (const bf16_t*)(ws + WS_G) + (size_t)n * D; bf16_t* MG = (bf16_t*)(ws + WS_MERGED); constexpr float GMIN = 9.094947e-13f;
#pragma unroll
        for (int ai = 0; ai < 2; ++ai) {
            u32x4 ga[4][2], gb[4][2];
#pragma unroll
            for (int m = 0; m < 4; ++m)
#pragma unroll
                for (int bj = 0; bj < 2; ++bj) { const size_t r = (size_t)(row0 + ai * 128 + wr * 64 + m * 16 + fr); const bf16_t* gp = G + r * 3 * D + cb + bj * 128 + wc * 32 + 8 * fq;
                    ga[m][bj] = *(const u32x4*)gp; if (n < 2) gb[m][bj] = *(const u32x4*)(gp + D); }
#pragma unroll
            for (int m = 0; m < 4; ++m)
#pragma unroll
                for (int bj = 0; bj < 2; ++bj) { float g[8]; unpack8(ga[m][bj], g);
                    if (n < 2) { float gn[8]; unpack8(gb[m][bj], gn);
#pragma unroll
                        for (int j = 0; j < 8; ++j) acc[ai][bj][m][j >> 2][j & 3] *= fmaxf(g[j], GMIN) * fast_rcp(fmaxf(gn[j], GMIN)); }
                    else { float v[8]; const size_t r = (size_t)(row0 + ai * 128 + wr * 64 + m * 16 + fr);
#pragma unroll
                        for (int j = 0; j < 8; ++j) v[j] = acc[ai][bj][m][j >> 2][j & 3] * fmaxf(g[j], GMIN);
                        *(u32x4*)(MG + r * D + cb + bj * 128 + wc * 32 + 8 * fq) = pack8(v); } }
        }
    }
};
struct SchedP4 {
    const unsigned char* ws; const unsigned char* dout; int G, c;
    __device__ __forceinline__ bool next(int i, Unit& u) const {
        if (i >= 3 || c >= 256) return false;
        const int vc = (c % 8) * 32 + c / 8, pm = vc / 8, pn = vc % 8; u.pm = pm; u.pn = pn; u.mode = M_BR0 + i;
        const unsigned char* y = i == 0 ? ws + WS_UG : i == 1 ? dout : dout + (size_t)S * D * 2;
        u.A = (const char*)y + (size_t)pm * 256 * D * 2; u.B = (const char*)(ws + WS_WBR) + ((size_t)i * D + pn * 256) * D * 2; return true;
    }
};

struct EpiP5 {
    __device__ __forceinline__ bool keep_acc(const Unit&) const { return false; }
    unsigned char* ws; float* out;
    __device__ __forceinline__ void operator()(f32x4 (&acc)[2][2][4][2], const Unit& u, int wr, int wc, int fr, int fq) const {
        const int row0 = u.pm * 256, cb = u.pn * 256; float* st = (float*)(ws + WS_OST) + (size_t)(u.pn * 4 + wc) * S;
#pragma unroll
        for (int ai = 0; ai < 2; ++ai)
#pragma unroll
            for (int m = 0; m < 4; ++m) { const int rt = ai * 128 + wr * 64 + m * 16 + fr; float s2 = 0.f;
#pragma unroll
                for (int bj = 0; bj < 2; ++bj) { const int ct = bj * 128 + wc * 32 + 8 * fq; const f32x4 a = acc[ai][bj][m][0], b = acc[ai][bj][m][1];
                    s2 += (a[0] * a[0] + a[1] * a[1]) + (a[2] * a[2] + a[3] * a[3]) + (b[0] * b[0] + b[1] * b[1]) + (b[2] * b[2] + b[3] * b[3]);
                    const float v_[8] = {a[0], a[1], a[2], a[3], b[0], b[1], b[2], b[3]}; *(u32x4*)((bf16_t*)(ws + WS_MP) + (size_t)(row0 + rt) * D + cb + ct) = pack8(v_); }
                s2 += __shfl_xor(s2, 16); s2 += __shfl_xor(s2, 32);
                if (fq == 0) st[row0 + rt] = s2; }
    }
};
struct SchedP5 {
    const unsigned char* ws; int G, c;
    __device__ __forceinline__ bool next(int i, Unit& u) const {
        if (i >= 1 || c >= 256) return false;
        const int vc = (c % 8) * 32 + c / 8, pm = vc / 8, pn = vc % 8; u.pm = pm; u.pn = pn; u.mode = M_OUT;
        u.A = (const char*)(ws + WS_MERGED) + (size_t)pm * 256 * D * 2; u.B = (const char*)(ws + WS_WOUT) + (size_t)pn * 256 * D * 2; return true;
    }
};

enum { MAP_ID = 0, MAP_WIN, MAP_UQ };
__device__ __forceinline__ int map_row(int map, int n) {
    if (map == MAP_WIN) { if (n < 7168) return n; if (n < 7232) { const int i = n - 7168; return 7168 + (i < 32 ? 2 * i : 2 * (i - 32) + 1); } return n + 192; }
    if (map == MAP_UQ) { const int h = n / DQK, w = n - h * DQK; if (w < 128) return n; const int i = w - 128; return h * DQK + 128 + (i < 32 ? 2 * i : 2 * (i - 32) + 1); }
    return n;
}
struct WTile { const float* W; bf16_t* WT; const float* kgain; int K, N, row_off, map, k0, n0; float sc; };
struct WSeg { const float* W; bf16_t* WT; const float* kgain; int K, N, row_off, map; float sc; };
__device__ __forceinline__ WTile wtile_of(const WSeg& s, int r) { WTile t; t.W = s.W; t.WT = s.WT; t.kgain = s.kgain; t.K = s.K; t.N = s.N; t.row_off = s.row_off; t.map = s.map; t.sc = s.sc;
    const int nblk = s.N / 64; t.k0 = 64 * (r / nblk); t.n0 = 64 * (r % nblk); return t; }
__device__ __forceinline__ void wtile_issue(const WTile& t, f32x4 (&r)[16], int lane) {
    const float* p = t.W + (size_t)(t.k0 + (lane >> 4)) * t.N + t.n0 + 4 * (lane & 15);
#pragma unroll
    for (int q = 0; q < 16; ++q) r[q] = *(const f32x4*)(p + (size_t)(4 * q) * t.N);
}
__device__ __forceinline__ void wtile_finish(const WTile& t, const f32x4 (&r)[16], LAS float* scr, int lane) {
#pragma unroll
    for (int q = 0; q < 16; ++q) { const int k = 4 * q + (lane >> 4); f32x4 v = r[q] * t.sc; if (t.kgain) v = v * t.kgain[t.k0 + k];
        *(LAS f32x4*)(scr + k * 64 + ((4 * (lane & 15)) ^ (((k >> 3) & 7) << 3))) = v; }
    asm volatile("s_waitcnt lgkmcnt(0)" ::: "memory");
    const int c = lane & 7;
#pragma unroll
    for (int j = 0; j < 8; ++j) { const int n = (lane >> 3) + 8 * j; const LAS float* s = scr + (8 * c) * 64 + (n ^ (c << 3));
        u32x4 o; o.x = cvt_pk_bf16(s[0 * 64], s[1 * 64]); o.y = cvt_pk_bf16(s[2 * 64], s[3 * 64]); o.z = cvt_pk_bf16(s[4 * 64], s[5 * 64]); o.w = cvt_pk_bf16(s[6 * 64], s[7 * 64]);
        *(u32x4*)(t.WT + (size_t)(t.row_off + map_row(t.map, t.n0 + n)) * t.K + t.k0 + 8 * c) = o; }
    asm volatile("s_waitcnt lgkmcnt(0)" ::: "memory");
}
template <int NSEG> __device__ __forceinline__ WTile wtile_decode(const WSeg (&seg)[NSEG], int it) {
    int r = it;
#pragma unroll
    for (int s = 0; s < NSEG - 1; ++s) { const int cnt = (seg[s].K / 64) * (seg[s].N / 64); if (r < cnt) return wtile_of(seg[s], r); r -= cnt; }
    return wtile_of(seg[NSEG - 1], r);
}
template <int NSEG> __device__ __forceinline__ void wconv_run(const WSeg (&seg)[NSEG], int ntiles, int it0, int stride, LAS float* scr, int lane) {
    if (it0 >= ntiles) return;
    f32x4 ra[16], rb[16];
    WTile ta = wtile_decode(seg, it0), tb = ta; wtile_issue(ta, ra, lane);
    for (int it = it0; it < ntiles; it += 2 * stride) {
        const bool hb = it + stride < ntiles; if (hb) { tb = wtile_decode(seg, it + stride); wtile_issue(tb, rb, lane); }
        wtile_finish(ta, ra, scr, lane);
        if (!hb) break;
        const bool ha = it + 2 * stride < ntiles; if (ha) { ta = wtile_decode(seg, it + 2 * stride); wtile_issue(ta, ra, lane); }
        wtile_finish(tb, rb, scr, lane);
    }
}
__device__ __forceinline__ void rms_row_to_bf16(const float* xrow, const float* g, bf16_t* orow, int lane) {
    const f32x4* xr = (const f32x4*)xrow + lane; const f32x4* gr = (const f32x4*)g + lane;
    f32x4 v[8]; float s = 0.f;
#pragma unroll
    for (int j = 0; j < 8; ++j) { v[j] = xr[64 * j]; s += (v[j].x * v[j].x + v[j].y * v[j].y) + (v[j].z * v[j].z + v[j].w * v[j].w); }
    const float rs = 1.0f / sqrtf(wave_sum(s) * (1.f / D) + EPS);
    u32x2* o8 = (u32x2*)orow + lane;
#pragma unroll
    for (int j = 0; j < 8; ++j) { const f32x4 gg = gr[64 * j]; u32x2 w; w.x = cvt_pk_bf16(v[j].x * rs * gg.x, v[j].y * rs * gg.y); w.y = cvt_pk_bf16(v[j].z * rs * gg.z, v[j].w * rs * gg.w); o8[64 * j] = w; }
}
__device__ __forceinline__ void phase0(const Ptrs& P, LAS unsigned char* lds, int vcu, int G, int tid, int lane, int wave) {
    unsigned char* ws = P.ws;
    LAS float* scr = (LAS float*)(lds + wave * 16384);
    const int gw = vcu * NWAVES + wave, NGW = G * NWAVES;
    { const WSeg seg[5] = {
          {P.in[4], (bf16_t*)(ws + WS_WIN), nullptr, D, IN_TOTAL, 0, MAP_WIN, 1.f},
          {P.in[15], (bf16_t*)(ws + WS_WIN), nullptr, D, 6144, 53 * 256, MAP_ID, 1.f},
          {P.in[10], (bf16_t*)(ws + WS_WUQ), P.in[9], 512, 3072, 0, MAP_UQ, QSCALE},
          {P.in[12], (bf16_t*)(ws + WS_WUKV), P.in[11], 512, 4096, 0, MAP_ID, 1.f},
          {P.in[14], (bf16_t*)(ws + WS_WMEM), nullptr, D, 4096, 0, MAP_ID, 1.f}};
      constexpr int NT0 = 32 * (IN_TOTAL / 64) + 32 * 96 + 8 * 48 + 8 * 64 + 32 * 64;
      wconv_run(seg, NT0, gw, NGW, scr, lane); }
    { u32x4* z = (u32x4*)((bf16_t*)(ws + WS_WIN) + (size_t)7232 * D); const int n16 = 192 * D * 2 / 16;
      for (int i = vcu * NTHREADS + tid; i < n16; i += G * NTHREADS) z[i] = (u32x4){0u, 0u, 0u, 0u}; }
    const int gwr = gw >= 416 ? gw - 416 : gw + NGW - 416;
    for (int m = gwr; m < S + ML; m += NGW) {
        if (m < S) rms_row_to_bf16(P.in[0] + (size_t)m * D, P.in[3], (bf16_t*)(ws + WS_H) + (size_t)m * D, lane);
        else rms_row_to_bf16(P.in[1] + (size_t)(m - S) * D, P.in[13], (bf16_t*)(ws + WS_MEMN) + (size_t)(m - S) * D, lane);
    }
    { const int* pos = (const int*)P.in[2]; f32x2* CS = (f32x2*)(ws + WS_CS);
      for (int e = vcu * NTHREADS + tid; e < S * 32; e += G * NTHREADS) { const int row = e >> 5, i = e & 31;
          const double inv = exp2(-(double)i * (13.287712379549449 / 32.0));
          const float invf = (float)inv; const float angf = (float)pos[row] * invf;
          const double a = (double)angf; const double k = rint(a * 0.15915494309189535); const float r = (float)(a - k * 6.283185307179586);
          CS[e] = (f32x2){__cosf(r), __sinf(r)}; } }
    { const float* w = P.in[7]; bf16_t* o = (bf16_t*)(ws + WS_WSM);
      for (int e = vcu * NTHREADS + tid; e < 16 * 128 * 128 / 2; e += G * NTHREADS) { const int idx = e * 2, t = (idx >> 7) & 127, s = idx & 127;
          const float a = s <= t ? w[idx] : 0.f, b = (s + 1) <= t ? w[idx + 1] : 0.f; ((unsigned*)o)[e] = cvt_pk_bf16(a, b); } }
}
__device__ __forceinline__ void phase_wconv2(const Ptrs& P, LAS unsigned char* lds, int wg0, int nwg, int lane, int wave) {
    unsigned char* ws = P.ws; LAS float* scr = (LAS float*)(lds + wave * 16384);
    const int gw = wg0 * NWAVES + wave, NGW = nwg * NWAVES;
    const WSeg seg[4] = {
        {P.in[17], (bf16_t*)(ws + WS_WBR), nullptr, D, D, 0, MAP_ID, 1.f},
        {P.in[17] + (size_t)D * D, (bf16_t*)(ws + WS_WBR), nullptr, D, D, D, MAP_ID, 1.f},
        {P.in[17] + (size_t)2 * D * D, (bf16_t*)(ws + WS_WBR), nullptr, D, D, 2 * D, MAP_ID, 1.f},
        {P.in[18], (bf16_t*)(ws + WS_WOUT), nullptr, D, D, 0, MAP_ID, 1.f}};
    wconv_run(seg, 4 * 32 * 32, gw, NGW, scr, lane);
}

namespace att {
constexpr int NW = 8, QBLK = 32, KVBLK = 64, QB = 256;
constexpr int SHM_V = KVBLK * DV * 2, SHM_K = KVBLK * DQK * 2;
constexpr float THR = 6.f;
#define SBAR() __builtin_amdgcn_sched_barrier(0)
#define KSWZ(row, colB) ((row) * 384 + ((colB) ^ ((((row) >> 1) & 7) << 4)))
__device__ __forceinline__ int v_st(int k, int c) { const int kk = (k & ~0xC) | ((k & 4) << 1) | ((k & 8) >> 1); return ((kk >> 3) * 4 + (c >> 5)) * 512 + ((kk & 7) * 32 + (c & 31)) * 2; }
__device__ __forceinline__ int v_rd_base(int lane) { return ((lane & 3) << 3) | (((lane >> 2) & 3) << 6) | (((lane >> 4) & 1) << 5) | (((lane >> 5) & 1) << 8); }
constexpr int v_rd_off(int d0, int ks, int half) { return d0 * 512 + ks * 4096 + half * 2048; }
__device__ __forceinline__ int crow(int r, int hi) { return (r & 3) + 8 * (r >> 2) + 4 * hi; }
__device__ __forceinline__ void mask_tile(f32x16& p0, f32x16& p1, int dq) {
    const float NEG = -__builtin_inff();
#pragma unroll
    for (int r = 0; r < 16; ++r) { const int c = (r & 3) + 8 * (r >> 2); if (dq - c < 0) p0[r] = NEG; if (dq - c - 32 < 0) p1[r] = NEG; }
}
__device__ __forceinline__ void partialSM(f32x16& p0, f32x16& p1, float& m_reg, float& mn, float& alpha) {
    float pmax = p0[0];
#pragma unroll
    for (int r = 1; r < 16; ++r) pmax = fmaxf(pmax, p0[r]);
#pragma unroll
    for (int r = 0; r < 16; ++r) pmax = fmaxf(pmax, p1[r]);
    { auto rr = __builtin_amdgcn_permlane32_swap(__float_as_uint(pmax), __float_as_uint(pmax), false, false); pmax = fmaxf(__uint_as_float(rr[0]), __uint_as_float(rr[1])); }
    if (__builtin_expect(__all((pmax - m_reg) <= THR), 1)) { mn = m_reg; alpha = 1.f; }
    else { mn = fmaxf(m_reg, pmax); alpha = fast_exp2(m_reg - mn); m_reg = mn; }
#pragma unroll
    for (int r = 0; r < 16; ++r) p0[r] = p0[r] - mn;
#pragma unroll
    for (int r = 0; r < 16; ++r) p1[r] = p1[r] - mn;
#pragma unroll
    for (int r = 0; r < 16; ++r) p0[r] = fast_exp2(p0[r]);
}
__device__ __forceinline__ void finishSM(f32x16& p0, f32x16& p1, float alpha, float& l_reg, bf16x8& pa0, bf16x8& pa1, bf16x8& pa2, bf16x8& pa3) {
#pragma unroll
    for (int r = 0; r < 16; ++r) p1[r] = fast_exp2(p1[r]);
    float ps = 0;
#pragma unroll
    for (int r = 0; r < 16; ++r) ps += p0[r];
#pragma unroll
    for (int r = 0; r < 16; ++r) ps += p1[r];
    { auto rr = __builtin_amdgcn_permlane32_swap(__float_as_uint(ps), __float_as_uint(ps), false, false); ps = __uint_as_float(rr[0]) + __uint_as_float(rr[1]); }
    l_reg = l_reg * alpha + ps;
#define PK4(P, B_, OUT) do { unsigned a0 = cvt_pk_bf16(P[B_+0], P[B_+1]), a1 = cvt_pk_bf16(P[B_+2], P[B_+3]); unsigned b0 = cvt_pk_bf16(P[B_+4], P[B_+5]), b1 = cvt_pk_bf16(P[B_+6], P[B_+7]); \
        auto r0 = __builtin_amdgcn_permlane32_swap(a0, b0, false, false); auto r1 = __builtin_amdgcn_permlane32_swap(a1, b1, false, false); \
        u32x4 w = {r0[0], r1[0], r0[1], r1[1]}; OUT = *reinterpret_cast<bf16x8*>(&w); } while (0)
    PK4(p0, 0, pa0); PK4(p0, 8, pa1); PK4(p1, 0, pa2); PK4(p1, 8, pa3);
#undef PK4
}
#define TRRD(dst, off) asm volatile("ds_read_b64_tr_b16 %0, %1 offset:%2" : "=&v"(dst) : "v"(vb0), "i"(off) : "memory")
#define PV_D0(OO, VBOFF, d0) do { s16x4 l0, l1, l2, l3, h0, h1, h2, h3; constexpr int b_ = (VBOFF) + v_rd_off(d0, 0, 0); \
        TRRD(l0, b_); TRRD(h0, b_ + 2048); TRRD(l1, b_ + 4096); TRRD(h1, b_ + 6144); TRRD(l2, b_ + 8192); TRRD(h2, b_ + 10240); TRRD(l3, b_ + 12288); TRRD(h3, b_ + 14336); \
        asm volatile("s_waitcnt lgkmcnt(0)" ::: "memory"); SBAR(); \
        OO = __builtin_amdgcn_mfma_f32_32x32x16_bf16(pa0, (bf16x8){l0[0], l0[1], l0[2], l0[3], h0[0], h0[1], h0[2], h0[3]}, OO, 0, 0, 0); \
        OO = __builtin_amdgcn_mfma_f32_32x32x16_bf16(pa1, (bf16x8){l1[0], l1[1], l1[2], l1[3], h1[0], h1[1], h1[2], h1[3]}, OO, 0, 0, 0); \
        OO = __builtin_amdgcn_mfma_f32_32x32x16_bf16(pa2, (bf16x8){l2[0], l2[1], l2[2], l2[3], h2[0], h2[1], h2[2], h2[3]}, OO, 0, 0, 0); \
        OO = __builtin_amdgcn_mfma_f32_32x32x16_bf16(pa3, (bf16x8){l3[0], l3[1], l3[2], l3[3], h3[0], h3[1], h3[2], h3[3]}, OO, 0, 0, 0); } while (0)
__device__ __forceinline__ void glds16(const void* gsrc, unsigned lds_dst) { unsigned keep;
    asm volatile("s_mov_b32 %0, m0\n\ts_mov_b32 m0, %2\n\ts_nop 0\n\tglobal_load_lds_dwordx4 %1, off\n\ts_mov_b32 m0, %0" : "=&s"(keep) : "v"(gsrc), "s"(lds_dst) : "memory"); }
typedef short v4i16_t __attribute__((ext_vector_type(4)));
__device__ __forceinline__ s16x4 vtr(const LAS char* p) { return __builtin_bit_cast(s16x4, __builtin_amdgcn_ds_read_tr16_b64_v4i16((LAS v4i16_t*)p)); }
__device__ __forceinline__ void pv_tile2(f32x16* o, const LAS char* vp, bf16x8 pa0, bf16x8 pa1, bf16x8 pa2, bf16x8 pa3) {
#pragma unroll
    for (int d0 = 0; d0 < 4; ++d0) {
        const s16x4 l0 = vtr(vp + d0 * 512), h0 = vtr(vp + d0 * 512 + 2048), l1 = vtr(vp + d0 * 512 + 4096), h1 = vtr(vp + d0 * 512 + 6144);
        const s16x4 l2 = vtr(vp + d0 * 512 + 8192), h2 = vtr(vp + d0 * 512 + 10240), l3 = vtr(vp + d0 * 512 + 12288), h3 = vtr(vp + d0 * 512 + 14336);
        o[d0] = __builtin_amdgcn_mfma_f32_32x32x16_bf16(pa0, (bf16x8){l0[0], l0[1], l0[2], l0[3], h0[0], h0[1], h0[2], h0[3]}, o[d0], 0, 0, 0);
        o[d0] = __builtin_amdgcn_mfma_f32_32x32x16_bf16(pa1, (bf16x8){l1[0], l1[1], l1[2], l1[3], h1[0], h1[1], h1[2], h1[3]}, o[d0], 0, 0, 0);
        o[d0] = __builtin_amdgcn_mfma_f32_32x32x16_bf16(pa2, (bf16x8){l2[0], l2[1], l2[2], l2[3], h2[0], h2[1], h2[2], h2[3]}, o[d0], 0, 0, 0);
        o[d0] = __builtin_amdgcn_mfma_f32_32x32x16_bf16(pa3, (bf16x8){l3[0], l3[1], l3[2], l3[3], h3[0], h3[1], h3[2], h3[3]}, o[d0], 0, 0, 0); }
}
constexpr int OFF3_V = 0, OFF3_K = 4 * SHM_V, OFF3_WS = OFF3_K + 3 * SHM_K + 256;
__device__ __forceinline__ void attn_block3(const bf16_t* Qh, const bf16_t* Kh, const bf16_t* Vh, bf16_t* ZY, int P0, char* lds, const int tid) {
    const int wid = __builtin_amdgcn_readfirstlane(tid >> 6), lane = tid & 63, r32 = lane & 31, hi = lane >> 5;
    const bool lag = wid >= 4;
    const int NT = (P0 + QB) / KVBLK;
    const int qlo = P0 + wid * QBLK, qm = qlo + r32 - 4 * hi;
    char* K_lds = lds + OFF3_K;
    float* wsf = (float*)(lds + OFF3_WS) + wid * 64; float* li_l = wsf, * al_l = wsf + 32;
    float m_reg = -1e30f, l_reg = 0; f32x16 o[4] = {};
    const unsigned lds0 = (unsigned)(uintptr_t)lds;
    int kso[3], vso[2];
#pragma unroll
    for (int j = 0; j < 3; ++j) { const int q = (wid * 3 + j) * 1024 + lane * 16, row = q / 384, pos = q - row * 384; kso[j] = row * 384 + (pos ^ (((row >> 1) & 7) << 4)); }
#pragma unroll
    for (int j = 0; j < 2; ++j) { const int q = (wid * 2 + j) * 1024 + lane * 16, sub = q >> 9, within = q & 511, kk = (sub >> 2) * 8 + (within >> 6), cc = (within & 63) >> 1;
        const int k = (kk & ~0xC) | ((kk & 4) << 1) | ((kk & 8) >> 1), c = (sub & 3) * 32 + cc; vso[j] = k * (DV * 2) + c * 2; }
    int kis = 0, vis = 0, kq = 0, vp = 0;
#define ROTK(x) ((x) == 2 * SHM_K ? 0 : (x) + SHM_K)
#define ROTV(x) ((x) == 3 * SHM_V ? 0 : (x) + SHM_V)
#define DMA_TILE(t) do { const char* kt_ = (const char*)Kh + (size_t)(t) * SHM_K; const char* vt_ = (const char*)Vh + (size_t)(t) * SHM_V; \
        _Pragma("unroll") for (int j_ = 0; j_ < 3; ++j_) glds16(kt_ + kso[j_], (unsigned)__builtin_amdgcn_readfirstlane(lds0 + OFF3_K + kis + (wid * 3 + j_) * 1024)); \
        _Pragma("unroll") for (int j_ = 0; j_ < 2; ++j_) glds16(vt_ + vso[j_], (unsigned)__builtin_amdgcn_readfirstlane(lds0 + OFF3_V + vis + (wid * 2 + j_) * 1024)); \
        kis = ROTK(kis); vis = ROTV(vis); } while (0)
#define END_M() asm volatile("s_waitcnt vmcnt(0) lgkmcnt(0)\n\ts_barrier" ::: "memory")
#define END_V() asm volatile("s_waitcnt lgkmcnt(0)\n\ts_barrier" ::: "memory")
    int ko[4];
#pragma unroll
    for (int dd = 0; dd < 4; ++dd) ko[dd] = KSWZ(r32, (dd * 16 + hi * 8) * 2);
    const LAS char* vbb = (const LAS char*)lds + OFF3_V + v_rd_base(lane);
    DMA_TILE(0); DMA_TILE(1);
    bf16x8 qr[12];
#pragma unroll
    for (int d0 = 0; d0 < 12; ++d0) qr[d0] = *reinterpret_cast<const bf16x8*>(Qh + (size_t)(P0 + wid * QBLK + r32) * DQK + d0 * 16 + hi * 8);
#define RESC(a) do { if (__any((a) < 1.f)) { if (hi == 0) al_l[r32] = (a); asm volatile("s_waitcnt lgkmcnt(0)" ::: "memory"); \
        _Pragma("unroll") for (int d_ = 0; d_ < 4; ++d_) _Pragma("unroll") for (int r = 0; r < 16; ++r) o[d_][r] *= al_l[crow(r, hi)]; } } while (0)
    f32x16 p0, p1; float mn, al; bf16x8 pa0, pa1, pa2, pa3;
    END_M();
    if (lag) END_V();
    for (int i = 0; i < NT; ++i) {
        const char* kb_ = K_lds + kq; bf16x8 ka[6], kb2[6];
#define KLOAD(dst, bt) do { _Pragma("unroll") for (int e = 0; e < 3; ++e) { const int d0 = 3 * (bt) + e; const char* a = kb_ + ko[d0 & 3] + (d0 >> 2) * 128; dst[2 * e] = *reinterpret_cast<const bf16x8*>(a); dst[2 * e + 1] = *reinterpret_cast<const bf16x8*>(a + 32 * 384); } } while (0)
#define KMMA(srcf, bt) do { _Pragma("unroll") for (int e = 0; e < 3; ++e) { p0 = __builtin_amdgcn_mfma_f32_32x32x16_bf16(srcf[2 * e], qr[3 * (bt) + e], p0, 0, 0, 0); p1 = __builtin_amdgcn_mfma_f32_32x32x16_bf16(srcf[2 * e + 1], qr[3 * (bt) + e], p1, 0, 0, 0); } } while (0)
        SBAR();
        if (i >= 1) { pv_tile2(o, vbb + vp, pa0, pa1, pa2, pa3); vp = ROTV(vp); }
        SBAR();
        { p0 = f32x16{}; p1 = f32x16{};
          KLOAD(ka, 0); SBAR(); KLOAD(kb2, 1); SBAR(); KMMA(ka, 0); SBAR(); KLOAD(ka, 2); SBAR(); KMMA(kb2, 1); SBAR(); KLOAD(kb2, 3); SBAR(); KMMA(ka, 2); SBAR(); KMMA(kb2, 3);
#undef KLOAD
#undef KMMA
          kq = ROTK(kq); }
        END_M();
        if (i + 2 < NT) DMA_TILE(i + 2);
        SBAR();
        { const int kb_ = i * KVBLK; if (kb_ + KVBLK - 1 > qlo) mask_tile(p0, p1, qm - kb_); }
        partialSM(p0, p1, m_reg, mn, al); RESC(al);
        finishSM(p0, p1, al, l_reg, pa0, pa1, pa2, pa3);
        END_V();
    }
    SBAR(); pv_tile2(o, vbb + vp, pa0, pa1, pa2, pa3);
    if (!lag) END_V();
    if (hi == 0) li_l[r32] = l_reg; asm volatile("s_waitcnt lgkmcnt(0)" ::: "memory");
    float rli[16];
#pragma unroll
    for (int r = 0; r < 16; ++r) rli[r] = fast_rcp(li_l[crow(r, hi)]);
    __syncthreads();
    bf16_t* stg = (bf16_t*)lds + wid * 4096;
#pragma unroll
    for (int r = 0; r < 16; ++r) { const int orow = crow(r, hi);
#pragma unroll
        for (int d0 = 0; d0 < 4; ++d0) { const float v = o[d0][r] * rli[r]; const float vn = __shfl_xor(v, 1);
            if ((r32 & 1) == 0) *(unsigned*)(stg + orow * 128 + d0 * 32 + r32) = cvt_pk_bf16(v, vn); } }
    asm volatile("s_waitcnt lgkmcnt(0)" ::: "memory");
    bf16_t* zy = ZY + (size_t)(P0 + wid * QBLK) * D;
#pragma unroll
    for (int i = 0; i < 8; ++i) { const int id = lane + 64 * i, row = id >> 4, ch = id & 15; float a[8], z[8];
        unpack8(*(const u32x4*)(stg + row * 128 + ch * 8), a); bf16_t* p = zy + (size_t)row * D + ch * 8; unpack8(*(const u32x4*)p, z);
#pragma unroll
        for (int j = 0; j < 8; ++j) a[j] *= z[j];
        *(u32x4*)p = pack8(a); }
    __syncthreads();
#undef ROTK
#undef ROTV
#undef DMA_TILE
#undef END_M
#undef END_V
#undef RESC
}

struct MixRegs { u32x4 vq[4]; f32x2 mrq[4]; u32x4 uq[4], zq[4]; };
__device__ __forceinline__ void mixer_issue(unsigned char* ws, int chunk, int g, const int tid, MixRegs& R) {
    const int wid = __builtin_amdgcn_readfirstlane(tid >> 6), lane = tid & 63; const int rb = wid & 3, dh = wid >> 2;
    const bf16_t* Vg = (const bf16_t*)(ws + WS_VG); const f32x2* VMR = (const f32x2*)(ws + WS_VMR); const bf16_t* Ug = (const bf16_t*)(ws + WS_UG); const bf16_t* Za = (const bf16_t*)(ws + WS_ZA);
    const int sr = tid >> 4, sc = (tid & 15) * 8; const int row0 = chunk * 128, col0 = g * 128;
#pragma unroll
    for (int q = 0; q < 4; ++q) { const int s = q * 32 + sr; R.vq[q] = *(const u32x4*)(Vg + (size_t)(row0 + s) * D + col0 + sc); R.mrq[q] = VMR[row0 + s]; }
#pragma unroll
    for (int i = 0; i < 4; ++i) { const int id = lane + 64 * i, tr = id >> 3, ch = id & 7, t = rb * 32 + tr; const size_t off = (size_t)(row0 + t) * D + col0 + dh * 64 + ch * 8;
        R.uq[i] = *(const u32x4*)(Ug + off); R.zq[i] = *(const u32x4*)(Za + off); }
}
struct MixInv { float bsq[4], lg[8], lb[8]; bf16x8 wa[2][4]; };
__device__ __forceinline__ void mixer_inv(unsigned char* ws, const float* ln_g, const float* ln_b, const float* b_s, int g, const int tid, MixInv& I) {
    const int wid = __builtin_amdgcn_readfirstlane(tid >> 6), lane = tid & 63, r32 = lane & 31, hi = lane >> 5; const int rb = wid & 3;
    const int sc = (tid & 15) * 8, col0 = g * 128;
#pragma unroll
    for (int i = 0; i < 4; ++i) { const int id = lane + 64 * i, tr = id >> 3; I.bsq[i] = b_s[g * 128 + rb * 32 + tr]; }
#pragma unroll
    for (int j = 0; j < 8; ++j) { I.lg[j] = ln_g[col0 + sc + j]; I.lb[j] = ln_b[col0 + sc + j]; }
    const bf16_t* Wm = (const bf16_t*)(ws + WS_WSM) + ((size_t)g * 128 + rb * 32 + r32) * 128;
#pragma unroll
    for (int kt = 0; kt < 2; ++kt)
#pragma unroll
        for (int ks = 0; ks < 4; ++ks) I.wa[kt][ks] = *(const bf16x8*)(Wm + kt * 64 + ks * 16 + hi * 8);
}
__device__ __forceinline__ void mixer_block(unsigned char* ws, int chunk, int g, char* lds, const int tid, const MixRegs& R, const MixInv& I) {
    const int wid = __builtin_amdgcn_readfirstlane(tid >> 6), lane = tid & 63, r32 = lane & 31, hi = lane >> 5;
    const int rb = wid & 3, dh = wid >> 2;
    const int sr = tid >> 4, sc = (tid & 15) * 8; const int row0 = chunk * 128, col0 = g * 128;
    bf16_t* Ug = (bf16_t*)(ws + WS_UG);
#pragma unroll
    for (int q = 0; q < 4; ++q) { const f32x2 mr = R.mrq[q]; float v[8];
        unpack8(R.vq[q], v);
#pragma unroll
        for (int j = 0; j < 8; ++j) v[j] = (v[j] - mr.x) * mr.y * I.lg[j] + I.lb[j];
        *(u32x4*)(lds + (q >> 1) * SHM_V + v_st((q & 1) * 32 + sr, sc)) = pack8(v); }
    __syncthreads();
    const int vb0 = (int)(uintptr_t)lds + v_rd_base(lane);
    f32x16 o0 = {}, o1 = {};
    if (dh == 0) {
        { bf16x8 pa0 = I.wa[0][0], pa1 = I.wa[0][1], pa2 = I.wa[0][2], pa3 = I.wa[0][3]; PV_D0(o0, 0, 0); PV_D0(o1, 0, 1); }
        if (rb >= 2) { bf16x8 pa0 = I.wa[1][0], pa1 = I.wa[1][1], pa2 = I.wa[1][2], pa3 = I.wa[1][3]; PV_D0(o0, SHM_V, 0); PV_D0(o1, SHM_V, 1); }
    } else {
        { bf16x8 pa0 = I.wa[0][0], pa1 = I.wa[0][1], pa2 = I.wa[0][2], pa3 = I.wa[0][3]; PV_D0(o0, 0, 2); PV_D0(o1, 0, 3); }
        if (rb >= 2) { bf16x8 pa0 = I.wa[1][0], pa1 = I.wa[1][1], pa2 = I.wa[1][2], pa3 = I.wa[1][3]; PV_D0(o0, SHM_V, 2); PV_D0(o1, SHM_V, 3); }
    }
    float* stg = (float*)(lds + 2 * SHM_V) + wid * 2048;
#pragma unroll
    for (int r = 0; r < 16; ++r) { const int tr = crow(r, hi); stg[tr * 64 + r32] = o0[r]; stg[tr * 64 + 32 + r32] = o1[r]; }
    asm volatile("s_waitcnt lgkmcnt(0)" ::: "memory");
#pragma unroll
    for (int i = 0; i < 4; ++i) { const int id = lane + 64 * i, tr = id >> 3, ch = id & 7, t = rb * 32 + tr; const float bs = I.bsq[i];
        const size_t off = (size_t)(row0 + t) * D + col0 + dh * 64 + ch * 8;
        const f32x4 s0 = *(const f32x4*)(stg + tr * 64 + ch * 8), s1 = *(const f32x4*)(stg + tr * 64 + ch * 8 + 4);
        float u[8], z[8], y[8]; unpack8(R.uq[i], u); unpack8(R.zq[i], z);
#pragma unroll
        for (int j = 0; j < 4; ++j) { y[j] = u[j] * (s0[j] + bs) * z[j]; y[4 + j] = u[4 + j] * (s1[j] + bs) * z[4 + j]; }
        *(u32x4*)(Ug + off) = pack8(y); }
    __syncthreads();
}
#undef SBAR
}


#define XB_TMO      128
#define XB_XCNT(j)  (256  + 64 * (j))
#define XB_XSUB(j)  (1280 + 64 * (j))
#define XB_XGEN(j)  (2304 + 64 * (j))
#define XB_TOP      3328
#define XB_TOPGEN   3392
#define XCD_BAR_WORDS 3456
#define XB_SPIN_CAP (1u << 22)
__device__ __forceinline__ unsigned xb_ld(unsigned* p)              { return __hip_atomic_load(p, __ATOMIC_RELAXED, __HIP_MEMORY_SCOPE_AGENT); }
__device__ __forceinline__ unsigned xb_add(unsigned* p, unsigned v) { return __hip_atomic_fetch_add(p, v, __ATOMIC_RELAXED, __HIP_MEMORY_SCOPE_AGENT); }
__device__ __forceinline__ unsigned xb_xcc_id() { return (unsigned)__builtin_amdgcn_s_getreg((3 << 11) | 20) & 0xFu; }
#define XB_SPIN(cond, bar) do { unsigned _sp = 0; while (cond) { __builtin_amdgcn_s_sleep(1); \
    if ((++_sp & 255u) == 0u) { if (xb_ld(&(bar)[XB_TMO])) break; if (_sp > XB_SPIN_CAP) { atomicAdd(&(bar)[XB_TMO], 1u); break; } } } } while (0)
__device__ __forceinline__ void xcd_barrier_complete(unsigned* bar, unsigned x, unsigned& nloc, unsigned& nx) {
    const unsigned G = gridDim.x;
    unsigned sum, cnt, mine, sp = 0u;
    for (;;) {
        sum = 0u; cnt = 0u; mine = 0u;
#pragma unroll
        for (unsigned j = 0; j < 16; ++j) { const unsigned c = xb_ld(&bar[XB_XCNT(j)]); sum += c; cnt += (c > 0u) ? 1u : 0u; mine = (j == x) ? c : mine; }
        if (sum == G) break;
        __builtin_amdgcn_s_sleep(1);
        if ((++sp & 255u) == 0u) { if (xb_ld(&bar[XB_TMO])) break; if (sp > XB_SPIN_CAP) { atomicAdd(&bar[XB_TMO], 1u); break; } }
    }
    nloc = mine > 0u ? mine : 1u; nx = cnt > 0u ? cnt : 1u;
}
__device__ __forceinline__ void xcd_barrier(unsigned* bar, volatile LAS unsigned* st, const int tid) {
    asm volatile("s_waitcnt vmcnt(0)" ::: "memory");
    __syncthreads();
    if (tid == 0) {
        const unsigned x = xb_xcc_id();
        __builtin_amdgcn_s_waitcnt(0);
        unsigned nloc = st[0], nx = st[1];
        if (nloc == 0u) { xcd_barrier_complete(bar, x, nloc, nx); st[0] = nloc; st[1] = nx; }
        const unsigned old = xb_add(&bar[XB_XSUB(x)], 1u);
        const unsigned gen = old / nloc;
        if (old + 1u == (gen + 1u) * nloc) {
            __builtin_amdgcn_fence(__ATOMIC_RELEASE, "agent");
            asm volatile("s_waitcnt vmcnt(0)" ::: "memory");
            const unsigned og = xb_add(&bar[XB_TOP], 1u);
            const unsigned tg = og / nx;
            if (og + 1u == (tg + 1u) * nx) xb_add(&bar[XB_TOPGEN], 1u);
            else XB_SPIN(xb_ld(&bar[XB_TOPGEN]) == tg, bar);
            __builtin_amdgcn_fence(__ATOMIC_ACQUIRE, "agent");
            xb_add(&bar[XB_XGEN(x)], 1u);
            asm volatile("s_waitcnt vmcnt(0)" ::: "memory");
        } else {
            XB_SPIN(xb_ld(&bar[XB_XGEN(x)]) == gen, bar);
            __builtin_amdgcn_fence(__ATOMIC_ACQUIRE, "agent");
            asm volatile("s_waitcnt vmcnt(0)" ::: "memory");
        }
    }
    __syncthreads();
}

typedef const __attribute__((address_space(4))) Ptrs* KargPtr;
#define PHASE_ENV() KargPtr kp_ = (KargPtr)__builtin_amdgcn_kernarg_segment_ptr(); asm volatile("" : "+s"(kp_)); \
    const int wave = wave0_; int lane = (int)__builtin_amdgcn_mbcnt_hi(~0u, __builtin_amdgcn_mbcnt_lo(~0u, 0u)); asm volatile("" : "+v"(lane)); const int tid = wave * 64 + lane; \
    int G = gridDim.x, c = blockIdx.x; asm volatile("" : "+s"(G), "+s"(c)); const int vcu = (G % 8 == 0) ? (c % 8) * (G / 8) + c / 8 : c; \
    unsigned char* ws = kp_->ws; unsigned char* dout = (unsigned char*)kp_->out; (void)lane; (void)wave; (void)vcu; (void)ws; (void)dout
__global__ void __launch_bounds__(NTHREADS, 2) hybrid_fwd(Ptrs Punused) {
    extern __shared__ __attribute__((aligned(16))) unsigned char lds_raw[];
    LAS unsigned char* lds = (LAS unsigned char*)lds_raw;
    const int wave0_ = __builtin_amdgcn_readfirstlane((int)threadIdx.x >> 6);
    int lo, hi; { KargPtr k0 = (KargPtr)__builtin_amdgcn_kernarg_segment_ptr(); lo = k0->ph_lo; hi = k0->ph_hi; }
#define IN(k) (lo <= (k) && (k) < hi)
#if MK_SINGLE
    volatile LAS unsigned* bst_ = (volatile LAS unsigned*)(lds + BARST_OFF);
    { if ((int)threadIdx.x == 0) { bst_[0] = 0u; bst_[1] = 0u; KargPtr k0 = (KargPtr)__builtin_amdgcn_kernarg_segment_ptr(); (void)xb_add(&((unsigned*)k0->ws)[XB_XCNT(xb_xcc_id())], 1u); } __syncthreads(); }
#define SEAM(k) do { if (IN(k) && IN((k) + 1)) { PHASE_ENV(); if ((k) == 0 && kp_->use_cg) cg::this_grid().sync(); else xcd_barrier((unsigned*)ws, bst_, tid); } } while (0)
#else
#define SEAM(k) do { } while (0)
#endif
    if (IN(0)) { PHASE_ENV(); Ptrs P; { const __attribute__((address_space(4))) unsigned long long* s_ = (const __attribute__((address_space(4))) unsigned long long*)kp_; unsigned long long* d_ = (unsigned long long*)&P; _Pragma("unroll") for (int i_ = 0; i_ < (int)(sizeof(Ptrs) / 8); ++i_) d_[i_] = s_[i_]; } phase0(P, lds, vcu, G, tid, lane, wave); }
    SEAM(0);
    if (IN(1)) { PHASE_ENV(); SchedP1 Sc{ws, G, c}; EpiP1 E{ws, dout, kp_->in[16]}; pg8::gemm_phase<2048>(lds, Sc, E, tid); }
    SEAM(1);
    if (IN(2)) { PHASE_ENV();
        { const f32x2* st = (const f32x2*)(ws + WS_VST); f32x2* mr = (f32x2*)(ws + WS_VMR);
          for (int row = c * 32 + (tid >> 4); row < S; row += G * 32) { const int sub = tid & 15;
              const f32x2 p0 = st[(size_t)sub * S + row], p1 = st[(size_t)(sub + 16) * S + row]; float s1 = p0.x + p1.x, s2 = p0.y + p1.y;
#pragma unroll
              for (int o = 1; o < 16; o <<= 1) { s1 += __shfl_xor(s1, o); s2 += __shfl_xor(s2, o); }
              const float mean = s1 * (1.f / D); const float var = fmaxf(s2 * (1.f / D) - mean * mean, 0.f); if (sub == 0) mr[row] = (f32x2){mean, 1.0f / sqrtf(var + EPS)}; } }
        SchedP2 Sc{ws, G, c}; EpiP2 E{ws, (LAS float*)(lds + XCH_OFF)}; pg8::gemm_phase<512>(lds, Sc, E, tid);
    }
    SEAM(2);
    if (IN(3)) {
        { PHASE_ENV();
          if (c < 224) { const int v2 = (c & 7) * 28 + (c >> 3), h = v2 / 14, b = v2 - h * 14;
            const bf16_t* Qh = (const bf16_t*)(ws + WS_QB) + (size_t)h * S * DQK; const bf16_t* Kh = (const bf16_t*)(ws + WS_KB) + (size_t)h * S * DQK; const bf16_t* Vh = (const bf16_t*)(ws + WS_VB) + (size_t)h * S * DV;
            bf16_t* ZY = (bf16_t*)dout + h * DV;
            const int qa = b == 0 ? 30 : b < 3 ? 29 - b : b < 10 ? 28 - b : b == 10 ? 31 : b == 11 ? 29 : b == 12 ? 26 : 18;
            const int qc = b < 10 ? 36 - qa : b == 10 ? 2 : b == 11 ? 3 : b == 12 ? 5 : 10;
            const int qd = b == 10 ? 0 : b == 11 ? 1 : b == 12 ? 4 : 7;
            att::attn_block3(Qh, Kh, Vh, ZY, qa * 256, (char*)lds_raw, tid); att::attn_block3(Qh, Kh, Vh, ZY, qc * 256, (char*)lds_raw, tid);
            if (b >= 10) att::attn_block3(Qh, Kh, Vh, ZY, qd * 256, (char*)lds_raw, tid); } }
        { PHASE_ENV(); if (c >= 224) { SchedP3b Sc{ws, 32, c - 224}; EpiMulZ E{dout}; pg8::gemm_phase<256>(lds, Sc, E, tid); } }
        { PHASE_ENV(); if (c >= 224) { const int mw = c - 224; const float* lng = kp_->in[5]; const float* lnb = kp_->in[6]; const float* bs = kp_->in[8];
            att::MixRegs ra, rb; att::MixInv inv;
            att::mixer_issue(ws, mw >> 4, mw & 15, tid, ra); att::mixer_inv(ws, lng, lnb, bs, mw & 15, tid, inv);
            for (int it = mw; it < 1024; it += 64) {
                const int it1 = it + 32, it2 = it + 64;
                if (it1 < 1024) att::mixer_issue(ws, it1 >> 4, mw & 15, tid, rb);
                att::mixer_block(ws, it >> 4, mw & 15, (char*)lds_raw, tid, ra, inv);
                if (it1 >= 1024) break;
                if (it2 < 1024) att::mixer_issue(ws, it2 >> 4, mw & 15, tid, ra);
                att::mixer_block(ws, it1 >> 4, mw & 15, (char*)lds_raw, tid, rb, inv);
            } } }
        { PHASE_ENV(); Ptrs P; { const __attribute__((address_space(4))) unsigned long long* s_ = (const __attribute__((address_space(4))) unsigned long long*)kp_; unsigned long long* d_ = (unsigned long long*)&P; _Pragma("unroll") for (int i_ = 0; i_ < (int)(sizeof(Ptrs) / 8); ++i_) d_[i_] = s_[i_]; } if (c < 224) phase_wconv2(P, lds, c, 224, lane, wave); }
    }
    SEAM(3);
    if (IN(4)) { PHASE_ENV(); SchedP4 Sc{ws, dout, G, c}; EpiP4 E{ws}; pg8::gemm_phase<2048>(lds, Sc, E, tid); }
    SEAM(4);
    if (IN(5)) { PHASE_ENV(); SchedP5 Sc{ws, G, c}; EpiP5 E{ws, (float*)dout}; pg8::gemm_phase<2048>(lds, Sc, E, tid); }
    SEAM(5);
    if (IN(6)) { PHASE_ENV();
        const float* st = (const float*)(ws + WS_OST); const float* x = kp_->in[0]; const float* gp = kp_->in[19]; float* outp = (float*)dout;
        for (int row = vcu * NWAVES + wave; row < S; row += G * NWAVES) {
            float s = lane < 32 ? st[(size_t)lane * S + row] : 0.f; s = wave_sum(s);
            const float rs = 1.0f / sqrtf(s * (1.f / D) + EPS);
            const f32x4* xr = (const f32x4*)(x + (size_t)row * D); f32x4* orow = (f32x4*)(outp + (size_t)row * D); const f32x4* gr = (const f32x4*)gp; const u32x4* ob = (const u32x4*)((const bf16_t*)(ws + WS_MP) + (size_t)row * D);
#pragma unroll
            for (int j = 0; j < 4; ++j) { const int q = 64 * j + lane; float a[8]; unpack8(ob[q], a); const f32x4 x0 = xr[2 * q], x1 = xr[2 * q + 1], g0 = gr[2 * q], g1 = gr[2 * q + 1];
                orow[2 * q] = x0 + (f32x4){a[0], a[1], a[2], a[3]} * rs * g0; orow[2 * q + 1] = x1 + (f32x4){a[4], a[5], a[6], a[7]} * rs * g1; }
        }
    }
#undef IN
#undef SEAM
}

extern "C" void kernel_launch(void* const* d_in, const int* in_sizes, int n_in, void* d_out, int out_size, void* d_ws, size_t ws_size, hipStream_t stream) {
    static int grid = 0;
    if (grid == 0) {
        if (n_in != 20 || out_size != S * D || ws_size < WS_END) { fprintf(stderr, "kernel_launch: unexpected shapes (n_in %d out %d ws %zu)\n", n_in, out_size, ws_size); grid = -1; return; }
        int dev = 0, cus = 0, per_cu = 0;
        (void)hipGetDevice(&dev); (void)hipDeviceGetAttribute(&cus, hipDeviceAttributeMultiprocessorCount, dev);
        (void)hipFuncSetAttribute((const void*)hybrid_fwd, hipFuncAttributeMaxDynamicSharedMemorySize, LDS_BYTES);
        (void)hipOccupancyMaxActiveBlocksPerMultiprocessor(&per_cu, (const void*)hybrid_fwd, NTHREADS, LDS_BYTES);
        if (per_cu < 1) { fprintf(stderr, "kernel_launch: occupancy query reports %d blocks per CU\n", per_cu); }
        grid = cus;
        (void)hipGetLastError();
    }
    if (grid < 0) return;
    Ptrs p{};
    for (int i = 0; i < 20; ++i) p.in[i] = (const float*)d_in[i];
    p.out = (float*)d_out; p.ws = (unsigned char*)d_ws;
#if MK_SINGLE
    (void)hipMemsetAsync(d_ws, 0, CTL_ZERO_BYTES, stream);
    p.ph_lo = 0; p.ph_hi = 7;
    void* args[] = {&p};
    hipError_t e = hipLaunchCooperativeKernel((const void*)hybrid_fwd, dim3(grid), dim3(NTHREADS), args, LDS_BYTES, stream);
    if (e != hipSuccess) fprintf(stderr, "cooperative launch failed: %s (grid %d)\n", hipGetErrorString(e), grid);
#else
    for (int k = 0; k < 7; ++k) { p.ph_lo = k; p.ph_hi = k + 1; hipLaunchKernelGGL(hybrid_fwd, dim3(grid), dim3(NTHREADS), LDS_BYTES, stream, p); }
#endif
}
```

```cpp
#include <hip/hip_runtime.h>
#include <hip/hip_cooperative_groups.h>
#include <cstdio>
#include <cstdint>
namespace cg = cooperative_groups;

#ifndef MK_SINGLE
#define MK_SINGLE 1
#endif

#define LAS __attribute__((address_space(3)))
typedef unsigned short bf16_t;
typedef short bf16x8 __attribute__((ext_vector_type(8)));
typedef short s16x4 __attribute__((ext_vector_type(4)));
typedef float f32x4 __attribute__((ext_vector_type(4)));
typedef float f32x2 __attribute__((ext_vector_type(2)));
typedef float f32x16 __attribute__((ext_vector_type(16)));
typedef unsigned u32x4 __attribute__((ext_vector_type(4)));
typedef unsigned u32x2 __attribute__((ext_vector_type(2)));

constexpr int S = 8192, D = 2048, ML = 256, NH = 16, DQK = 192, DV = 128;
constexpr int IN_TOTAL = 13376, NT_IN = 77;
constexpr float EPS = 1e-6f, LOG2E = 1.4426950408889634f;
constexpr float QSCALE = 0.07216878364870322f * 1.4426950408889634f;
constexpr float MSCALE = 0.04419417382415922f * 1.4426950408889634f;
constexpr int NTHREADS = 512, NWAVES = 8;
constexpr int RING_BYTES = 131072, XCH_OFF = RING_BYTES, BARST_OFF = XCH_OFF + 8192, LDS_BYTES = 147456;
#define XB_WMEM 3520
constexpr size_t CTL_ZERO_BYTES = 16384;

constexpr size_t MiB = 1u << 20;
constexpr size_t WS_CS = 1 * MiB;
constexpr size_t WS_VST = 3 * MiB;
constexpr size_t WS_CQST = 5 * MiB;
constexpr size_t WS_CKVST = 5 * MiB + 256 * 1024;
constexpr size_t WS_VMR = 5 * MiB + 512 * 1024;
constexpr size_t WS_OST = 6 * MiB;
constexpr size_t WS_WSM = 7 * MiB;
constexpr size_t WS_KR = 8 * MiB;
constexpr size_t WS_KMH = 9 * MiB;
constexpr size_t WS_VMT = 10 * MiB;
constexpr size_t WS_WUQ = 11 * MiB;
constexpr size_t WS_WUKV = 14 * MiB;
constexpr size_t WS_WIN = 18 * MiB;
constexpr size_t WS_WMEM = 95 * MiB;
constexpr size_t WS_H = 111 * MiB;
constexpr size_t WS_MEMN = 143 * MiB;
constexpr size_t WS_UG = 144 * MiB;
constexpr size_t WS_VG = 176 * MiB;
constexpr size_t WS_ZA = 208 * MiB;
constexpr size_t WS_CQ = 240 * MiB;
constexpr size_t WS_CKV = 248 * MiB;
constexpr size_t WS_QMH = 256 * MiB;
constexpr size_t WS_G = 288 * MiB;
constexpr size_t WS_VB = 384 * MiB;
constexpr size_t WS_QB = 18 * MiB;
constexpr size_t WS_KB = 66 * MiB;
constexpr size_t WS_P = 114 * MiB;
constexpr size_t WS_WBR = 240 * MiB;
constexpr size_t WS_WOUT = 264 * MiB;
constexpr size_t WS_MP = 18 * MiB;
constexpr size_t WS_MERGED = 82 * MiB;
constexpr size_t WS_END = 416 * MiB;

typedef __bf16 bf16x2_t __attribute__((ext_vector_type(2)));
__device__ __forceinline__ unsigned cvt_pk_bf16(float lo, float hi) { const f32x2 v = {lo, hi}; const bf16x2_t b = __builtin_convertvector(v, bf16x2_t); return __builtin_bit_cast(unsigned, b); }
__device__ __forceinline__ float bf_lo(unsigned w) { return __uint_as_float(w << 16); }
__device__ __forceinline__ float bf_hi(unsigned w) { return __uint_as_float(w & 0xffff0000u); }
__device__ __forceinline__ u32x4 pack8(const float* v) { u32x4 w; w.x = cvt_pk_bf16(v[0], v[1]); w.y = cvt_pk_bf16(v[2], v[3]); w.z = cvt_pk_bf16(v[4], v[5]); w.w = cvt_pk_bf16(v[6], v[7]); return w; }
__device__ __forceinline__ void unpack8(u32x4 w, float* v) { v[0] = bf_lo(w.x); v[1] = bf_hi(w.x); v[2] = bf_lo(w.y); v[3] = bf_hi(w.y); v[4] = bf_lo(w.z); v[5] = bf_hi(w.z); v[6] = bf_lo(w.w); v[7] = bf_hi(w.w); }
__device__ __forceinline__ float fast_rcp(float x) { return __builtin_amdgcn_rcpf(x); }
__device__ __forceinline__ float fast_exp2(float x) { return __builtin_amdgcn_exp2f(x); }
__device__ __forceinline__ float act_gelu(float x) { const float u = x * (1.f + 0.044715f * x * x); return x * fast_rcp(1.f + fast_exp2(-2.3022081983f * u)); }
__device__ __forceinline__ float act_silu(float x) { return x * fast_rcp(1.f + fast_exp2(-LOG2E * x)); }
__device__ __forceinline__ float act_sigmoid(float x) { return fast_rcp(1.f + fast_exp2(-LOG2E * x)); }
__device__ __forceinline__ float wave_sum(float v) {
#pragma unroll
    for (int o = 1; o < 64; o <<= 1) v += __shfl_xor(v, o);
    return v;
}

namespace pg8 {
constexpr int BM = 256, BK = 64, HALF = 128, HTB = HALF * BK * 2, STAGE_BYTES = 8 * HTB;
__host__ __device__ __forceinline__ int lds_byte(int r, int c) { const int st = (r >> 4) * 2 + (c >> 5), rr = r & 15, cc = c & 31, ob = rr * 64 + cc * 2; return st * 1024 + (ob ^ (((ob >> 9) & 1) << 5)); }
__host__ __device__ __forceinline__ void stage_rc(int b, int& R, int& C) { const int st = b / 1024, sb = b % 1024, swz = sb ^ (((sb >> 9) & 1) << 5); R = (st >> 1) * 16 + swz / 64; C = (st & 1) * 32 + (swz % 64) / 2; }
__host__ __device__ __forceinline__ int perm32(int rho) { const int n = rho >> 4, i = rho & 15; return 8 * (i >> 2) + 4 * n + (i & 3); }

struct Unit { const char* A; const char* B; int pm, pn, mode; };

template <int K, class Sched, class Epi>
__device__ __forceinline__ void gemm_phase(LAS unsigned char* lds, const Sched& S, const Epi& E, const int tid) {
    const int wid = __builtin_amdgcn_readfirstlane(tid >> 6), lane = tid & 63, wr = wid >> 2, wc = wid & 3, fr = lane & 15, fq = lane >> 4;
    constexpr int nt = K / BK;
    unsigned voffA[2], voffB[2];
#pragma unroll
    for (int i = 0; i < 2; ++i) { int R, C; stage_rc(tid * 16 + i * 8192, R, C); const int Rb = (R & ~31) + perm32(R & 31);
        voffA[i] = (unsigned)(R * K + C) * 2u; voffB[i] = (unsigned)(Rb * K + C) * 2u; }
    constexpr size_t kstep = (size_t)(BK * 2);
    constexpr size_t hstep = (size_t)HALF * K * 2;
    const unsigned ldsw = (unsigned)wid * 1024u;
    const int aoff = lds_byte(wr * 64 + fr, fq * 8), boff = lds_byte(wc * 32 + fr, fq * 8);
#define PG8_SA(b, h) (((b) * 2 + (h)) * HTB)
#define PG8_SB(b, h) ((4 + (b) * 2 + (h)) * HTB)
#define PG8_STAGE(bufoff, gbase, voff) do { _Pragma("unroll") for (int _i = 0; _i < 2; ++_i) \
        __builtin_amdgcn_global_load_lds((const unsigned*)((const char*)(gbase) + (voff)[_i]), (LAS unsigned*)(lds + (bufoff) + ldsw + _i * 8192), 16, 0, 0); } while (0)
#define PG8_LDA(dst, b, h) do { _Pragma("unroll") for (int m = 0; m < 4; ++m) _Pragma("unroll") for (int k = 0; k < 2; ++k) dst[m][k] = *(const LAS bf16x8*)(lds + PG8_SA(b, h) + aoff + m * 2048 + k * 1024); } while (0)
#define PG8_LDB(dst, b, h) do { _Pragma("unroll") for (int n = 0; n < 2; ++n) _Pragma("unroll") for (int k = 0; k < 2; ++k) dst[n][k] = *(const LAS bf16x8*)(lds + PG8_SB(b, h) + boff + n * 2048 + k * 1024); } while (0)
#define PG8_MMA(ai, bj, At, Bt) do { __builtin_amdgcn_s_setprio(1); _Pragma("unroll") for (int m = 0; m < 4; ++m) _Pragma("unroll") for (int n = 0; n < 2; ++n) _Pragma("unroll") for (int k = 0; k < 2; ++k) \
        acc[ai][bj][m][n] = __builtin_amdgcn_mfma_f32_16x16x32_bf16(Bt[n][k], At[m][k], acc[ai][bj][m][n], 0, 0, 0); __builtin_amdgcn_s_setprio(0); } while (0)
#define PG8_WAIT_V(n) asm volatile("s_waitcnt vmcnt(" #n ")" ::: "memory")
#define PG8_WAIT_L(n) asm volatile("s_waitcnt lgkmcnt(" #n ")" ::: "memory")
#define PG8_BAR __builtin_amdgcn_s_barrier()
#define PG8_SCHED __builtin_amdgcn_sched_barrier(0)
    Unit cur, nxt; int ui = 0;
    if (!S.next(0, cur)) return;
    f32x4 acc[2][2][4][2];
#pragma unroll
    for (int a = 0; a < 2; ++a)
#pragma unroll
        for (int b = 0; b < 2; ++b)
#pragma unroll
            for (int m = 0; m < 4; ++m)
#pragma unroll
                for (int n = 0; n < 2; ++n) acc[a][b][m][n] = (f32x4){0.f, 0.f, 0.f, 0.f};
    bf16x8 At[4][2], B0[2][2], B1[2][2];
    const char* cA = cur.A; const char* cB = cur.B;
#define PG8_KT(t) ((size_t)((t) & (nt - 1)) * kstep)
    PG8_STAGE(PG8_SB(0, 0), cB + PG8_KT(0), voffB); PG8_STAGE(PG8_SB(0, 1), cB + hstep + PG8_KT(0), voffB); PG8_STAGE(PG8_SA(0, 0), cA + PG8_KT(0), voffA); PG8_STAGE(PG8_SA(0, 1), cA + hstep + PG8_KT(0), voffA);
    if (wr == 1) PG8_BAR;
    PG8_WAIT_V(2); PG8_BAR;
    PG8_STAGE(PG8_SB(1, 0), cB + PG8_KT(1), voffB); PG8_STAGE(PG8_SA(1, 0), cA + PG8_KT(1), voffA); PG8_STAGE(PG8_SB(1, 1), cB + hstep + PG8_KT(1), voffB);
    PG8_WAIT_V(6); PG8_BAR;
    for (;;) {
        const bool has_next = S.next(ui + 1, nxt);
        const char* nA = has_next ? nxt.A : cA; const char* nB = has_next ? nxt.B : cB;
#pragma unroll 1
        for (int t = 0; t < nt; t += 2) {
            const bool last = (t == nt - 2);
            const char* a1 = cA + PG8_KT(t + 1);
            const char* a2 = (last ? nA : cA) + PG8_KT(t + 2); const char* b2 = (last ? nB : cB) + PG8_KT(t + 2);
            const char* a3 = (last ? nA : cA) + PG8_KT(t + 3); const char* b3 = (last ? nB : cB) + PG8_KT(t + 3);
            PG8_LDB(B0, 0, 0); PG8_LDB(B1, 0, 1); PG8_SCHED; PG8_LDA(At, 0, 0); PG8_STAGE(PG8_SA(1, 1), a1 + hstep, voffA);
            PG8_WAIT_V(8); PG8_WAIT_L(0); PG8_BAR; PG8_MMA(0, 0, At, B0); PG8_MMA(0, 1, At, B1); PG8_BAR; PG8_SCHED;
            PG8_LDA(At, 0, 1); PG8_STAGE(PG8_SB(0, 0), b2, voffB); PG8_STAGE(PG8_SB(0, 1), b2 + hstep, voffB); PG8_STAGE(PG8_SA(0, 0), a2, voffA);
            PG8_WAIT_V(8); PG8_WAIT_L(0); PG8_BAR; PG8_MMA(1, 0, At, B0); PG8_MMA(1, 1, At, B1); PG8_BAR; PG8_SCHED;
            PG8_LDB(B0, 1, 0); PG8_LDB(B1, 1, 1); PG8_SCHED; PG8_LDA(At, 1, 0); PG8_STAGE(PG8_SA(0, 1), a2 + hstep, voffA);
            PG8_WAIT_V(8); PG8_WAIT_L(0); PG8_BAR; PG8_MMA(0, 0, At, B0); PG8_MMA(0, 1, At, B1); PG8_BAR; PG8_SCHED;
            PG8_LDA(At, 1, 1); PG8_STAGE(PG8_SB(1, 0), b3, voffB); PG8_STAGE(PG8_SB(1, 1), b3 + hstep, voffB); PG8_STAGE(PG8_SA(1, 0), a3, voffA);
            PG8_WAIT_V(8); PG8_WAIT_L(0); PG8_BAR; PG8_MMA(1, 0, At, B0); PG8_MMA(1, 1, At, B1); PG8_BAR; PG8_SCHED;
        }
        if (wr == 0) PG8_BAR;
        E(acc, cur, wr, wc, fr, fq);
        if (!has_next) break;
        if (!E.keep_acc(cur)) {
#pragma unroll
        for (int a = 0; a < 2; ++a)
#pragma unroll
            for (int b = 0; b < 2; ++b)
#pragma unroll
                for (int m = 0; m < 4; ++m)
#pragma unroll
                    for (int n = 0; n < 2; ++n) acc[a][b][m][n] = (f32x4){0.f, 0.f, 0.f, 0.f};
        }
        cur = nxt; cA = nA; cB = nB; ++ui;
        if (wr == 1) PG8_BAR;
    }
    PG8_WAIT_V(0);
    PG8_BAR;
#undef PG8_KT
#undef PG8_SA
#undef PG8_SB
#undef PG8_STAGE
#undef PG8_LDA
#undef PG8_LDB
#undef PG8_MMA
#undef PG8_WAIT_V
#undef PG8_WAIT_L
#undef PG8_BAR
#undef PG8_SCHED
}
}
using pg8::Unit;

#define EPI_LOOP_BEGIN \
    _Pragma("unroll") for (int ai = 0; ai < 2; ++ai) _Pragma("unroll") for (int m = 0; m < 4; ++m) { const int rt = ai * 128 + wr * 64 + m * 16 + fr; \
    _Pragma("unroll") for (int bj = 0; bj < 2; ++bj) { const int ct = bj * 128 + wc * 32 + 8 * fq; \
        float v[8] = {acc[ai][bj][m][0][0], acc[ai][bj][m][0][1], acc[ai][bj][m][0][2], acc[ai][bj][m][0][3], acc[ai][bj][m][1][0], acc[ai][bj][m][1][1], acc[ai][bj][m][1][2], acc[ai][bj][m][1][3]};
#define EPI_LOOP_END } }

enum { M_GELU = 0, M_GELU_STAT, M_SILU, M_RAW_SS, M_KROPE, M_QM, M_GATE, M_MEMK, M_MEMV,
       M_QUP, M_KVUP, M_MEMS,
       M_MULZ, M_BR0, M_BR1, M_BR2, M_OUT };

struct Ptrs {
    const float* in[20]; float* out; unsigned char* ws; int ph_lo, ph_hi; int use_cg, pad;
};

struct EpiP1 {
    __device__ __forceinline__ bool keep_acc(const Unit&) const { return false; }
    unsigned char* ws; unsigned char* dout; const float* bgate;
    __device__ __forceinline__ void operator()(f32x4 (&acc)[2][2][4][2], const Unit& u, int wr, int wc, int fr, int fq) const {
        const int mode = u.mode, pn = u.pn, row0 = u.pm * 256;
        if (mode == M_KROPE) {
            if (wc < 2) {
                const f32x2* CS = (const f32x2*)(ws + WS_CS); bf16_t* KR = (bf16_t*)(ws + WS_KR);
#pragma unroll
                for (int ai = 0; ai < 2; ++ai)
#pragma unroll
                    for (int m = 0; m < 4; ++m) { const int row = row0 + ai * 128 + wr * 64 + m * 16 + fr; const int i0 = (wc * 32 + 8 * fq) >> 1;
                        const f32x4 a = acc[ai][0][m][0], b = acc[ai][0][m][1]; const float t1[4] = {a[0], a[2], b[0], b[2]}, t2[4] = {a[1], a[3], b[1], b[3]};
                        float o1[4], o2[4];
#pragma unroll
                        for (int j = 0; j < 4; ++j) { const f32x2 cs = CS[row * 32 + i0 + j]; o1[j] = t1[j] * cs.x - t2[j] * cs.y; o2[j] = t2[j] * cs.x + t1[j] * cs.y; }
                        u32x2 w1, w2; w1.x = cvt_pk_bf16(o1[0], o1[1]); w1.y = cvt_pk_bf16(o1[2], o1[3]); w2.x = cvt_pk_bf16(o2[0], o2[1]); w2.y = cvt_pk_bf16(o2[2], o2[3]);
                        *(u32x2*)(KR + (size_t)row * 64 + i0) = w1; *(u32x2*)(KR + (size_t)row * 64 + 32 + i0) = w2; }
            }
            return;
        }
        bf16_t* dst; int ldc, cbase = 0; int act = 0;
        float scale = 1.f; int stat = 0; float* stp = nullptr; const float* bias = nullptr;
        if (mode == M_GELU)           { dst = (bf16_t*)(ws + WS_UG); ldc = D; cbase = pn * 256; act = 1; }
        else if (mode == M_GELU_STAT) { dst = (bf16_t*)(ws + WS_VG); ldc = D; cbase = (pn - 8) * 256; act = 1; stat = 2; stp = (float*)(ws + WS_VST) + (size_t)((pn - 8) * 4 + wc) * S * 2; }
        else if (mode == M_SILU)      { act = 2; ldc = D; if (pn < 24) { dst = (bf16_t*)(ws + WS_ZA); cbase = (pn - 16) * 256; } else if (pn < 37) { dst = (bf16_t*)dout; cbase = (pn - 29) * 256; } else { dst = (bf16_t*)dout + (size_t)S * D; cbase = (pn - 45) * 256; } }
        else if (mode == M_RAW_SS)    { ldc = 512; stat = 1; if (pn < 26) { dst = (bf16_t*)(ws + WS_CQ); cbase = (pn - 24) * 256; stp = (float*)(ws + WS_CQST) + (size_t)((pn - 24) * 4 + wc) * S; }
                                        else { dst = (bf16_t*)(ws + WS_CKV); cbase = (pn - 26) * 256; stp = (float*)(ws + WS_CKVST) + (size_t)((pn - 26) * 4 + wc) * S; } }
        else if (mode == M_QM)        { const int t = pn - 37; dst = (bf16_t*)(ws + WS_QMH) + (size_t)(t >> 1) * S * 512; ldc = 512; cbase = (t & 1) * 256; scale = MSCALE; }
        else if (mode == M_GATE)      { dst = (bf16_t*)(ws + WS_G); ldc = 3 * D; cbase = (pn - 53) * 256; act = 3; bias = bgate + cbase; }
        else if (mode == M_MEMK)      { dst = (bf16_t*)(ws + WS_KMH) + (size_t)(pn >> 1) * ML * 512; ldc = 512; cbase = (pn & 1) * 256; }
        else                          { dst = (bf16_t*)(ws + WS_VMT); ldc = ML; cbase = 0; }
#pragma unroll
        for (int ai = 0; ai < 2; ++ai)
#pragma unroll
            for (int m = 0; m < 4; ++m) { const int rt = ai * 128 + wr * 64 + m * 16 + fr; float s1 = 0.f, s2 = 0.f;
#pragma unroll
                for (int bj = 0; bj < 2; ++bj) { const int ct = bj * 128 + wc * 32 + 8 * fq;
                    float v[8] = {acc[ai][bj][m][0][0], acc[ai][bj][m][0][1], acc[ai][bj][m][0][2], acc[ai][bj][m][0][3], acc[ai][bj][m][1][0], acc[ai][bj][m][1][1], acc[ai][bj][m][1][2], acc[ai][bj][m][1][3]};
                    if (act == 1) {
#pragma unroll
                        for (int j = 0; j < 8; ++j) v[j] = act_gelu(v[j]);
                    } else if (act == 2) {
#pragma unroll
                        for (int j = 0; j < 8; ++j) v[j] = act_silu(v[j]);
                    } else if (act == 3) { const f32x4 b0 = *(const f32x4*)(bias + ct), b1 = *(const f32x4*)(bias + ct + 4);
#pragma unroll
                        for (int j = 0; j < 4; ++j) { v[j] = act_sigmoid(v[j] + b0[j]); v[4 + j] = act_sigmoid(v[4 + j] + b1[j]); }
                    } else {
#pragma unroll
                        for (int j = 0; j < 8; ++j) v[j] *= scale;
                    }
                    if (stat) {
#pragma unroll
                        for (int j = 0; j < 8; ++j) { s1 += v[j]; s2 += v[j] * v[j]; }
                    }
                    *(u32x4*)(dst + (size_t)(row0 + rt) * ldc + cbase + ct) = pack8(v);
                }
                if (stat) { s1 += __shfl_xor(s1, 16); s1 += __shfl_xor(s1, 32); s2 += __shfl_xor(s2, 16); s2 += __shfl_xor(s2, 32);
                    if (fq == 0) { if (stat == 2) *(f32x2*)(stp + (size_t)(row0 + rt) * 2) = (f32x2){s1, s2}; else stp[row0 + rt] = s2; } }
            }
    }
};

struct SchedP1 {
    const unsigned char* ws; int G, c; int nconv;
    __device__ __forceinline__ bool next(int i, Unit& u) const {
        const int L = i * G + c; constexpr int NMAIN = 32 * NT_IN;
        if (L >= NMAIN + 16) return false;
        if (L >= NMAIN) { unsigned* fl = (unsigned*)ws + XB_WMEM; unsigned sp = 0u;
            while (__hip_atomic_load(fl, __ATOMIC_RELAXED, __HIP_MEMORY_SCOPE_AGENT) < (unsigned)nconv) { __builtin_amdgcn_s_sleep(2); if (++sp > (1u << 22)) break; }
            __builtin_amdgcn_fence(__ATOMIC_ACQUIRE, "agent"); }
        if (L < NMAIN) { const int wg = (L % 8) * (NMAIN / 8) + L / 8; constexpr int nig = 8 * NT_IN; const int gid = wg / nig, w = wg % nig; const int pm = gid * 8 + (w % 8), pn = w / 8;
            u.pm = pm; u.pn = pn; u.A = (const char*)(ws + WS_H) + (size_t)pm * 256 * D * 2; u.B = (const char*)(ws + WS_WIN) + (size_t)pn * 256 * D * 2;
            u.mode = pn < 8 ? M_GELU : pn < 16 ? M_GELU_STAT : pn < 24 ? M_SILU : pn < 28 ? M_RAW_SS : pn == 28 ? M_KROPE : pn < 37 ? M_SILU : pn < 45 ? M_QM : pn < 53 ? M_SILU : M_GATE; }
        else if (L < NMAIN + 8) { const int pn = L - NMAIN; u.pm = 0; u.pn = pn; u.A = (const char*)(ws + WS_MEMN); u.B = (const char*)(ws + WS_WMEM) + (size_t)pn * 256 * D * 2; u.mode = M_MEMK; }
        else { const int pm = L - NMAIN - 8; u.pm = pm; u.pn = 0; u.A = (const char*)(ws + WS_WMEM) + (size_t)(2048 + pm * 256) * D * 2; u.B = (const char*)(ws + WS_MEMN); u.mode = M_MEMV; }
        return true;
    }
};

struct EpiP2 {
    __device__ __forceinline__ bool keep_acc(const Unit&) const { return false; }
    unsigned char* ws; LAS float* xch;
    __device__ __forceinline__ void operator()(f32x4 (&acc)[2][2][4][2], const Unit& u, int wr, int wc, int fr, int fq) const {
        const int mode = u.mode, row0 = u.pm * 256;
        if (mode == M_MEMS) {
            LAS float* XM = xch; LAS float* XS = xch + 1024;
#pragma unroll
            for (int ai = 0; ai < 2; ++ai)
#pragma unroll
                for (int m = 0; m < 4; ++m) { float t = -1e30f;
#pragma unroll
                    for (int bj = 0; bj < 2; ++bj)
#pragma unroll
                        for (int n = 0; n < 2; ++n) { const f32x4 x = acc[ai][bj][m][n]; t = fmaxf(t, fmaxf(fmaxf(x[0], x[1]), fmaxf(x[2], x[3]))); }
                    t = fmaxf(t, __shfl_xor(t, 16)); t = fmaxf(t, __shfl_xor(t, 32));
                    if (fq == 0) XM[(ai * 128 + wr * 64 + m * 16 + fr) * 4 + wc] = t; }
            asm volatile("s_waitcnt lgkmcnt(0)" ::: "memory"); __builtin_amdgcn_s_barrier(); asm volatile("" ::: "memory");
#pragma unroll
            for (int ai = 0; ai < 2; ++ai)
#pragma unroll
                for (int m = 0; m < 4; ++m) { const int rt = ai * 128 + wr * 64 + m * 16 + fr; const f32x4 q = *(const LAS f32x4*)(XM + rt * 4);
                    const float mxr = fmaxf(fmaxf(q[0], q[1]), fmaxf(q[2], q[3])); float s = 0.f;
#pragma unroll
                    for (int bj = 0; bj < 2; ++bj)
#pragma unroll
                        for (int n = 0; n < 2; ++n)
#pragma unroll
                            for (int e = 0; e < 4; ++e) { const float x = fast_exp2(acc[ai][bj][m][n][e] - mxr); acc[ai][bj][m][n][e] = x; s += x; }
                    s += __shfl_xor(s, 16); s += __shfl_xor(s, 32);
                    if (fq == 0) XS[rt * 4 + wc] = s; }
            asm volatile("s_waitcnt lgkmcnt(0)" ::: "memory"); __builtin_amdgcn_s_barrier(); asm volatile("" ::: "memory");
            bf16_t* P = (bf16_t*)(ws + WS_P) + (size_t)u.pn * S * 256;
#pragma unroll
            for (int ai = 0; ai < 2; ++ai)
#pragma unroll
                for (int m = 0; m < 4; ++m) { const int rt = ai * 128 + wr * 64 + m * 16 + fr; const f32x4 q = *(const LAS f32x4*)(XS + rt * 4);
                    const float iv = fast_rcp((q[0] + q[1]) + (q[2] + q[3]));
#pragma unroll
                    for (int bj = 0; bj < 2; ++bj) { float v[8];
#pragma unroll
                        for (int j = 0; j < 8; ++j) v[j] = acc[ai][bj][m][j >> 2][j & 3] * iv;
                        *(u32x4*)(P + (size_t)(row0 + rt) * 256 + bj * 128 + wc * 32 + 8 * fq) = pack8(v); } }
            return;
        }
        const float* stp = (const float*)(ws + (mode == M_QUP ? WS_CQST : WS_CKVST));
        const f32x2* CS = (const f32x2*)(ws + WS_CS);
        LAS float* RS = xch + 2048 + 64;
        { const int t_ = ((wr * 4 + wc) * 4 + fq) * 16 + fr;
          if (t_ < 256) { float ss = 0.f;
#pragma unroll
              for (int j = 0; j < 8; ++j) ss += stp[(size_t)j * S + row0 + t_];
              RS[t_] = 1.0f / sqrtf(ss * (1.f / 512.f) + EPS); }
          asm volatile("s_waitcnt lgkmcnt(0)" ::: "memory"); __builtin_amdgcn_s_barrier(); asm volatile("" ::: "memory"); }
#pragma unroll
        for (int ai = 0; ai < 2; ++ai)
#pragma unroll
            for (int m = 0; m < 4; ++m) { const int row = row0 + ai * 128 + wr * 64 + m * 16 + fr;
                const float rs = RS[ai * 128 + wr * 64 + m * 16 + fr];
#pragma unroll
                for (int bj = 0; bj < 2; ++bj) { const int ct = bj * 128 + wc * 32 + 8 * fq;
                    float v[8] = {acc[ai][bj][m][0][0], acc[ai][bj][m][0][1], acc[ai][bj][m][0][2], acc[ai][bj][m][0][3], acc[ai][bj][m][1][0], acc[ai][bj][m][1][1], acc[ai][bj][m][1][2], acc[ai][bj][m][1][3]};
#pragma unroll
                    for (int j = 0; j < 8; ++j) v[j] *= rs;
                    if (mode == M_QUP) { const int cg = u.pn * 256 + ct, head = cg / DQK, w = cg - head * DQK;
                        bf16_t* q = (bf16_t*)(ws + WS_QB) + ((size_t)head * S + row) * DQK;
                        if (w < 128) *(u32x4*)(q + w) = pack8(v);
                        else { const int i0 = (w - 128) >> 1; float o1[4], o2[4];
#pragma unroll
                            for (int j = 0; j < 4; ++j) { const f32x2 cs = CS[row * 32 + i0 + j]; const float t1 = v[2 * j], t2 = v[2 * j + 1]; o1[j] = t1 * cs.x - t2 * cs.y; o2[j] = t2 * cs.x + t1 * cs.y; }
                            u32x2 w1, w2; w1.x = cvt_pk_bf16(o1[0], o1[1]); w1.y = cvt_pk_bf16(o1[2], o1[3]); w2.x = cvt_pk_bf16(o2[0], o2[1]); w2.y = cvt_pk_bf16(o2[2], o2[3]);
                            *(u32x2*)(q + 128 + i0) = w1; *(u32x2*)(q + 160 + i0) = w2; } }
                    else { const int head = u.pn;
                        if (bj == 0) *(u32x4*)((bf16_t*)(ws + WS_KB) + ((size_t)head * S + row) * DQK + wc * 32 + 8 * fq) = pack8(v);
                        else *(u32x4*)((bf16_t*)(ws + WS_VB) + ((size_t)head * S + row) * DV + wc * 32 + 8 * fq) = pack8(v); }
                }
                if (mode == M_KVUP && wc < 2) {
                    const u32x4 kr = *(const u32x4*)((const bf16_t*)(ws + WS_KR) + (size_t)row * 64 + (wc * 4 + fq) * 8);
                    *(u32x4*)((bf16_t*)(ws + WS_KB) + ((size_t)u.pn * S + row) * DQK + 128 + (wc * 4 + fq) * 8) = kr; }
            }
    }
};
struct SchedP2 {
    const unsigned char* ws; int G, c;
    __device__ __forceinline__ bool next(int i, Unit& u) const {
        if (i >= 4 || c >= 256) return false;
        const int x = c & 7, l = i * 32 + (c >> 3);
        if (l < 48) { const int pm = 4 * x + (l & 3), pn = l >> 2; u.pm = pm; u.pn = pn; u.mode = M_QUP; u.A = (const char*)(ws + WS_CQ) + (size_t)pm * 256 * 512 * 2; u.B = (const char*)(ws + WS_WUQ) + (size_t)pn * 256 * 512 * 2; }
        else if (l < 112) { const int l2 = l - 48, pm = 4 * x + (l2 & 3), pn = l2 >> 2; u.pm = pm; u.pn = pn; u.mode = M_KVUP; u.A = (const char*)(ws + WS_CKV) + (size_t)pm * 256 * 512 * 2; u.B = (const char*)(ws + WS_WUKV) + (size_t)pn * 256 * 512 * 2; }
        else { const int l2 = l - 112, pm = 4 * x + (l2 & 3), h = l2 >> 2; u.pm = pm; u.pn = h; u.mode = M_MEMS; u.A = (const char*)(ws + WS_QMH) + ((size_t)h * S + pm * 256) * 512 * 2; u.B = (const char*)(ws + WS_KMH) + (size_t)h * ML * 512 * 2; }
        return true;
    }
};

struct EpiMulZ {
    __device__ __forceinline__ bool keep_acc(const Unit&) const { return false; }
    unsigned char* dout;
    __device__ __forceinline__ void operator()(f32x4 (&acc)[2][2][4][2], const Unit& u, int wr, int wc, int fr, int fq) const {
        bf16_t* Z = (bf16_t*)dout + (size_t)S * D; const int row0 = u.pm * 256, cb = u.pn * 256;
        EPI_LOOP_BEGIN
            bf16_t* p = Z + (size_t)(row0 + rt) * D + cb + ct; float z[8]; unpack8(*(const u32x4*)p, z);
#pragma unroll
            for (int j = 0; j < 8; ++j) v[j] *= z[j];
            *(u32x4*)p = pack8(v);
        EPI_LOOP_END
    }
};
struct SchedP3b {
    const unsigned char* ws; int G, c;
    __device__ __forceinline__ bool next(int i, Unit& u) const {
        const int L = i * G + c; if (L >= 256) return false;
        const int pm = L >> 3, hn = L & 7, h = hn >> 1; u.pm = pm; u.pn = hn; u.mode = M_MULZ;
        u.A = (const char*)(ws + WS_P) + ((size_t)h * S + pm * 256) * 256 * 2; u.B = (const char*)(ws + WS_VMT) + (size_t)hn * 256 * 256 * 2; return true;
    }
};

struct EpiP4 {
    unsigned char* ws;
    __device__ __forceinline__ bool keep_acc(const Unit& u) const { return u.mode != M_BR2; }
    __device__ __forceinline__ void operator()(f32x4 (&acc)[2][2][4][2], const Unit& u, int wr, int wc, int fr, int fq) const {
        const int n = u.mode - M_BR0, row0 = u.pm * 256, cb = u.pn * 256;
        const bf16_t* G = (const bf16_t*)(ws + WS_G) + (size_t)n * D; bf16_t* MG = (bf16_t*)(ws + WS_MERGED); constexpr float GMIN = 9.094947e-13f;
#pragma unroll
        for (int ai = 0; ai < 2; ++ai) {
            u32x4 ga[4][2], gb[4][2];
#pragma unroll
            for (int m = 0; m < 4; ++m)
#pragma unroll
                for (int bj = 0; bj < 2; ++bj) { const size_t r = (size_t)(row0 + ai * 128 + wr * 64 + m * 16 + fr); const bf16_t* gp = G + r * 3 * D + cb + bj * 128 + wc * 32 + 8 * fq;
                    ga[m][bj] = *(const u32x4*)gp; if (n < 2) gb[m][bj] = *(const u32x4*)(gp + D); }
#pragma unroll
            for (int m = 0; m < 4; ++m)
#pragma unroll
                for (int bj = 0; bj < 2; ++bj) { float g[8]; unpack8(ga[m][bj], g);
                    if (n < 2) { float gn[8]; unpack8(gb[m][bj], gn);
#pragma unroll
                        for (int j = 0; j < 8; ++j) acc[ai][bj][m][j >> 2][j & 3] *= fmaxf(g[j], GMIN) * fast_rcp(fmaxf(gn[j], GMIN)); }
                    else { float v[8]; const size_t r = (size_t)(row0 + ai * 128 + wr * 64 + m * 16 + fr);
#pragma unroll
                        for (int j = 0; j < 8; ++j) v[j] = acc[ai][bj][m][j >> 2][j & 3] * fmaxf(g[j], GMIN);
                        *(u32x4*)(MG + r * D + cb + bj * 128 + wc * 32 + 8 * fq) = pack8(v); } }
        }
    }
};
struct SchedP4 {
    const unsigned char* ws; const unsigned char* dout; int G, c;
    __device__ __forceinline__ bool next(int i, Unit& u) const {
        if (i >= 3 || c >= 256) return false;
        const int vc = (c % 8) * 32 + c / 8, pm = vc / 8, pn = vc % 8; u.pm = pm; u.pn = pn; u.mode = M_BR0 + i;
        const unsigned char* y = i == 0 ? ws + WS_UG : i == 1 ? dout : dout + (size_t)S * D * 2;
        u.A = (const char*)y + (size_t)pm * 256 * D * 2; u.B = (const char*)(ws + WS_WBR) + ((size_t)i * D + pn * 256) * D * 2; return true;
    }
};

struct EpiP5 {
    __device__ __forceinline__ bool keep_acc(const Unit&) const { return false; }
    unsigned char* ws; float* out;
    __device__ __forceinline__ void operator()(f32x4 (&acc)[2][2][4][2], const Unit& u, int wr, int wc, int fr, int fq) const {
        const int row0 = u.pm * 256, cb = u.pn * 256; float* st = (float*)(ws + WS_OST) + (size_t)(u.pn * 4 + wc) * S;
#pragma unroll
        for (int ai = 0; ai < 2; ++ai)
#pragma unroll
            for (int m = 0; m < 4; ++m) { const int rt = ai * 128 + wr * 64 + m * 16 + fr; float s2 = 0.f;
#pragma unroll
                for (int bj = 0; bj < 2; ++bj) { const int ct = bj * 128 + wc * 32 + 8 * fq; const f32x4 a = acc[ai][bj][m][0], b = acc[ai][bj][m][1];
                    s2 += (a[0] * a[0] + a[1] * a[1]) + (a[2] * a[2] + a[3] * a[3]) + (b[0] * b[0] + b[1] * b[1]) + (b[2] * b[2] + b[3] * b[3]);
                    const float v_[8] = {a[0], a[1], a[2], a[3], b[0], b[1], b[2], b[3]}; *(u32x4*)((bf16_t*)(ws + WS_MP) + (size_t)(row0 + rt) * D + cb + ct) = pack8(v_); }
                s2 += __shfl_xor(s2, 16); s2 += __shfl_xor(s2, 32);
                if (fq == 0) st[row0 + rt] = s2; }
    }
};
struct SchedP5 {
    const unsigned char* ws; int G, c;
    __device__ __forceinline__ bool next(int i, Unit& u) const {
        if (i >= 1 || c >= 256) return false;
        const int vc = (c % 8) * 32 + c / 8, pm = vc / 8, pn = vc % 8; u.pm = pm; u.pn = pn; u.mode = M_OUT;
        u.A = (const char*)(ws + WS_MERGED) + (size_t)pm * 256 * D * 2; u.B = (const char*)(ws + WS_WOUT) + (size_t)pn * 256 * D * 2; return true;
    }
};

enum { MAP_ID = 0, MAP_WIN, MAP_UQ };
__device__ __forceinline__ int map_row(int map, int n) {
    if (map == MAP_WIN) { if (n < 7168) return n; if (n < 7232) { const int i = n - 7168; return 7168 + (i < 32 ? 2 * i : 2 * (i - 32) + 1); } return n + 192; }
    if (map == MAP_UQ) { const int h = n / DQK, w = n - h * DQK; if (w < 128) return n; const int i = w - 128; return h * DQK + 128 + (i < 32 ? 2 * i : 2 * (i - 32) + 1); }
    return n;
}
struct WTile { const float* W; bf16_t* WT; const float* kgain; int K, N, row_off, map, k0, n0; float sc; };
struct WSeg { const float* W; bf16_t* WT; const float* kgain; int K, N, row_off, map; float sc; };
__device__ __forceinline__ WTile wtile_of(const WSeg& s, int r) { WTile t; t.W = s.W; t.WT = s.WT; t.kgain = s.kgain; t.K = s.K; t.N = s.N; t.row_off = s.row_off; t.map = s.map; t.sc = s.sc;
    const int nblk = s.N / 64; t.k0 = 64 * (r / nblk); t.n0 = 64 * (r % nblk); return t; }
__device__ __forceinline__ void wtile_issue(const WTile& t, f32x4 (&r)[16], int lane) {
    const float* p = t.W + (size_t)(t.k0 + (lane >> 4)) * t.N + t.n0 + 4 * (lane & 15);
#pragma unroll
    for (int q = 0; q < 16; ++q) r[q] = *(const f32x4*)(p + (size_t)(4 * q) * t.N);
}
__device__ __forceinline__ void wtile_finish(const WTile& t, const f32x4 (&r)[16], LAS float* scr, int lane) {
#pragma unroll
    for (int q = 0; q < 16; ++q) { const int k = 4 * q + (lane >> 4); f32x4 v = r[q] * t.sc; if (t.kgain) v = v * t.kgain[t.k0 + k];
        *(LAS f32x4*)(scr + k * 64 + ((4 * (lane & 15)) ^ (((k >> 3) & 7) << 3))) = v; }
    asm volatile("s_waitcnt lgkmcnt(0)" ::: "memory");
    const int c = lane & 7;
#pragma unroll
    for (int j = 0; j < 8; ++j) { const int n = (lane >> 3) + 8 * j; const LAS float* s = scr + (8 * c) * 64 + (n ^ (c << 3));
        u32x4 o; o.x = cvt_pk_bf16(s[0 * 64], s[1 * 64]); o.y = cvt_pk_bf16(s[2 * 64], s[3 * 64]); o.z = cvt_pk_bf16(s[4 * 64], s[5 * 64]); o.w = cvt_pk_bf16(s[6 * 64], s[7 * 64]);
        *(u32x4*)(t.WT + (size_t)(t.row_off + map_row(t.map, t.n0 + n)) * t.K + t.k0 + 8 * c) = o; }
    asm volatile("s_waitcnt lgkmcnt(0)" ::: "memory");
}
template <int NSEG> __device__ __forceinline__ WTile wtile_decode(const WSeg (&seg)[NSEG], int it) {
    int r = it;
#pragma unroll
    for (int s = 0; s < NSEG - 1; ++s) { const int cnt = (seg[s].K / 64) * (seg[s].N / 64); if (r < cnt) return wtile_of(seg[s], r); r -= cnt; }
    return wtile_of(seg[NSEG - 1], r);
}
template <int NSEG> __device__ __forceinline__ void wconv_run(const WSeg (&seg)[NSEG], int ntiles, int it0, int stride, LAS float* scr, int lane) {
    if (it0 >= ntiles) return;
    f32x4 ra[16], rb[16];
    WTile ta = wtile_decode(seg, it0), tb = ta; wtile_issue(ta, ra, lane);
    for (int it = it0; it < ntiles; it += 2 * stride) {
        const bool hb = it + stride < ntiles; if (hb) { tb = wtile_decode(seg, it + stride); wtile_issue(tb, rb, lane); }
        wtile_finish(ta, ra, scr, lane);
        if (!hb) break;
        const bool ha = it + 2 * stride < ntiles; if (ha) { ta = wtile_decode(seg, it + 2 * stride); wtile_issue(ta, ra, lane); }
        wtile_finish(tb, rb, scr, lane);
    }
}
__device__ __forceinline__ void rms_row_to_bf16(const float* xrow, const float* g, bf16_t* orow, int lane) {
    const f32x4* xr = (const f32x4*)xrow + lane; const f32x4* gr = (const f32x4*)g + lane;
    f32x4 v[8]; float s = 0.f;
#pragma unroll
    for (int j = 0; j < 8; ++j) { v[j] = xr[64 * j]; s += (v[j].x * v[j].x + v[j].y * v[j].y) + (v[j].z * v[j].z + v[j].w * v[j].w); }
    const float rs = 1.0f / sqrtf(wave_sum(s) * (1.f / D) + EPS);
    u32x2* o8 = (u32x2*)orow + lane;
#pragma unroll
    for (int j = 0; j < 8; ++j) { const f32x4 gg = gr[64 * j]; u32x2 w; w.x = cvt_pk_bf16(v[j].x * rs * gg.x, v[j].y * rs * gg.y); w.y = cvt_pk_bf16(v[j].z * rs * gg.z, v[j].w * rs * gg.w); o8[64 * j] = w; }
}
__device__ __forceinline__ void phase0(const Ptrs& P, LAS unsigned char* lds, int vcu, int G, int tid, int lane, int wave) {
    unsigned char* ws = P.ws;
    LAS float* scr = (LAS float*)(lds + wave * 16384);
    const int gw = vcu * NWAVES + wave, NGW = G * NWAVES;
    { const WSeg seg[2] = {
          {P.in[4], (bf16_t*)(ws + WS_WIN), nullptr, D, IN_TOTAL, 0, MAP_WIN, 1.f},
          {P.in[15], (bf16_t*)(ws + WS_WIN), nullptr, D, 6144, 53 * 256, MAP_ID, 1.f}};
      constexpr int NT0 = 32 * (IN_TOTAL / 64) + 32 * 96;
      wconv_run(seg, NT0, gw, NGW, scr, lane); }
    { u32x4* z = (u32x4*)((bf16_t*)(ws + WS_WIN) + (size_t)7232 * D); const int n16 = 192 * D * 2 / 16;
      for (int i = vcu * NTHREADS + tid; i < n16; i += G * NTHREADS) z[i] = (u32x4){0u, 0u, 0u, 0u}; }
    constexpr int NT0R = (32 * (IN_TOTAL / 64) + 32 * 96) % (256 * NWAVES);
    const int gwr = gw >= NT0R ? gw - NT0R : gw + NGW - NT0R;
    for (int m = gwr; m < S + ML; m += NGW) {
        if (m < S) rms_row_to_bf16(P.in[0] + (size_t)m * D, P.in[3], (bf16_t*)(ws + WS_H) + (size_t)m * D, lane);
        else rms_row_to_bf16(P.in[1] + (size_t)(m - S) * D, P.in[13], (bf16_t*)(ws + WS_MEMN) + (size_t)(m - S) * D, lane);
    }
    { const int* pos = (const int*)P.in[2]; f32x2* CS = (f32x2*)(ws + WS_CS);
      for (int e = vcu * NTHREADS + tid; e < S * 32; e += G * NTHREADS) { const int row = e >> 5, i = e & 31;
          const double inv = exp2(-(double)i * (13.287712379549449 / 32.0));
          const float invf = (float)inv; const float angf = (float)pos[row] * invf;
          const double a = (double)angf; const double k = rint(a * 0.15915494309189535); const float r = (float)(a - k * 6.283185307179586);
          CS[e] = (f32x2){__cosf(r), __sinf(r)}; } }
    { const float* w = P.in[7]; bf16_t* o = (bf16_t*)(ws + WS_WSM);
      for (int e = vcu * NTHREADS + tid; e < 16 * 128 * 128 / 2; e += G * NTHREADS) { const int idx = e * 2, t = (idx >> 7) & 127, s = idx & 127;
          const float a = s <= t ? w[idx] : 0.f, b = (s + 1) <= t ? w[idx + 1] : 0.f; ((unsigned*)o)[e] = cvt_pk_bf16(a, b); } }
}
__device__ __forceinline__ void phase_wconv2(const Ptrs& P, LAS unsigned char* lds, int part, int wg0, int nwg, int lane, int wave) {
    unsigned char* ws = P.ws; LAS float* scr = (LAS float*)(lds + wave * 16384);
    const int gw = wg0 * NWAVES + wave, NGW = nwg * NWAVES;
    if (part == 0) {
        const WSeg seg[3] = {
            {P.in[14], (bf16_t*)(ws + WS_WMEM), nullptr, D, 4096, 0, MAP_ID, 1.f},
            {P.in[10], (bf16_t*)(ws + WS_WUQ), P.in[9], 512, 3072, 0, MAP_UQ, QSCALE},
            {P.in[12], (bf16_t*)(ws + WS_WUKV), P.in[11], 512, 4096, 0, MAP_ID, 1.f}};
        wconv_run(seg, 32 * 64 + 8 * 48 + 8 * 64, gw, NGW, scr, lane);
    } else {
        const WSeg seg[4] = {
            {P.in[17], (bf16_t*)(ws + WS_WBR), nullptr, D, D, 0, MAP_ID, 1.f},
            {P.in[17] + (size_t)D * D, (bf16_t*)(ws + WS_WBR), nullptr, D, D, D, MAP_ID, 1.f},
            {P.in[17] + (size_t)2 * D * D, (bf16_t*)(ws + WS_WBR), nullptr, D, D, 2 * D, MAP_ID, 1.f},
            {P.in[18], (bf16_t*)(ws + WS_WOUT), nullptr, D, D, 0, MAP_ID, 1.f}};
        wconv_run(seg, 4 * 32 * 32, gw, NGW, scr, lane);
    }
}

namespace att {
constexpr int NW = 8, QBLK = 32, KVBLK = 64, QB = 256;
constexpr int SHM_V = KVBLK * DV * 2, SHM_K = KVBLK * DQK * 2;
constexpr float THR = 6.f;
#define SBAR() __builtin_amdgcn_sched_barrier(0)
#define KSWZ(row, colB) ((row) * 384 + ((colB) ^ ((((row) >> 1) & 7) << 4)))
__device__ __forceinline__ int v_st(int k, int c) { const int kk = (k & ~0xC) | ((k & 4) << 1) | ((k & 8) >> 1); return ((kk >> 3) * 4 + (c >> 5)) * 512 + ((kk & 7) * 32 + (c & 31)) * 2; }
__device__ __forceinline__ int v_rd_base(int lane) { return ((lane & 3) << 3) | (((lane >> 2) & 3) << 6) | (((lane >> 4) & 1) << 5) | (((lane >> 5) & 1) << 8); }
constexpr int v_rd_off(int d0, int ks, int half) { return d0 * 512 + ks * 4096 + half * 2048; }
__device__ __forceinline__ int crow(int r, int hi) { return (r & 3) + 8 * (r >> 2) + 4 * hi; }
__device__ __forceinline__ void mask_tile(f32x16& p0, f32x16& p1, int dq) {
    const float NEG = -__builtin_inff();
#pragma unroll
    for (int r = 0; r < 16; ++r) { const int c = (r & 3) + 8 * (r >> 2); if (dq - c < 0) p0[r] = NEG; if (dq - c - 32 < 0) p1[r] = NEG; }
}
__device__ __forceinline__ void partialSM(f32x16& p0, f32x16& p1, float& m_reg, float& mn, float& alpha) {
    float pmax = p0[0];
#pragma unroll
    for (int r = 1; r < 16; ++r) pmax = fmaxf(pmax, p0[r]);
#pragma unroll
    for (int r = 0; r < 16; ++r) pmax = fmaxf(pmax, p1[r]);
    { auto rr = __builtin_amdgcn_permlane32_swap(__float_as_uint(pmax), __float_as_uint(pmax), false, false); pmax = fmaxf(__uint_as_float(rr[0]), __uint_as_float(rr[1])); }
    if (__builtin_expect(__all((pmax - m_reg) <= THR), 1)) { mn = m_reg; alpha = 1.f; }
    else { mn = fmaxf(m_reg, pmax); alpha = fast_exp2(m_reg - mn); m_reg = mn; }
#pragma unroll
    for (int r = 0; r < 16; ++r) p0[r] = p0[r] - mn;
#pragma unroll
    for (int r = 0; r < 16; ++r) p1[r] = p1[r] - mn;
#pragma unroll
    for (int r = 0; r < 16; ++r) p0[r] = fast_exp2(p0[r]);
}
__device__ __forceinline__ void finishSM(f32x16& p0, f32x16& p1, float alpha, float& l_reg, bf16x8& pa0, bf16x8& pa1, bf16x8& pa2, bf16x8& pa3) {
#pragma unroll
    for (int r = 0; r < 16; ++r) p1[r] = fast_exp2(p1[r]);
    float ps = 0;
#pragma unroll
    for (int r = 0; r < 16; ++r) ps += p0[r];
#pragma unroll
    for (int r = 0; r < 16; ++r) ps += p1[r];
    { auto rr = __builtin_amdgcn_permlane32_swap(__float_as_uint(ps), __float_as_uint(ps), false, false); ps = __uint_as_float(rr[0]) + __uint_as_float(rr[1]); }
    l_reg = l_reg * alpha + ps;
#define PK4(P, B_, OUT) do { unsigned a0 = cvt_pk_bf16(P[B_+0], P[B_+1]), a1 = cvt_pk_bf16(P[B_+2], P[B_+3]); unsigned b0 = cvt_pk_bf16(P[B_+4], P[B_+5]), b1 = cvt_pk_bf16(P[B_+6], P[B_+7]); \
        auto r0 = __builtin_amdgcn_permlane32_swap(a0, b0, false, false); auto r1 = __builtin_amdgcn_permlane32_swap(a1, b1, false, false); \
        u32x4 w = {r0[0], r1[0], r0[1], r1[1]}; OUT = *reinterpret_cast<bf16x8*>(&w); } while (0)
    PK4(p0, 0, pa0); PK4(p0, 8, pa1); PK4(p1, 0, pa2); PK4(p1, 8, pa3);
#undef PK4
}
#define TRRD(dst, off) asm volatile("ds_read_b64_tr_b16 %0, %1 offset:%2" : "=&v"(dst) : "v"(vb0), "i"(off) : "memory")
#define PV_D0(OO, VBOFF, d0) do { s16x4 l0, l1, l2, l3, h0, h1, h2, h3; constexpr int b_ = (VBOFF) + v_rd_off(d0, 0, 0); \
        TRRD(l0, b_); TRRD(h0, b_ + 2048); TRRD(l1, b_ + 4096); TRRD(h1, b_ + 6144); TRRD(l2, b_ + 8192); TRRD(h2, b_ + 10240); TRRD(l3, b_ + 12288); TRRD(h3, b_ + 14336); \
        asm volatile("s_waitcnt lgkmcnt(0)" ::: "memory"); SBAR(); \
        OO = __builtin_amdgcn_mfma_f32_32x32x16_bf16(pa0, (bf16x8){l0[0], l0[1], l0[2], l0[3], h0[0], h0[1], h0[2], h0[3]}, OO, 0, 0, 0); \
        OO = __builtin_amdgcn_mfma_f32_32x32x16_bf16(pa1, (bf16x8){l1[0], l1[1], l1[2], l1[3], h1[0], h1[1], h1[2], h1[3]}, OO, 0, 0, 0); \
        OO = __builtin_amdgcn_mfma_f32_32x32x16_bf16(pa2, (bf16x8){l2[0], l2[1], l2[2], l2[3], h2[0], h2[1], h2[2], h2[3]}, OO, 0, 0, 0); \
        OO = __builtin_amdgcn_mfma_f32_32x32x16_bf16(pa3, (bf16x8){l3[0], l3[1], l3[2], l3[3], h3[0], h3[1], h3[2], h3[3]}, OO, 0, 0, 0); } while (0)
__device__ __forceinline__ void glds16(const void* gsrc, unsigned lds_dst) { unsigned keep;
    asm volatile("s_mov_b32 %0, m0\n\ts_mov_b32 m0, %2\n\ts_nop 0\n\tglobal_load_lds_dwordx4 %1, off\n\ts_mov_b32 m0, %0" : "=&s"(keep) : "v"(gsrc), "s"(lds_dst) : "memory"); }
typedef short v4i16_t __attribute__((ext_vector_type(4)));
__device__ __forceinline__ s16x4 vtr(const LAS char* p) { return __builtin_bit_cast(s16x4, __builtin_amdgcn_ds_read_tr16_b64_v4i16((LAS v4i16_t*)p)); }
__device__ __forceinline__ void pv_tile2(f32x16* o, const LAS char* vp, bf16x8 pa0, bf16x8 pa1, bf16x8 pa2, bf16x8 pa3) {
#pragma unroll
    for (int d0 = 0; d0 < 4; ++d0) {
        const s16x4 l0 = vtr(vp + d0 * 512), h0 = vtr(vp + d0 * 512 + 2048), l1 = vtr(vp + d0 * 512 + 4096), h1 = vtr(vp + d0 * 512 + 6144);
        const s16x4 l2 = vtr(vp + d0 * 512 + 8192), h2 = vtr(vp + d0 * 512 + 10240), l3 = vtr(vp + d0 * 512 + 12288), h3 = vtr(vp + d0 * 512 + 14336);
        o[d0] = __builtin_amdgcn_mfma_f32_32x32x16_bf16(pa0, (bf16x8){l0[0], l0[1], l0[2], l0[3], h0[0], h0[1], h0[2], h0[3]}, o[d0], 0, 0, 0);
        o[d0] = __builtin_amdgcn_mfma_f32_32x32x16_bf16(pa1, (bf16x8){l1[0], l1[1], l1[2], l1[3], h1[0], h1[1], h1[2], h1[3]}, o[d0], 0, 0, 0);
        o[d0] = __builtin_amdgcn_mfma_f32_32x32x16_bf16(pa2, (bf16x8){l2[0], l2[1], l2[2], l2[3], h2[0], h2[1], h2[2], h2[3]}, o[d0], 0, 0, 0);
        o[d0] = __builtin_amdgcn_mfma_f32_32x32x16_bf16(pa3, (bf16x8){l3[0], l3[1], l3[2], l3[3], h3[0], h3[1], h3[2], h3[3]}, o[d0], 0, 0, 0); }
}
constexpr int OFF3_V = 0, OFF3_K = 4 * SHM_V, OFF3_WS = OFF3_K + 3 * SHM_K + 256;
__device__ __forceinline__ void attn_block3(const bf16_t* Qh, const bf16_t* Kh, const bf16_t* Vh, bf16_t* ZY, int P0, char* lds, const int tid) {
    const int wid = __builtin_amdgcn_readfirstlane(tid >> 6), lane = tid & 63, r32 = lane & 31, hi = lane >> 5;
    const bool lag = wid >= 4;
    const int NT = (P0 + QB) / KVBLK;
    const int qlo = P0 + wid * QBLK, qm = qlo + r32 - 4 * hi;
    char* K_lds = lds + OFF3_K;
    float* wsf = (float*)(lds + OFF3_WS) + wid * 64; float* li_l = wsf, * al_l = wsf + 32;
    float m_reg = -1e30f, l_reg = 0; f32x16 o[4] = {};
    const unsigned lds0 = (unsigned)(uintptr_t)lds;
    int kso[3], vso[2];
#pragma unroll
    for (int j = 0; j < 3; ++j) { const int q = (wid * 3 + j) * 1024 + lane * 16, row = q / 384, pos = q - row * 384; kso[j] = row * 384 + (pos ^ (((row >> 1) & 7) << 4)); }
#pragma unroll
    for (int j = 0; j < 2; ++j) { const int q = (wid * 2 + j) * 1024 + lane * 16, sub = q >> 9, within = q & 511, kk = (sub >> 2) * 8 + (within >> 6), cc = (within & 63) >> 1;
        const int k = (kk & ~0xC) | ((kk & 4) << 1) | ((kk & 8) >> 1), c = (sub & 3) * 32 + cc; vso[j] = k * (DV * 2) + c * 2; }
    int kis = 0, vis = 0, kq = 0, vp = 0;
#define ROTK(x) ((x) == 2 * SHM_K ? 0 : (x) + SHM_K)
#define ROTV(x) ((x) == 3 * SHM_V ? 0 : (x) + SHM_V)
#define DMA_TILE(t) do { const char* kt_ = (const char*)Kh + (size_t)(t) * SHM_K; const char* vt_ = (const char*)Vh + (size_t)(t) * SHM_V; \
        _Pragma("unroll") for (int j_ = 0; j_ < 3; ++j_) glds16(kt_ + kso[j_], (unsigned)__builtin_amdgcn_readfirstlane(lds0 + OFF3_K + kis + (wid * 3 + j_) * 1024)); \
        _Pragma("unroll") for (int j_ = 0; j_ < 2; ++j_) glds16(vt_ + vso[j_], (unsigned)__builtin_amdgcn_readfirstlane(lds0 + OFF3_V + vis + (wid * 2 + j_) * 1024)); \
        kis = ROTK(kis); vis = ROTV(vis); } while (0)
#define END_M() asm volatile("s_waitcnt vmcnt(0) lgkmcnt(0)\n\ts_barrier" ::: "memory")
#define END_V() asm volatile("s_waitcnt lgkmcnt(0)\n\ts_barrier" ::: "memory")
    int ko[4];
#pragma unroll
    for (int dd = 0; dd < 4; ++dd) ko[dd] = KSWZ(r32, (dd * 16 + hi * 8) * 2);
    const LAS char* vbb = (const LAS char*)lds + OFF3_V + v_rd_base(lane);
    DMA_TILE(0); DMA_TILE(1);
    bf16x8 qr[12];
#pragma unroll
    for (int d0 = 0; d0 < 12; ++d0) qr[d0] = *reinterpret_cast<const bf16x8*>(Qh + (size_t)(P0 + wid * QBLK + r32) * DQK + d0 * 16 + hi * 8);
#define RESC(a) do { if (__any((a) < 1.f)) { if (hi == 0) al_l[r32] = (a); asm volatile("s_waitcnt lgkmcnt(0)" ::: "memory"); \
        _Pragma("unroll") for (int d_ = 0; d_ < 4; ++d_) _Pragma("unroll") for (int r = 0; r < 16; ++r) o[d_][r] *= al_l[crow(r, hi)]; } } while (0)
    f32x16 p0, p1; float mn, al; bf16x8 pa0, pa1, pa2, pa3;
    END_M();
    if (lag) END_V();
    for (int i = 0; i < NT; ++i) {
        const char* kb_ = K_lds + kq; bf16x8 ka[6], kb2[6];
#define KLOAD(dst, bt) do { _Pragma("unroll") for (int e = 0; e < 3; ++e) { const int d0 = 3 * (bt) + e; const char* a = kb_ + ko[d0 & 3] + (d0 >> 2) * 128; dst[2 * e] = *reinterpret_cast<const bf16x8*>(a); dst[2 * e + 1] = *reinterpret_cast<const bf16x8*>(a + 32 * 384); } } while (0)
#define KMMA(srcf, bt) do { _Pragma("unroll") for (int e = 0; e < 3; ++e) { p0 = __builtin_amdgcn_mfma_f32_32x32x16_bf16(srcf[2 * e], qr[3 * (bt) + e], p0, 0, 0, 0); p1 = __builtin_amdgcn_mfma_f32_32x32x16_bf16(srcf[2 * e + 1], qr[3 * (bt) + e], p1, 0, 0, 0); } } while (0)
        SBAR();
        if (i >= 1) { pv_tile2(o, vbb + vp, pa0, pa1, pa2, pa3); vp = ROTV(vp); }
        SBAR();
        { p0 = f32x16{}; p1 = f32x16{};
          KLOAD(ka, 0); SBAR(); KLOAD(kb2, 1); SBAR(); KMMA(ka, 0); SBAR(); KLOAD(ka, 2); SBAR(); KMMA(kb2, 1); SBAR(); KLOAD(kb2, 3); SBAR(); KMMA(ka, 2); SBAR(); KMMA(kb2, 3);
#undef KLOAD
#undef KMMA
          kq = ROTK(kq); }
        END_M();
        if (i + 2 < NT) DMA_TILE(i + 2);
        SBAR();
        { const int kb_ = i * KVBLK; if (kb_ + KVBLK - 1 > qlo) mask_tile(p0, p1, qm - kb_); }
        partialSM(p0, p1, m_reg, mn, al); RESC(al);
        finishSM(p0, p1, al, l_reg, pa0, pa1, pa2, pa3);
        END_V();
    }
    SBAR(); pv_tile2(o, vbb + vp, pa0, pa1, pa2, pa3);
    if (!lag) END_V();
    if (hi == 0) li_l[r32] = l_reg; asm volatile("s_waitcnt lgkmcnt(0)" ::: "memory");
    float rli[16];
#pragma unroll
    for (int r = 0; r < 16; ++r) rli[r] = fast_rcp(li_l[crow(r, hi)]);
    __syncthreads();
    bf16_t* stg = (bf16_t*)lds + wid * 4096;
#pragma unroll
    for (int r = 0; r < 16; ++r) { const int orow = crow(r, hi);
#pragma unroll
        for (int d0 = 0; d0 < 4; ++d0) { const float v = o[d0][r] * rli[r]; const float vn = __shfl_xor(v, 1);
            if ((r32 & 1) == 0) *(unsigned*)(stg + orow * 128 + d0 * 32 + r32) = cvt_pk_bf16(v, vn); } }
    asm volatile("s_waitcnt lgkmcnt(0)" ::: "memory");
    bf16_t* zy = ZY + (size_t)(P0 + wid * QBLK) * D;
#pragma unroll
    for (int i = 0; i < 8; ++i) { const int id = lane + 64 * i, row = id >> 4, ch = id & 15; float a[8], z[8];
        unpack8(*(const u32x4*)(stg + row * 128 + ch * 8), a); bf16_t* p = zy + (size_t)row * D + ch * 8; unpack8(*(const u32x4*)p, z);
#pragma unroll
        for (int j = 0; j < 8; ++j) a[j] *= z[j];
        *(u32x4*)p = pack8(a); }
    __syncthreads();
#undef ROTK
#undef ROTV
#undef DMA_TILE
#undef END_M
#undef END_V
#undef RESC
}

struct MixRegs { u32x4 vq[4]; f32x2 mrq[4]; u32x4 uq[4], zq[4]; };
__device__ __forceinline__ void mixer_issue(unsigned char* ws, int chunk, int g, const int tid, MixRegs& R) {
    const int wid = __builtin_amdgcn_readfirstlane(tid >> 6), lane = tid & 63; const int rb = wid & 3, dh = wid >> 2;
    const bf16_t* Vg = (const bf16_t*)(ws + WS_VG); const f32x2* VMR = (const f32x2*)(ws + WS_VMR); const bf16_t* Ug = (const bf16_t*)(ws + WS_UG); const bf16_t* Za = (const bf16_t*)(ws + WS_ZA);
    const int sr = tid >> 4, sc = (tid & 15) * 8; const int row0 = chunk * 128, col0 = g * 128;
#pragma unroll
    for (int q = 0; q < 4; ++q) { const int s = q * 32 + sr; R.vq[q] = *(const u32x4*)(Vg + (size_t)(row0 + s) * D + col0 + sc); R.mrq[q] = VMR[row0 + s]; }
#pragma unroll
    for (int i = 0; i < 4; ++i) { const int id = lane + 64 * i, tr = id >> 3, ch = id & 7, t = rb * 32 + tr; const size_t off = (size_t)(row0 + t) * D + col0 + dh * 64 + ch * 8;
        R.uq[i] = *(const u32x4*)(Ug + off); R.zq[i] = *(const u32x4*)(Za + off); }
}
struct MixInv { float bsq[4], lg[8], lb[8]; bf16x8 wa[2][4]; };
__device__ __forceinline__ void mixer_inv(unsigned char* ws, const float* ln_g, const float* ln_b, const float* b_s, int g, const int tid, MixInv& I) {
    const int wid = __builtin_amdgcn_readfirstlane(tid >> 6), lane = tid & 63, r32 = lane & 31, hi = lane >> 5; const int rb = wid & 3;
    const int sc = (tid & 15) * 8, col0 = g * 128;
#pragma unroll
    for (int i = 0; i < 4; ++i) { const int id = lane + 64 * i, tr = id >> 3; I.bsq[i] = b_s[g * 128 + rb * 32 + tr]; }
#pragma unroll
    for (int j = 0; j < 8; ++j) { I.lg[j] = ln_g[col0 + sc + j]; I.lb[j] = ln_b[col0 + sc + j]; }
    const bf16_t* Wm = (const bf16_t*)(ws + WS_WSM) + ((size_t)g * 128 + rb * 32 + r32) * 128;
#pragma unroll
    for (int kt = 0; kt < 2; ++kt)
#pragma unroll
        for (int ks = 0; ks < 4; ++ks) I.wa[kt][ks] = *(const bf16x8*)(Wm + kt * 64 + ks * 16 + hi * 8);
}
__device__ __forceinline__ void mixer_block(unsigned char* ws, int chunk, int g, char* lds, const int tid, const MixRegs& R, const MixInv& I) {
    const int wid = __builtin_amdgcn_readfirstlane(tid >> 6), lane = tid & 63, r32 = lane & 31, hi = lane >> 5;
    const int rb = wid & 3, dh = wid >> 2;
    const int sr = tid >> 4, sc = (tid & 15) * 8; const int row0 = chunk * 128, col0 = g * 128;
    bf16_t* Ug = (bf16_t*)(ws + WS_UG);
#pragma unroll
    for (int q = 0; q < 4; ++q) { const f32x2 mr = R.mrq[q]; float v[8];
        unpack8(R.vq[q], v);
#pragma unroll
        for (int j = 0; j < 8; ++j) v[j] = (v[j] - mr.x) * mr.y * I.lg[j] + I.lb[j];
        *(u32x4*)(lds + (q >> 1) * SHM_V + v_st((q & 1) * 32 + sr, sc)) = pack8(v); }
    __syncthreads();
    const int vb0 = (int)(uintptr_t)lds + v_rd_base(lane);
    f32x16 o0 = {}, o1 = {};
    if (dh == 0) {
        { bf16x8 pa0 = I.wa[0][0], pa1 = I.wa[0][1], pa2 = I.wa[0][2], pa3 = I.wa[0][3]; PV_D0(o0, 0, 0); PV_D0(o1, 0, 1); }
        if (rb >= 2) { bf16x8 pa0 = I.wa[1][0], pa1 = I.wa[1][1], pa2 = I.wa[1][2], pa3 = I.wa[1][3]; PV_D0(o0, SHM_V, 0); PV_D0(o1, SHM_V, 1); }
    } else {
        { bf16x8 pa0 = I.wa[0][0], pa1 = I.wa[0][1], pa2 = I.wa[0][2], pa3 = I.wa[0][3]; PV_D0(o0, 0, 2); PV_D0(o1, 0, 3); }
        if (rb >= 2) { bf16x8 pa0 = I.wa[1][0], pa1 = I.wa[1][1], pa2 = I.wa[1][2], pa3 = I.wa[1][3]; PV_D0(o0, SHM_V, 2); PV_D0(o1, SHM_V, 3); }
    }
    float* stg = (float*)(lds + 2 * SHM_V) + wid * 2048;
#pragma unroll
    for (int r = 0; r < 16; ++r) { const int tr = crow(r, hi); stg[tr * 64 + r32] = o0[r]; stg[tr * 64 + 32 + r32] = o1[r]; }
    asm volatile("s_waitcnt lgkmcnt(0)" ::: "memory");
#pragma unroll
    for (int i = 0; i < 4; ++i) { const int id = lane + 64 * i, tr = id >> 3, ch = id & 7, t = rb * 32 + tr; const float bs = I.bsq[i];
        const size_t off = (size_t)(row0 + t) * D + col0 + dh * 64 + ch * 8;
        const f32x4 s0 = *(const f32x4*)(stg + tr * 64 + ch * 8), s1 = *(const f32x4*)(stg + tr * 64 + ch * 8 + 4);
        float u[8], z[8], y[8]; unpack8(R.uq[i], u); unpack8(R.zq[i], z);
#pragma unroll
        for (int j = 0; j < 4; ++j) { y[j] = u[j] * (s0[j] + bs) * z[j]; y[4 + j] = u[4 + j] * (s1[j] + bs) * z[4 + j]; }
        *(u32x4*)(Ug + off) = pack8(y); }
    __syncthreads();
}
#undef SBAR
}


#define XB_TMO      128
#define XB_XCNT(j)  (256  + 64 * (j))
#define XB_XSUB(j)  (1280 + 64 * (j))
#define XB_XGEN(j)  (2304 + 64 * (j))
#define XB_TOP      3328
#define XB_TOPGEN   3392
#define XCD_BAR_WORDS 3456
#define XB_SPIN_CAP (1u << 22)
__device__ __forceinline__ unsigned xb_ld(unsigned* p)              { return __hip_atomic_load(p, __ATOMIC_RELAXED, __HIP_MEMORY_SCOPE_AGENT); }
__device__ __forceinline__ unsigned xb_add(unsigned* p, unsigned v) { return __hip_atomic_fetch_add(p, v, __ATOMIC_RELAXED, __HIP_MEMORY_SCOPE_AGENT); }
__device__ __forceinline__ unsigned xb_xcc_id() { return (unsigned)__builtin_amdgcn_s_getreg((3 << 11) | 20) & 0xFu; }
#define XB_SPIN(cond, bar) do { unsigned _sp = 0; while (cond) { __builtin_amdgcn_s_sleep(1); \
    if ((++_sp & 255u) == 0u) { if (xb_ld(&(bar)[XB_TMO])) break; if (_sp > XB_SPIN_CAP) { atomicAdd(&(bar)[XB_TMO], 1u); break; } } } } while (0)
__device__ __forceinline__ void xcd_barrier_complete(unsigned* bar, unsigned x, unsigned& nloc, unsigned& nx) {
    const unsigned G = gridDim.x;
    unsigned sum, cnt, mine, sp = 0u;
    for (;;) {
        sum = 0u; cnt = 0u; mine = 0u;
#pragma unroll
        for (unsigned j = 0; j < 16; ++j) { const unsigned c = xb_ld(&bar[XB_XCNT(j)]); sum += c; cnt += (c > 0u) ? 1u : 0u; mine = (j == x) ? c : mine; }
        if (sum == G) break;
        __builtin_amdgcn_s_sleep(1);
        if ((++sp & 255u) == 0u) { if (xb_ld(&bar[XB_TMO])) break; if (sp > XB_SPIN_CAP) { atomicAdd(&bar[XB_TMO], 1u); break; } }
    }
    nloc = mine > 0u ? mine : 1u; nx = cnt > 0u ? cnt : 1u;
}
__device__ __forceinline__ void xcd_barrier(unsigned* bar, volatile LAS unsigned* st, const int tid) {
    asm volatile("s_waitcnt vmcnt(0)" ::: "memory");
    __syncthreads();
    if (tid == 0) {
        const unsigned x = xb_xcc_id();
        __builtin_amdgcn_s_waitcnt(0);
        unsigned nloc = st[0], nx = st[1];
        if (nloc == 0u) { xcd_barrier_complete(bar, x, nloc, nx); st[0] = nloc; st[1] = nx; }
        const unsigned old = xb_add(&bar[XB_XSUB(x)], 1u);
        const unsigned gen = old / nloc;
        if (old + 1u == (gen + 1u) * nloc) {
            __builtin_amdgcn_fence(__ATOMIC_RELEASE, "agent");
            asm volatile("s_waitcnt vmcnt(0)" ::: "memory");
            const unsigned og = xb_add(&bar[XB_TOP], 1u);
            const unsigned tg = og / nx;
            if (og + 1u == (tg + 1u) * nx) xb_add(&bar[XB_TOPGEN], 1u);
            else XB_SPIN(xb_ld(&bar[XB_TOPGEN]) == tg, bar);
            __builtin_amdgcn_fence(__ATOMIC_ACQUIRE, "agent");
            xb_add(&bar[XB_XGEN(x)], 1u);
            asm volatile("s_waitcnt vmcnt(0)" ::: "memory");
        } else {
            XB_SPIN(xb_ld(&bar[XB_XGEN(x)]) == gen, bar);
            __builtin_amdgcn_fence(__ATOMIC_ACQUIRE, "agent");
            asm volatile("s_waitcnt vmcnt(0)" ::: "memory");
        }
    }
    __syncthreads();
}

typedef const __attribute__((address_space(4))) Ptrs* KargPtr;
#define PHASE_ENV() KargPtr kp_ = (KargPtr)__builtin_amdgcn_kernarg_segment_ptr(); asm volatile("" : "+s"(kp_)); \
    const int wave = wave0_; int lane = (int)__builtin_amdgcn_mbcnt_hi(~0u, __builtin_amdgcn_mbcnt_lo(~0u, 0u)); asm volatile("" : "+v"(lane)); const int tid = wave * 64 + lane; \
    int G = gridDim.x, c = blockIdx.x; asm volatile("" : "+s"(G), "+s"(c)); const int vcu = (G % 8 == 0) ? (c % 8) * (G / 8) + c / 8 : c; \
    unsigned char* ws = kp_->ws; unsigned char* dout = (unsigned char*)kp_->out; (void)lane; (void)wave; (void)vcu; (void)ws; (void)dout
__global__ void __launch_bounds__(NTHREADS, 2) hybrid_fwd(Ptrs Punused) {
    extern __shared__ __attribute__((aligned(16))) unsigned char lds_raw[];
    LAS unsigned char* lds = (LAS unsigned char*)lds_raw;
    const int wave0_ = __builtin_amdgcn_readfirstlane((int)threadIdx.x >> 6);
    int lo, hi; { KargPtr k0 = (KargPtr)__builtin_amdgcn_kernarg_segment_ptr(); lo = k0->ph_lo; hi = k0->ph_hi; }
#define IN(k) (lo <= (k) && (k) < hi)
#if MK_SINGLE
    volatile LAS unsigned* bst_ = (volatile LAS unsigned*)(lds + BARST_OFF);
    { if ((int)threadIdx.x == 0) { bst_[0] = 0u; bst_[1] = 0u; KargPtr k0 = (KargPtr)__builtin_amdgcn_kernarg_segment_ptr(); (void)xb_add(&((unsigned*)k0->ws)[XB_XCNT(xb_xcc_id())], 1u); } __syncthreads(); }
#define SEAM(k) do { if (IN(k) && IN((k) + 1)) { PHASE_ENV(); if ((k) == 0 && kp_->use_cg) cg::this_grid().sync(); else xcd_barrier((unsigned*)ws, bst_, tid); } } while (0)
#else
#define SEAM(k) do { } while (0)
#endif
    if (IN(0)) { PHASE_ENV(); Ptrs P; { const __attribute__((address_space(4))) unsigned long long* s_ = (const __attribute__((address_space(4))) unsigned long long*)kp_; unsigned long long* d_ = (unsigned long long*)&P; _Pragma("unroll") for (int i_ = 0; i_ < (int)(sizeof(Ptrs) / 8); ++i_) d_[i_] = s_[i_]; } phase0(P, lds, vcu, G, tid, lane, wave); }
    SEAM(0);
    if (IN(1)) {
        { PHASE_ENV(); const int nfull = (32 * NT_IN + 16) % G;
          if (nfull == 0 || c >= nfull) { Ptrs P; { const __attribute__((address_space(4))) unsigned long long* s_ = (const __attribute__((address_space(4))) unsigned long long*)kp_; unsigned long long* d_ = (unsigned long long*)&P; _Pragma("unroll") for (int i_ = 0; i_ < (int)(sizeof(Ptrs) / 8); ++i_) d_[i_] = s_[i_]; }
              phase_wconv2(P, lds, 0, c - nfull, G - nfull, lane, wave);
              asm volatile("s_waitcnt vmcnt(0)" ::: "memory"); __syncthreads();
              if (tid == 0) { __builtin_amdgcn_fence(__ATOMIC_RELEASE, "agent"); asm volatile("s_waitcnt vmcnt(0)" ::: "memory"); (void)__hip_atomic_fetch_add((unsigned*)ws + XB_WMEM, 1u, __ATOMIC_RELAXED, __HIP_MEMORY_SCOPE_AGENT); } } }
        { PHASE_ENV(); const int nfull = (32 * NT_IN + 16) % G; SchedP1 Sc{ws, G, c, nfull == 0 ? G : G - nfull}; EpiP1 E{ws, dout, kp_->in[16]}; pg8::gemm_phase<2048>(lds, Sc, E, tid); } }
    SEAM(1);
    if (IN(2)) { PHASE_ENV();
        { const f32x2* st = (const f32x2*)(ws + WS_VST); f32x2* mr = (f32x2*)(ws + WS_VMR);
          for (int row = c * 32 + (tid >> 4); row < S; row += G * 32) { const int sub = tid & 15;
              const f32x2 p0 = st[(size_t)sub * S + row], p1 = st[(size_t)(sub + 16) * S + row]; float s1 = p0.x + p1.x, s2 = p0.y + p1.y;
#pragma unroll
              for (int o = 1; o < 16; o <<= 1) { s1 += __shfl_xor(s1, o); s2 += __shfl_xor(s2, o); }
              const float mean = s1 * (1.f / D); const float var = fmaxf(s2 * (1.f / D) - mean * mean, 0.f); if (sub == 0) mr[row] = (f32x2){mean, 1.0f / sqrtf(var + EPS)}; } }
        SchedP2 Sc{ws, G, c}; EpiP2 E{ws, (LAS float*)(lds + XCH_OFF)}; pg8::gemm_phase<512>(lds, Sc, E, tid);
    }
    SEAM(2);
    if (IN(3)) {
        { PHASE_ENV();
          if (c < 224) { const int v2 = (c & 7) * 28 + (c >> 3), h = v2 / 14, b = v2 - h * 14;
            const bf16_t* Qh = (const bf16_t*)(ws + WS_QB) + (size_t)h * S * DQK; const bf16_t* Kh = (const bf16_t*)(ws + WS_KB) + (size_t)h * S * DQK; const bf16_t* Vh = (const bf16_t*)(ws + WS_VB) + (size_t)h * S * DV;
            bf16_t* ZY = (bf16_t*)dout + h * DV;
            const int qa = b == 0 ? 30 : b < 3 ? 29 - b : b < 10 ? 28 - b : b == 10 ? 31 : b == 11 ? 29 : b == 12 ? 26 : 18;
            const int qc = b < 10 ? 36 - qa : b == 10 ? 2 : b == 11 ? 3 : b == 12 ? 5 : 10;
            const int qd = b == 10 ? 0 : b == 11 ? 1 : b == 12 ? 4 : 7;
            att::attn_block3(Qh, Kh, Vh, ZY, qa * 256, (char*)lds_raw, tid); att::attn_block3(Qh, Kh, Vh, ZY, qc * 256, (char*)lds_raw, tid);
            if (b >= 10) att::attn_block3(Qh, Kh, Vh, ZY, qd * 256, (char*)lds_raw, tid); } }
        { PHASE_ENV(); if (c >= 224) { SchedP3b Sc{ws, 32, c - 224}; EpiMulZ E{dout}; pg8::gemm_phase<256>(lds, Sc, E, tid); } }
        { PHASE_ENV(); if (c >= 224) { const int mw = c - 224; const float* lng = kp_->in[5]; const float* lnb = kp_->in[6]; const float* bs = kp_->in[8];
            att::MixRegs ra, rb; att::MixInv inv;
            att::mixer_issue(ws, mw >> 4, mw & 15, tid, ra); att::mixer_inv(ws, lng, lnb, bs, mw & 15, tid, inv);
            for (int it = mw; it < 1024; it += 64) {
                const int it1 = it + 32, it2 = it + 64;
                if (it1 < 1024) att::mixer_issue(ws, it1 >> 4, mw & 15, tid, rb);
                att::mixer_block(ws, it >> 4, mw & 15, (char*)lds_raw, tid, ra, inv);
                if (it1 >= 1024) break;
                if (it2 < 1024) att::mixer_issue(ws, it2 >> 4, mw & 15, tid, ra);
                att::mixer_block(ws, it1 >> 4, mw & 15, (char*)lds_raw, tid, rb, inv);
            } } }
        { PHASE_ENV(); Ptrs P; { const __attribute__((address_space(4))) unsigned long long* s_ = (const __attribute__((address_space(4))) unsigned long long*)kp_; unsigned long long* d_ = (unsigned long long*)&P; _Pragma("unroll") for (int i_ = 0; i_ < (int)(sizeof(Ptrs) / 8); ++i_) d_[i_] = s_[i_]; } if (c < 224) phase_wconv2(P, lds, 1, c, 224, lane, wave); }
    }
    SEAM(3);
    if (IN(4)) { PHASE_ENV(); SchedP4 Sc{ws, dout, G, c}; EpiP4 E{ws}; pg8::gemm_phase<2048>(lds, Sc, E, tid); }
    SEAM(4);
    if (IN(5)) { PHASE_ENV(); SchedP5 Sc{ws, G, c}; EpiP5 E{ws, (float*)dout}; pg8::gemm_phase<2048>(lds, Sc, E, tid); }
    SEAM(5);
    if (IN(6)) { PHASE_ENV();
        const float* st = (const float*)(ws + WS_OST); const float* x = kp_->in[0]; const float* gp = kp_->in[19]; float* outp = (float*)dout;
        for (int row = vcu * NWAVES + wave; row < S; row += G * NWAVES) {
            float s = lane < 32 ? st[(size_t)lane * S + row] : 0.f; s = wave_sum(s);
            const float rs = 1.0f / sqrtf(s * (1.f / D) + EPS);
            const f32x4* xr = (const f32x4*)(x + (size_t)row * D); f32x4* orow = (f32x4*)(outp + (size_t)row * D); const f32x4* gr = (const f32x4*)gp; const u32x4* ob = (const u32x4*)((const bf16_t*)(ws + WS_MP) + (size_t)row * D);
#pragma unroll
            for (int j = 0; j < 4; ++j) { const int q = 64 * j + lane; float a[8]; unpack8(ob[q], a); const f32x4 x0 = xr[2 * q], x1 = xr[2 * q + 1], g0 = gr[2 * q], g1 = gr[2 * q + 1];
                orow[2 * q] = x0 + (f32x4){a[0], a[1], a[2], a[3]} * rs * g0; orow[2 * q + 1] = x1 + (f32x4){a[4], a[5], a[6], a[7]} * rs * g1; }
        }
    }
#undef IN
#undef SEAM
}

extern "C" void kernel_launch(void* const* d_in, const int* in_sizes, int n_in, void* d_out, int out_size, void* d_ws, size_t ws_size, hipStream_t stream) {
    static int grid = 0;
    if (grid == 0) {
        if (n_in != 20 || out_size != S * D || ws_size < WS_END) { fprintf(stderr, "kernel_launch: unexpected shapes (n_in %d out %d ws %zu)\n", n_in, out_size, ws_size); grid = -1; return; }
        int dev = 0, cus = 0, per_cu = 0;
        (void)hipGetDevice(&dev); (void)hipDeviceGetAttribute(&cus, hipDeviceAttributeMultiprocessorCount, dev);
        (void)hipFuncSetAttribute((const void*)hybrid_fwd, hipFuncAttributeMaxDynamicSharedMemorySize, LDS_BYTES);
        (void)hipOccupancyMaxActiveBlocksPerMultiprocessor(&per_cu, (const void*)hybrid_fwd, NTHREADS, LDS_BYTES);
        if (per_cu < 1) { fprintf(stderr, "kernel_launch: occupancy query reports %d blocks per CU\n", per_cu); }
        grid = cus;
        (void)hipGetLastError();
    }
    if (grid < 0) return;
    Ptrs p{};
    for (int i = 0; i < 20; ++i) p.in[i] = (const float*)d_in[i];
    p.out = (float*)d_out; p.ws = (unsigned char*)d_ws;
#if MK_SINGLE
    (void)hipMemsetAsync(d_ws, 0, CTL_ZERO_BYTES, stream);
    p.ph_lo = 0; p.ph_hi = 7;
    void* args[] = {&p};
    hipError_t e = hipLaunchCooperativeKernel((const void*)hybrid_fwd, dim3(grid), dim3(NTHREADS), args, LDS_BYTES, stream);
    if (e != hipSuccess) fprintf(stderr, "cooperative launch failed: %s (grid %d)\n", hipGetErrorString(e), grid);
#else
    for (int k = 0; k < 7; ++k) { p.ph_lo = k; p.ph_hi = k + 1; hipLaunchKernelGGL(hybrid_fwd, dim3(grid), dim3(NTHREADS), LDS_BYTES, stream, p); }
#endif
}
```

```cpp
#include <hip/hip_runtime.h>
#include <hip/hip_cooperative_groups.h>
#include <cstdio>
#include <cstdint>
namespace cg = cooperative_groups;

#ifndef MK_SINGLE
#define MK_SINGLE 1
#endif

#define LAS __attribute__((address_space(3)))
typedef unsigned short bf16_t;
typedef short bf16x8 __attribute__((ext_vector_type(8)));
typedef short s16x4 __attribute__((ext_vector_type(4)));
typedef float f32x4 __attribute__((ext_vector_type(4)));
typedef float f32x2 __attribute__((ext_vector_type(2)));
typedef float f32x16 __attribute__((ext_vector_type(16)));
typedef unsigned u32x4 __attribute__((ext_vector_type(4)));
typedef unsigned u32x2 __attribute__((ext_vector_type(2)));

constexpr int S = 8192, D = 2048, ML = 256, NH = 16, DQK = 192, DV = 128;
constexpr int IN_TOTAL = 13376, NT_IN = 77;
constexpr float EPS = 1e-6f, LOG2E = 1.4426950408889634f;
constexpr float QSCALE = 0.07216878364870322f * 1.4426950408889634f;
constexpr float MSCALE = 0.04419417382415922f * 1.4426950408889634f;
constexpr int NTHREADS = 512, NWAVES = 8;
constexpr int RING_BYTES = 131072, XCH_OFF = RING_BYTES, BARST_OFF = XCH_OFF + 8192, LDS_BYTES = 147456;
#define WC2_MEM_TILES 4096
#define GATE_P0_COLS 0
#define XB_WMEM 3520
constexpr size_t CTL_ZERO_BYTES = 16384;

constexpr size_t MiB = 1u << 20;
constexpr size_t WS_CS = 1 * MiB;
constexpr size_t WS_VST = 3 * MiB;
constexpr size_t WS_CQST = 5 * MiB;
constexpr size_t WS_CKVST = 5 * MiB + 256 * 1024;
constexpr size_t WS_VMR = 5 * MiB + 512 * 1024;
constexpr size_t WS_OST = 6 * MiB;
constexpr size_t WS_WSM = 7 * MiB;
constexpr size_t WS_KR = 8 * MiB;
constexpr size_t WS_KMH = 9 * MiB;
constexpr size_t WS_VMT = 10 * MiB;
constexpr size_t WS_WUQ = 11 * MiB;
constexpr size_t WS_WUKV = 14 * MiB;
constexpr size_t WS_WIN = 288 * MiB;
constexpr size_t WS_WMEM = 114 * MiB;
constexpr size_t WS_H = 384 * MiB;
constexpr size_t WS_MEMN = 143 * MiB;
constexpr size_t WS_UG = 144 * MiB;
constexpr size_t WS_VG = 176 * MiB;
constexpr size_t WS_ZA = 208 * MiB;
constexpr size_t WS_CQ = 240 * MiB;
constexpr size_t WS_CKV = 248 * MiB;
constexpr size_t WS_QMH = 256 * MiB;
constexpr size_t WS_G = 18 * MiB;
constexpr size_t WS_VB = 384 * MiB;
constexpr size_t WS_QB = 288 * MiB;
constexpr size_t WS_KB = 336 * MiB;
constexpr size_t WS_P = 114 * MiB;
constexpr size_t WS_WBR = 240 * MiB;
constexpr size_t WS_WOUT = 264 * MiB;
constexpr size_t WS_MP = 18 * MiB;
constexpr size_t WS_MERGED = 336 * MiB;
constexpr size_t WS_END = 416 * MiB;

typedef __bf16 bf16x2_t __attribute__((ext_vector_type(2)));
__device__ __forceinline__ unsigned cvt_pk_bf16(float lo, float hi) { const f32x2 v = {lo, hi}; const bf16x2_t b = __builtin_convertvector(v, bf16x2_t); return __builtin_bit_cast(unsigned, b); }
__device__ __forceinline__ float bf_lo(unsigned w) { return __uint_as_float(w << 16); }
__device__ __forceinline__ float bf_hi(unsigned w) { return __uint_as_float(w & 0xffff0000u); }
__device__ __forceinline__ u32x4 pack8(const float* v) { u32x4 w; w.x = cvt_pk_bf16(v[0], v[1]); w.y = cvt_pk_bf16(v[2], v[3]); w.z = cvt_pk_bf16(v[4], v[5]); w.w = cvt_pk_bf16(v[6], v[7]); return w; }
__device__ __forceinline__ void unpack8(u32x4 w, float* v) { v[0] = bf_lo(w.x); v[1] = bf_hi(w.x); v[2] = bf_lo(w.y); v[3] = bf_hi(w.y); v[4] = bf_lo(w.z); v[5] = bf_hi(w.z); v[6] = bf_lo(w.w); v[7] = bf_hi(w.w); }
__device__ __forceinline__ float fast_rcp(float x) { return __builtin_amdgcn_rcpf(x); }
__device__ __forceinline__ float fast_exp2(float x) { return __builtin_amdgcn_exp2f(x); }
__device__ __forceinline__ float act_gelu(float x) { const float t = x * __builtin_fmaf(x * x, -0.10294324f, -2.3022081983f); return x * fast_rcp(1.f + fast_exp2(t)); }
__device__ __forceinline__ float act_silu(float x) { return x * fast_rcp(1.f + fast_exp2(-LOG2E * x)); }
constexpr float GATE_MIN = 9.094947e-13f;
__device__ __forceinline__ float act_sigmoid(float x) { return fast_rcp(1.f + fast_exp2(-LOG2E * x)); }
__device__ __forceinline__ float wave_sum(float v) {
#pragma unroll
    for (int o = 1; o < 64; o <<= 1) v += __shfl_xor(v, o);
    return v;
}

namespace pg8 {
constexpr int BM = 256, BK = 64, HALF = 128, HTB = HALF * BK * 2, STAGE_BYTES = 8 * HTB;
__host__ __device__ __forceinline__ int lds_byte(int r, int c) { const int st = (r >> 4) * 2 + (c >> 5), rr = r & 15, cc = c & 31, ob = rr * 64 + cc * 2; return st * 1024 + (ob ^ (((ob >> 9) & 1) << 5)); }
__host__ __device__ __forceinline__ void stage_rc(int b, int& R, int& C) { const int st = b / 1024, sb = b % 1024, swz = sb ^ (((sb >> 9) & 1) << 5); R = (st >> 1) * 16 + swz / 64; C = (st & 1) * 32 + (swz % 64) / 2; }
__host__ __device__ __forceinline__ int perm32(int rho) { const int n = rho >> 4, i = rho & 15; return 8 * (i >> 2) + 4 * n + (i & 3); }

struct Unit { const char* A; const char* B; int pm, pn, mode; };

template <int K, class Sched, class Epi>
__device__ __forceinline__ void gemm_phase(LAS unsigned char* lds, const Sched& S, const Epi& E, const int tid) {
    const int wid = __builtin_amdgcn_readfirstlane(tid >> 6), lane = tid & 63, wr = wid >> 2, wc = wid & 3, fr = lane & 15, fq = lane >> 4;
    constexpr int nt = K / BK;
    unsigned voffA[2], voffB[2];
#pragma unroll
    for (int i = 0; i < 2; ++i) { int R, C; stage_rc(tid * 16 + i * 8192, R, C); const int Rb = (R & ~31) + perm32(R & 31);
        voffA[i] = (unsigned)(R * K + C) * 2u; voffB[i] = (unsigned)(Rb * K + C) * 2u; }
    constexpr size_t kstep = (size_t)(BK * 2);
    constexpr size_t hstep = (size_t)HALF * K * 2;
    const unsigned ldsw = (unsigned)wid * 1024u;
    const int aoff = lds_byte(wr * 64 + fr, fq * 8), boff = lds_byte(wc * 32 + fr, fq * 8);
#define PG8_SA(b, h) (((b) * 2 + (h)) * HTB)
#define PG8_SB(b, h) ((4 + (b) * 2 + (h)) * HTB)
#define PG8_STAGE(bufoff, gbase, voff) do { _Pragma("unroll") for (int _i = 0; _i < 2; ++_i) \
        __builtin_amdgcn_global_load_lds((const unsigned*)((const char*)(gbase) + (voff)[_i]), (LAS unsigned*)(lds + (bufoff) + ldsw + _i * 8192), 16, 0, 0); } while (0)
#define PG8_LDA(dst, b, h) do { _Pragma("unroll") for (int m = 0; m < 4; ++m) _Pragma("unroll") for (int k = 0; k < 2; ++k) dst[m][k] = *(const LAS bf16x8*)(lds + PG8_SA(b, h) + aoff + m * 2048 + k * 1024); } while (0)
#define PG8_LDB(dst, b, h) do { _Pragma("unroll") for (int n = 0; n < 2; ++n) _Pragma("unroll") for (int k = 0; k < 2; ++k) dst[n][k] = *(const LAS bf16x8*)(lds + PG8_SB(b, h) + boff + n * 2048 + k * 1024); } while (0)
#define PG8_MMA(ai, bj, At, Bt) do { __builtin_amdgcn_s_setprio(1); _Pragma("unroll") for (int m = 0; m < 4; ++m) _Pragma("unroll") for (int n = 0; n < 2; ++n) _Pragma("unroll") for (int k = 0; k < 2; ++k) \
        acc[ai][bj][m][n] = __builtin_amdgcn_mfma_f32_16x16x32_bf16(Bt[n][k], At[m][k], acc[ai][bj][m][n], 0, 0, 0); __builtin_amdgcn_s_setprio(0); } while (0)
#define PG8_WAIT_V(n) asm volatile("s_waitcnt vmcnt(" #n ")" ::: "memory")
#define PG8_WAIT_L(n) asm volatile("s_waitcnt lgkmcnt(" #n ")" ::: "memory")
#define PG8_BAR __builtin_amdgcn_s_barrier()
#define PG8_SCHED __builtin_amdgcn_sched_barrier(0)
    Unit cur, nxt; int ui = 0;
    if (!S.next(0, cur)) return;
    f32x4 acc[2][2][4][2];
#pragma unroll
    for (int a = 0; a < 2; ++a)
#pragma unroll
        for (int b = 0; b < 2; ++b)
#pragma unroll
            for (int m = 0; m < 4; ++m)
#pragma unroll
                for (int n = 0; n < 2; ++n) acc[a][b][m][n] = (f32x4){0.f, 0.f, 0.f, 0.f};
    bf16x8 At[4][2], B0[2][2], B1[2][2];
    const char* cA = cur.A; const char* cB = cur.B;
#define PG8_KT(t) ((size_t)((t) & (nt - 1)) * kstep)
    PG8_STAGE(PG8_SB(0, 0), cB + PG8_KT(0), voffB); PG8_STAGE(PG8_SB(0, 1), cB + hstep + PG8_KT(0), voffB); PG8_STAGE(PG8_SA(0, 0), cA + PG8_KT(0), voffA); PG8_STAGE(PG8_SA(0, 1), cA + hstep + PG8_KT(0), voffA);
    if (wr == 1) PG8_BAR;
    PG8_WAIT_V(2); PG8_BAR;
    PG8_STAGE(PG8_SB(1, 0), cB + PG8_KT(1), voffB); PG8_STAGE(PG8_SA(1, 0), cA + PG8_KT(1), voffA); PG8_STAGE(PG8_SB(1, 1), cB + hstep + PG8_KT(1), voffB);
    PG8_WAIT_V(6); PG8_BAR;
    for (;;) {
        const bool has_next = S.next(ui + 1, nxt);
        const char* nA = has_next ? nxt.A : cA; const char* nB = has_next ? nxt.B : cB;
#pragma unroll 1
        for (int t = 0; t < nt; t += 2) {
            const bool last = (t == nt - 2);
            const char* a1 = cA + PG8_KT(t + 1);
            const char* a2 = (last ? nA : cA) + PG8_KT(t + 2); const char* b2 = (last ? nB : cB) + PG8_KT(t + 2);
            const char* a3 = (last ? nA : cA) + PG8_KT(t + 3); const char* b3 = (last ? nB : cB) + PG8_KT(t + 3);
            PG8_LDB(B0, 0, 0); PG8_LDB(B1, 0, 1); PG8_SCHED; PG8_LDA(At, 0, 0); PG8_STAGE(PG8_SA(1, 1), a1 + hstep, voffA);
            PG8_WAIT_V(8); PG8_WAIT_L(0); PG8_BAR; PG8_MMA(0, 0, At, B0); PG8_MMA(0, 1, At, B1); PG8_BAR; PG8_SCHED;
            PG8_LDA(At, 0, 1); PG8_STAGE(PG8_SB(0, 0), b2, voffB); PG8_STAGE(PG8_SB(0, 1), b2 + hstep, voffB); PG8_STAGE(PG8_SA(0, 0), a2, voffA);
            PG8_WAIT_V(8); PG8_WAIT_L(0); PG8_BAR; PG8_MMA(1, 0, At, B0); PG8_MMA(1, 1, At, B1); PG8_BAR; PG8_SCHED;
            PG8_LDB(B0, 1, 0); PG8_LDB(B1, 1, 1); PG8_SCHED; PG8_LDA(At, 1, 0); PG8_STAGE(PG8_SA(0, 1), a2 + hstep, voffA);
            PG8_WAIT_V(8); PG8_WAIT_L(0); PG8_BAR; PG8_MMA(0, 0, At, B0); PG8_MMA(0, 1, At, B1); PG8_BAR; PG8_SCHED;
            PG8_LDA(At, 1, 1); PG8_STAGE(PG8_SB(1, 0), b3, voffB); PG8_STAGE(PG8_SB(1, 1), b3 + hstep, voffB); PG8_STAGE(PG8_SA(1, 0), a3, voffA);
            PG8_WAIT_V(8); PG8_WAIT_L(0); PG8_BAR; PG8_MMA(1, 0, At, B0); PG8_MMA(1, 1, At, B1); PG8_BAR; PG8_SCHED;
        }
        if (wr == 0) PG8_BAR;
        E(acc, cur, wr, wc, fr, fq);
        if (!has_next) break;
        if (!E.keep_acc(cur)) {
#pragma unroll
        for (int a = 0; a < 2; ++a)
#pragma unroll
            for (int b = 0; b < 2; ++b)
#pragma unroll
                for (int m = 0; m < 4; ++m)
#pragma unroll
                    for (int n = 0; n < 2; ++n) acc[a][b][m][n] = (f32x4){0.f, 0.f, 0.f, 0.f};
        }
        cur = nxt; cA = nA; cB = nB; ++ui;
        if (wr == 1) PG8_BAR;
    }
    PG8_WAIT_V(0);
    PG8_BAR;
#undef PG8_KT
#undef PG8_SA
#undef PG8_SB
#undef PG8_STAGE
#undef PG8_LDA
#undef PG8_LDB
#undef PG8_MMA
#undef PG8_WAIT_V
#undef PG8_WAIT_L
#undef PG8_BAR
#undef PG8_SCHED
}
}
using pg8::Unit;

#define EPI_LOOP_BEGIN \
    _Pragma("unroll") for (int ai = 0; ai < 2; ++ai) _Pragma("unroll") for (int m = 0; m < 4; ++m) { const int rt = ai * 128 + wr * 64 + m * 16 + fr; \
    _Pragma("unroll") for (int bj = 0; bj < 2; ++bj) { const int ct = bj * 128 + wc * 32 + 8 * fq; \
        float v[8] = {acc[ai][bj][m][0][0], acc[ai][bj][m][0][1], acc[ai][bj][m][0][2], acc[ai][bj][m][0][3], acc[ai][bj][m][1][0], acc[ai][bj][m][1][1], acc[ai][bj][m][1][2], acc[ai][bj][m][1][3]};
#define EPI_LOOP_END } }

enum { M_GELU = 0, M_GELU_STAT, M_SILU, M_RAW_SS, M_KROPE, M_QM, M_GATE, M_MEMK, M_MEMV,
       M_QUP, M_KVUP, M_MEMS,
       M_MULZ, M_BR0, M_BR1, M_BR2, M_OUT };

struct Ptrs {
    const float* in[20]; float* out; unsigned char* ws; int ph_lo, ph_hi; int use_cg, pad;
};

struct EpiP1 {
    __device__ __forceinline__ bool keep_acc(const Unit&) const { return false; }
    unsigned char* ws; unsigned char* dout; const float* bgate;
    __device__ __forceinline__ void operator()(f32x4 (&acc)[2][2][4][2], const Unit& u, int wr, int wc, int fr, int fq) const {
        const int mode = u.mode, pn = u.pn, row0 = u.pm * 256;
        if (mode == M_KROPE) {
            if (wc < 2) {
                const f32x2* CS = (const f32x2*)(ws + WS_CS); bf16_t* KR = (bf16_t*)(ws + WS_KR); const int i0 = (wc * 32 + 8 * fq) >> 1;
#pragma unroll
                for (int ai = 0; ai < 2; ++ai) { f32x2 cs[4][4];
#pragma unroll
                    for (int m = 0; m < 4; ++m) { const int row = row0 + ai * 128 + wr * 64 + m * 16 + fr;
#pragma unroll
                        for (int j = 0; j < 4; ++j) cs[m][j] = CS[row * 32 + i0 + j]; }
#pragma unroll
                    for (int m = 0; m < 4; ++m) { const int row = row0 + ai * 128 + wr * 64 + m * 16 + fr;
                        const f32x4 a = acc[ai][0][m][0], b = acc[ai][0][m][1]; const float t1[4] = {a[0], a[2], b[0], b[2]}, t2[4] = {a[1], a[3], b[1], b[3]};
                        float o1[4], o2[4];
#pragma unroll
                        for (int j = 0; j < 4; ++j) { const f32x2 c2 = cs[m][j]; o1[j] = t1[j] * c2.x - t2[j] * c2.y; o2[j] = t2[j] * c2.x + t1[j] * c2.y; }
                        u32x2 w1, w2; w1.x = cvt_pk_bf16(o1[0], o1[1]); w1.y = cvt_pk_bf16(o1[2], o1[3]); w2.x = cvt_pk_bf16(o2[0], o2[1]); w2.y = cvt_pk_bf16(o2[2], o2[3]);
                        *(u32x2*)(KR + (size_t)row * 64 + i0) = w1; *(u32x2*)(KR + (size_t)row * 64 + 32 + i0) = w2; } }
            }
            return;
        }
        bf16_t* dst; int ldc, cbase = 0; int act = 0;
        float scale = 1.f; int stat = 0; float* stp = nullptr; const float* bias = nullptr;
        if (mode == M_GELU)           { dst = (bf16_t*)(ws + WS_UG); ldc = D; cbase = pn * 256; act = 1; }
        else if (mode == M_GELU_STAT) { dst = (bf16_t*)(ws + WS_VG); ldc = D; cbase = (pn - 8) * 256; act = 1; stat = 2; stp = (float*)(ws + WS_VST) + (size_t)((pn - 8) * 4 + wc) * S * 2; }
        else if (mode == M_SILU)      { act = 2; ldc = D; if (pn < 24) { dst = (bf16_t*)(ws + WS_ZA); cbase = (pn - 16) * 256; } else if (pn < 37) { dst = (bf16_t*)dout; cbase = (pn - 29) * 256; } else { dst = (bf16_t*)dout + (size_t)S * D; cbase = (pn - 45) * 256; } }
        else if (mode == M_RAW_SS)    { ldc = 512; stat = 1; if (pn < 26) { dst = (bf16_t*)(ws + WS_CQ); cbase = (pn - 24) * 256; stp = (float*)(ws + WS_CQST) + (size_t)((pn - 24) * 4 + wc) * S; }
                                        else { dst = (bf16_t*)(ws + WS_CKV); cbase = (pn - 26) * 256; stp = (float*)(ws + WS_CKVST) + (size_t)((pn - 26) * 4 + wc) * S; } }
        else if (mode == M_QM)        { const int t = pn - 37; dst = (bf16_t*)(ws + WS_QMH) + (size_t)(t >> 1) * S * 512; ldc = 512; cbase = (t & 1) * 256; scale = MSCALE; }
        else if (mode == M_GATE)      { dst = (bf16_t*)(ws + WS_G); ldc = 3 * D; cbase = (pn - 53) * 256; act = 3; bias = bgate + cbase; }
        else if (mode == M_MEMK)      { dst = (bf16_t*)(ws + WS_KMH) + (size_t)(pn >> 1) * ML * 512; ldc = 512; cbase = (pn & 1) * 256; }
        else                          { dst = (bf16_t*)(ws + WS_VMT); ldc = ML; cbase = 0; }
        if (act == 1 && stat == 0)      body<1, 0>(acc, dst, ldc, cbase, row0, scale, stp, bias, wr, wc, fr, fq);
        else if (act == 1)              body<1, 2>(acc, dst, ldc, cbase, row0, scale, stp, bias, wr, wc, fr, fq);
        else if (act == 2)              body<2, 0>(acc, dst, ldc, cbase, row0, scale, stp, bias, wr, wc, fr, fq);
        else if (act == 3)              body<3, 0>(acc, dst, ldc, cbase, row0, scale, stp, bias, wr, wc, fr, fq);
        else if (stat == 1)             body<0, 1>(acc, dst, ldc, cbase, row0, scale, stp, bias, wr, wc, fr, fq);
        else                            body<0, 0>(acc, dst, ldc, cbase, row0, scale, stp, bias, wr, wc, fr, fq);
    }
    template <int ACT, int STAT>
    __device__ __forceinline__ void body(f32x4 (&acc)[2][2][4][2], bf16_t* dst, int ldc, int cbase, int row0, float scale, float* stp, const float* bias, int wr, int wc, int fr, int fq) const {
        bf16_t* const p0 = dst + (size_t)(row0 + wr * 64 + fr) * ldc + cbase + wc * 32 + 8 * fq;
        f32x4 bb[2][2] = {};
        if (ACT == 3) {
#pragma unroll
            for (int bj = 0; bj < 2; ++bj) { const int ct = bj * 128 + wc * 32 + 8 * fq; bb[bj][0] = *(const f32x4*)(bias + ct); bb[bj][1] = *(const f32x4*)(bias + ct + 4); } }
#pragma unroll
        for (int ai = 0; ai < 2; ++ai)
#pragma unroll
            for (int m = 0; m < 4; ++m) { const int rt = ai * 128 + wr * 64 + m * 16 + fr; float s1 = 0.f, s2 = 0.f;
                bf16_t* const prow = p0 + (size_t)((ai * 128 + m * 16) * ldc);
#pragma unroll
                for (int bj = 0; bj < 2; ++bj) {
                    float v[8] = {acc[ai][bj][m][0][0], acc[ai][bj][m][0][1], acc[ai][bj][m][0][2], acc[ai][bj][m][0][3], acc[ai][bj][m][1][0], acc[ai][bj][m][1][1], acc[ai][bj][m][1][2], acc[ai][bj][m][1][3]};
                    if (ACT == 1) {
#pragma unroll
                        for (int j = 0; j < 8; ++j) v[j] = act_gelu(v[j]);
                    } else if (ACT == 2) {
#pragma unroll
                        for (int j = 0; j < 8; ++j) v[j] = act_silu(v[j]);
                    } else if (ACT == 3) { const f32x4 b0 = bb[bj][0], b1 = bb[bj][1];
#pragma unroll
                        for (int j = 0; j < 4; ++j) { v[j] = fmaxf(act_sigmoid(v[j] + b0[j]), GATE_MIN); v[4 + j] = fmaxf(act_sigmoid(v[4 + j] + b1[j]), GATE_MIN); }
                    } else {
#pragma unroll
                        for (int j = 0; j < 8; ++j) v[j] *= scale;
                    }
                    if (STAT) {
#pragma unroll
                        for (int j = 0; j < 8; ++j) { s1 += v[j]; s2 += v[j] * v[j]; }
                    }
                    *(u32x4*)(prow + bj * 128) = pack8(v);
                }
                if (STAT) { s1 += __shfl_xor(s1, 16); s1 += __shfl_xor(s1, 32); s2 += __shfl_xor(s2, 16); s2 += __shfl_xor(s2, 32);
                    if (fq == 0) { if (STAT == 2) *(f32x2*)(stp + (size_t)(row0 + rt) * 2) = (f32x2){s1, s2}; else stp[row0 + rt] = s2; } }
            }
    }
};

struct SchedP1 {
    const unsigned char* ws; int G, c; int nconv;
    __device__ __forceinline__ bool next(int i, Unit& u) const {
        const int L = i * G + c; constexpr int NMAIN = 32 * NT_IN;
        if (L >= NMAIN + 16) return false;
        if (L >= NMAIN && G != 256) { unsigned* fl = (unsigned*)ws + XB_WMEM; unsigned sp = 0u;
            while (__hip_atomic_load(fl, __ATOMIC_RELAXED, __HIP_MEMORY_SCOPE_AGENT) < (unsigned)nconv) { __builtin_amdgcn_s_sleep(2); if (++sp > (1u << 22)) break; }
            __builtin_amdgcn_fence(__ATOMIC_ACQUIRE, "agent"); }
        else if (G == 256 ? (i == 3 && ((c & 1) || (c >= 160 && c < 176))) : i > 0) { if (
(int)__builtin_amdgcn_mbcnt_hi(~0u, __builtin_amdgcn_mbcnt_lo(~0u, 0u)) == 0) { unsigned* fl = (unsigned*)ws + XB_WMEM; unsigned sp = 0u;
            while (__hip_atomic_load(fl, __ATOMIC_RELAXED, __HIP_MEMORY_SCOPE_AGENT) < (unsigned)nconv) { __builtin_amdgcn_s_sleep(2); if (++sp > (1u << 22)) break; } } }
        if (L < NMAIN) { const int wg = (L % 8) * (NMAIN / 8) + L / 8; constexpr int nig = 8 * NT_IN; const int gid = wg / nig, w = wg % nig; const int pm = gid * 8 + (w % 8), pn = w / 8;
            u.pm = pm; u.pn = pn; u.A = (const char*)(ws + WS_H) + (size_t)pm * 256 * D * 2; u.B = (const char*)(ws + WS_WIN) + (size_t)pn * 256 * D * 2;
            u.mode = pn < 8 ? M_GELU : pn < 16 ? M_GELU_STAT : pn < 24 ? M_SILU : pn < 28 ? M_RAW_SS : pn == 28 ? M_KROPE : pn < 37 ? M_SILU : pn < 45 ? M_QM : pn < 53 ? M_SILU : M_GATE; }
        else if (L < NMAIN + 8) { const int pn = L - NMAIN; u.pm = 0; u.pn = pn; u.A = (const char*)(ws + WS_MEMN); u.B = (const char*)(ws + WS_WMEM) + (size_t)pn * 256 * D * 2; u.mode = M_MEMK; }
        else { const int pm = L - NMAIN - 8; u.pm = pm; u.pn = 0; u.A = (const char*)(ws + WS_WMEM) + (size_t)(2048 + pm * 256) * D * 2; u.B = (const char*)(ws + WS_MEMN); u.mode = M_MEMV; }
        return true;
    }
};

struct EpiP2 {
    __device__ __forceinline__ bool keep_acc(const Unit&) const { return false; }
    unsigned char* ws; LAS float* xch;
    __device__ __forceinline__ void operator()(f32x4 (&acc)[2][2][4][2], const Unit& u, int wr, int wc, int fr, int fq) const {
        const int mode = u.mode, row0 = u.pm * 256;
        if (mode == M_MEMS) {
            LAS float* XM = xch; LAS float* XS = xch + 1024;
#pragma unroll
            for (int ai = 0; ai < 2; ++ai)
#pragma unroll
                for (int m = 0; m < 4; ++m) { float t = -1e30f;
#pragma unroll
                    for (int bj = 0; bj < 2; ++bj)
#pragma unroll
                        for (int n = 0; n < 2; ++n) { const f32x4 x = acc[ai][bj][m][n]; t = fmaxf(t, fmaxf(fmaxf(x[0], x[1]), fmaxf(x[2], x[3]))); }
                    t = fmaxf(t, __shfl_xor(t, 16)); t = fmaxf(t, __shfl_xor(t, 32));
                    if (fq == 0) XM[(ai * 128 + wr * 64 + m * 16 + fr) * 4 + wc] = t; }
            asm volatile("s_waitcnt lgkmcnt(0)" ::: "memory"); __builtin_amdgcn_s_barrier(); asm volatile("" ::: "memory");
#pragma unroll
            for (int ai = 0; ai < 2; ++ai)
#pragma unroll
                for (int m = 0; m < 4; ++m) { const int rt = ai * 128 + wr * 64 + m * 16 + fr; const f32x4 q = *(const LAS f32x4*)(XM + rt * 4);
                    const float mxr = fmaxf(fmaxf(q[0], q[1]), fmaxf(q[2], q[3])); float s = 0.f;
#pragma unroll
                    for (int bj = 0; bj < 2; ++bj)
#pragma unroll
                        for (int n = 0; n < 2; ++n)
#pragma unroll
                            for (int e = 0; e < 4; ++e) { const float x = fast_exp2(acc[ai][bj][m][n][e] - mxr); acc[ai][bj][m][n][e] = x; s += x; }
                    s += __shfl_xor(s, 16); s += __shfl_xor(s, 32);
                    if (fq == 0) XS[rt * 4 + wc] = s; }
            asm volatile("s_waitcnt lgkmcnt(0)" ::: "memory"); __builtin_amdgcn_s_barrier(); asm volatile("" ::: "memory");
            bf16_t* P = (bf16_t*)(ws + WS_P) + (size_t)u.pn * S * 256;
#pragma unroll
            for (int ai = 0; ai < 2; ++ai)
#pragma unroll
                for (int m = 0; m < 4; ++m) { const int rt = ai * 128 + wr * 64 + m * 16 + fr; const f32x4 q = *(const LAS f32x4*)(XS + rt * 4);
                    const float iv = fast_rcp((q[0] + q[1]) + (q[2] + q[3]));
#pragma unroll
                    for (int bj = 0; bj < 2; ++bj) { float v[8];
#pragma unroll
                        for (int j = 0; j < 8; ++j) v[j] = acc[ai][bj][m][j >> 2][j & 3] * iv;
                        *(u32x4*)(P + (size_t)(row0 + rt) * 256 + bj * 128 + wc * 32 + 8 * fq) = pack8(v); } }
            return;
        }
        const float* stp = (const float*)(ws + (mode == M_QUP ? WS_CQST : WS_CKVST));
        const f32x2* CS = (const f32x2*)(ws + WS_CS);
        LAS float* RS = xch + 2048 + 64;
        { const int t_ = ((wr * 4 + wc) * 4 + fq) * 16 + fr;
          if (t_ < 256) { float ss = 0.f;
#pragma unroll
              for (int j = 0; j < 8; ++j) ss += stp[(size_t)j * S + row0 + t_];
              RS[t_] = 1.0f / sqrtf(ss * (1.f / 512.f) + EPS); }
          asm volatile("s_waitcnt lgkmcnt(0)" ::: "memory"); __builtin_amdgcn_s_barrier(); asm volatile("" ::: "memory"); }
        float rsv[2][4];
#pragma unroll
        for (int ai = 0; ai < 2; ++ai)
#pragma unroll
            for (int m = 0; m < 4; ++m) rsv[ai][m] = RS[ai * 128 + wr * 64 + m * 16 + fr];
#define P2_V8(ai, m, bj) float v[8] = {acc[ai][bj][m][0][0], acc[ai][bj][m][0][1], acc[ai][bj][m][0][2], acc[ai][bj][m][0][3], acc[ai][bj][m][1][0], acc[ai][bj][m][1][1], acc[ai][bj][m][1][2], acc[ai][bj][m][1][3]}; \
        _Pragma("unroll") for (int j = 0; j < 8; ++j) v[j] *= rsv[ai][m]
        if (mode == M_QUP) {
#pragma unroll
            for (int bj = 0; bj < 2; ++bj) { const int ct = bj * 128 + wc * 32 + 8 * fq; const int cg = u.pn * 256 + ct, head = cg / DQK, w = cg - head * DQK;
                bf16_t* q0 = (bf16_t*)(ws + WS_QB) + (size_t)head * S * DQK;
                if (w < 128) {
#pragma unroll
                    for (int ai = 0; ai < 2; ++ai)
#pragma unroll
                        for (int m = 0; m < 4; ++m) { const int row = row0 + ai * 128 + wr * 64 + m * 16 + fr; P2_V8(ai, m, bj); *(u32x4*)(q0 + (size_t)row * DQK + w) = pack8(v); }
                } else { const int i0 = (w - 128) >> 1;
#pragma unroll
                    for (int ai = 0; ai < 2; ++ai) { f32x2 cs[4][4];
#pragma unroll
                        for (int m = 0; m < 4; ++m) { const int row = row0 + ai * 128 + wr * 64 + m * 16 + fr;
#pragma unroll
                            for (int j = 0; j < 4; ++j) cs[m][j] = CS[row * 32 + i0 + j]; }
#pragma unroll
                        for (int m = 0; m < 4; ++m) { const int row = row0 + ai * 128 + wr * 64 + m * 16 + fr; P2_V8(ai, m, bj); float o1[4], o2[4];
#pragma unroll
                            for (int j = 0; j < 4; ++j) { const f32x2 c2 = cs[m][j]; const float t1 = v[2 * j], t2 = v[2 * j + 1]; o1[j] = t1 * c2.x - t2 * c2.y; o2[j] = t2 * c2.x + t1 * c2.y; }
                            u32x2 w1, w2; w1.x = cvt_pk_bf16(o1[0], o1[1]); w1.y = cvt_pk_bf16(o1[2], o1[3]); w2.x = cvt_pk_bf16(o2[0], o2[1]); w2.y = cvt_pk_bf16(o2[2], o2[3]);
                            bf16_t* q = q0 + (size_t)row * DQK; *(u32x2*)(q + 128 + i0) = w1; *(u32x2*)(q + 160 + i0) = w2; } }
                }
            }
        } else { const int head = u.pn;
#pragma unroll
            for (int ai = 0; ai < 2; ++ai) { u32x4 kr[4];
                if (wc < 2) {
#pragma unroll
                    for (int m = 0; m < 4; ++m) { const int row = row0 + ai * 128 + wr * 64 + m * 16 + fr; kr[m] = *(const u32x4*)((const bf16_t*)(ws + WS_KR) + (size_t)row * 64 + (wc * 4 + fq) * 8); } }
#pragma unroll
                for (int m = 0; m < 4; ++m) { const int row = row0 + ai * 128 + wr * 64 + m * 16 + fr;
                    { P2_V8(ai, m, 0); *(u32x4*)((bf16_t*)(ws + WS_KB) + ((size_t)head * S + row) * DQK + wc * 32 + 8 * fq) = pack8(v); }
                    { P2_V8(ai, m, 1); *(u32x4*)((bf16_t*)(ws + WS_VB) + ((size_t)head * S + row) * DV + wc * 32 + 8 * fq) = pack8(v); }
                    if (wc < 2) *(u32x4*)((bf16_t*)(ws + WS_KB) + ((size_t)head * S + row) * DQK + 128 + (wc * 4 + fq) * 8) = kr[m]; } }
        }
#undef P2_V8
    }
};
struct SchedP2 {
    const unsigned char* ws; int G, c;
    __device__ __forceinline__ bool next(int i, Unit& u) const {
        if (i >= 4 || c >= 256) return false;
        const int x = c & 7, l = i * 32 + (c >> 3);
        if (l < 48) { const int pm = 4 * x + (l & 3), pn = l >> 2; u.pm = pm; u.pn = pn; u.mode = M_QUP; u.A = (const char*)(ws + WS_CQ) + (size_t)pm * 256 * 512 * 2; u.B = (const char*)(ws + WS_WUQ) + (size_t)pn * 256 * 512 * 2; }
        else if (l < 112) { const int l2 = l - 48, pm = 4 * x + (l2 & 3), pn = l2 >> 2; u.pm = pm; u.pn = pn; u.mode = M_KVUP; u.A = (const char*)(ws + WS_CKV) + (size_t)pm * 256 * 512 * 2; u.B = (const char*)(ws + WS_WUKV) + (size_t)pn * 256 * 512 * 2; }
        else { const int l2 = l - 112, pm = 4 * x + (l2 & 3), h = l2 >> 2; u.pm = pm; u.pn = h; u.mode = M_MEMS; u.A = (const char*)(ws + WS_QMH) + ((size_t)h * S + pm * 256) * 512 * 2; u.B = (const char*)(ws + WS_KMH) + (size_t)h * ML * 512 * 2; }
        return true;
    }
};

struct EpiMulZ {
    __device__ __forceinline__ bool keep_acc(const Unit&) const { return false; }
    unsigned char* dout;
    __device__ __forceinline__ void operator()(f32x4 (&acc)[2][2][4][2], const Unit& u, int wr, int wc, int fr, int fq) const {
        bf16_t* Z = (bf16_t*)dout + (size_t)S * D; const int row0 = u.pm * 256, cb = u.pn * 256;
        EPI_LOOP_BEGIN
            bf16_t* p = Z + (size_t)(row0 + rt) * D + cb + ct; float z[8]; unpack8(*(const u32x4*)p, z);
#pragma unroll
            for (int j = 0; j < 8; ++j) v[j] *= z[j];
            *(u32x4*)p = pack8(v);
        EPI_LOOP_END
    }
};
struct SchedP3b {
    const unsigned char* ws; int G, c;
    __device__ __forceinline__ bool next(int i, Unit& u) const {
        const int L = i * G + c; if (L >= 256) return false;
        const int pm = L >> 3, hn = L & 7, h = hn >> 1; u.pm = pm; u.pn = hn; u.mode = M_MULZ;
        u.A = (const char*)(ws + WS_P) + ((size_t)h * S + pm * 256) * 256 * 2; u.B = (const char*)(ws + WS_VMT) + (size_t)hn * 256 * 256 * 2; return true;
    }
};

struct EpiP4 {
    unsigned char* ws;
    __device__ __forceinline__ bool keep_acc(const Unit& u) const { return u.mode != M_BR2; }
    __device__ __forceinline__ void operator()(f32x4 (&acc)[2][2][4][2], const Unit& u, int wr, int wc, int fr, int fq) const {
        const int n = u.mode - M_BR0, row0 = u.pm * 256, cb = u.pn * 256;
        const bf16_t* G = (const bf16_t*)(ws + WS_G) + (size_t)n * D; bf16_t* MG = (bf16_t*)(ws + WS_MERGED);
#pragma unroll
        for (int ai = 0; ai < 2; ++ai) {
            u32x4 ga[4][2], gb[4][2];
#pragma unroll
            for (int m = 0; m < 4; ++m)
#pragma unroll
                for (int bj = 0; bj < 2; ++bj) { const size_t r = (size_t)(row0 + ai * 128 + wr * 64 + m * 16 + fr); const bf16_t* gp = G + r * 3 * D + cb + bj * 128 + wc * 32 + 8 * fq;
                    ga[m][bj] = *(const u32x4*)gp; if (n < 2) gb[m][bj] = *(const u32x4*)(gp + D); }
#pragma unroll
            for (int m = 0; m < 4; ++m)
#pragma unroll
                for (int bj = 0; bj < 2; ++bj) { float g[8]; unpack8(ga[m][bj], g);
                    if (n < 2) { float gn[8]; unpack8(gb[m][bj], gn);
#pragma unroll
                        for (int j = 0; j < 8; ++j) acc[ai][bj][m][j >> 2][j & 3] *= g[j] * fast_rcp(gn[j]); }
                    else { float v[8]; const size_t r = (size_t)(row0 + ai * 128 + wr * 64 + m * 16 + fr);
#pragma unroll
                        for (int j = 0; j < 8; ++j) v[j] = acc[ai][bj][m][j >> 2][j & 3] * g[j];
                        *(u32x4*)(MG + r * D + cb + bj * 128 + wc * 32 + 8 * fq) = pack8(v); } }
        }
    }
};
struct SchedP4 {
    const unsigned char* ws; const unsigned char* dout; int G, c;
    __device__ __forceinline__ bool next(int i, Unit& u) const {
        if (i >= 3 || c >= 256) return false;
        const int vc = (c % 8) * 32 + c / 8, pm = vc / 8, pn = vc % 8; u.pm = pm; u.pn = pn; u.mode = M_BR0 + i;
        const unsigned char* y = i == 0 ? ws + WS_UG : i == 1 ? dout : dout + (size_t)S * D * 2;
        u.A = (const char*)y + (size_t)pm * 256 * D * 2; u.B = (const char*)(ws + WS_WBR) + ((size_t)i * D + pn * 256) * D * 2; return true;
    }
};

struct EpiP5 {
    __device__ __forceinline__ bool keep_acc(const Unit&) const { return false; }
    unsigned char* ws; float* out;
    __device__ __forceinline__ void operator()(f32x4 (&acc)[2][2][4][2], const Unit& u, int wr, int wc, int fr, int fq) const {
        const int row0 = u.pm * 256, cb = u.pn * 256; float* st = (float*)(ws + WS_OST) + (size_t)(u.pn * 4 + wc) * S;
#pragma unroll
        for (int ai = 0; ai < 2; ++ai)
#pragma unroll
            for (int m = 0; m < 4; ++m) { const int rt = ai * 128 + wr * 64 + m * 16 + fr; float s2 = 0.f;
#pragma unroll
                for (int bj = 0; bj < 2; ++bj) { const int ct = bj * 128 + wc * 32 + 8 * fq; const f32x4 a = acc[ai][bj][m][0], b = acc[ai][bj][m][1];
                    s2 += (a[0] * a[0] + a[1] * a[1]) + (a[2] * a[2] + a[3] * a[3]) + (b[0] * b[0] + b[1] * b[1]) + (b[2] * b[2] + b[3] * b[3]);
                    const float v_[8] = {a[0], a[1], a[2], a[3], b[0], b[1], b[2], b[3]}; *(u32x4*)((bf16_t*)(ws + WS_MP) + (size_t)(row0 + rt) * D + cb + ct) = pack8(v_); }
                s2 += __shfl_xor(s2, 16); s2 += __shfl_xor(s2, 32);
                if (fq == 0) st[row0 + rt] = s2; }
    }
};
struct SchedP5 {
    const unsigned char* ws; int G, c;
    __device__ __forceinline__ bool next(int i, Unit& u) const {
        if (i >= 1 || c >= 256) return false;
        const int vc = (c % 8) * 32 + c / 8, pm = vc / 8, pn = vc % 8; u.pm = pm; u.pn = pn; u.mode = M_OUT;
        u.A = (const char*)(ws + WS_MERGED) + (size_t)pm * 256 * D * 2; u.B = (const char*)(ws + WS_WOUT) + (size_t)pn * 256 * D * 2; return true;
    }
};

enum { MAP_ID = 0, MAP_WIN, MAP_UQ };
__device__ __forceinline__ int map_row(int map, int n) {
    if (map == MAP_WIN) { if (n < 7168) return n; if (n < 7232) { const int i = n - 7168; return 7168 + (i < 32 ? 2 * i : 2 * (i - 32) + 1); } return n + 192; }
    if (map == MAP_UQ) { const int h = n / DQK, w = n - h * DQK; if (w < 128) return n; const int i = w - 128; return h * DQK + 128 + (i < 32 ? 2 * i : 2 * (i - 32) + 1); }
    return n;
}
struct WTile { const float* W; bf16_t* WT; const float* kgain; int K, N, row_off, map, k0, n0; float sc; };
struct WSeg { const float* W; bf16_t* WT; const float* kgain; int K, N, row_off, map; float sc; int ncols; };
__device__ __forceinline__ WTile wtile_of(const WSeg& s, int r) { WTile t; t.W = s.W; t.WT = s.WT; t.kgain = s.kgain; t.K = s.K; t.N = s.N; t.row_off = s.row_off; t.map = s.map; t.sc = s.sc;
    const int nblk = (s.ncols ? s.ncols : s.N) / 64; t.k0 = 64 * (r / nblk); t.n0 = 64 * (r % nblk); return t; }
__device__ __forceinline__ void wtile_issue(const WTile& t, f32x4 (&r)[16], int lane) {
    const float* p = t.W + (size_t)(t.k0 + (lane >> 4)) * t.N + t.n0 + 4 * (lane & 15);
#pragma unroll
    for (int q = 0; q < 16; ++q) r[q] = __builtin_nontemporal_load((const __attribute__((address_space(1))) f32x4*)(p + (size_t)(4 * q) * t.N));
}
__device__ __forceinline__ void wtile_finish(const WTile& t, const f32x4 (&r)[16], LAS float* scr, int lane) {
#pragma unroll
    for (int q = 0; q < 16; ++q) { const int k = 4 * q + (lane >> 4); f32x4 v = r[q] * t.sc; if (t.kgain) v = v * t.kgain[t.k0 + k];
        *(LAS f32x4*)(scr + k * 64 + ((4 * (lane & 15)) ^ (((k >> 3) & 7) << 3))) = v; }
    asm volatile("s_waitcnt lgkmcnt(0)" ::: "memory");
    const int c = lane & 7;
#pragma unroll
    for (int j = 0; j < 8; ++j) { const int n = (lane >> 3) + 8 * j; const LAS float* s = scr + (8 * c) * 64 + (n ^ (c << 3));
        u32x4 o; o.x = cvt_pk_bf16(s[0 * 64], s[1 * 64]); o.y = cvt_pk_bf16(s[2 * 64], s[3 * 64]); o.z = cvt_pk_bf16(s[4 * 64], s[5 * 64]); o.w = cvt_pk_bf16(s[6 * 64], s[7 * 64]);
        *(u32x4*)(t.WT + (size_t)(t.row_off + map_row(t.map, t.n0 + n)) * t.K + t.k0 + 8 * c) = o; }
    asm volatile("s_waitcnt lgkmcnt(0)" ::: "memory");
}
template <int NSEG> __device__ __forceinline__ WTile wtile_decode(const WSeg (&seg)[NSEG], int it) {
    int r = it;
#pragma unroll
    for (int s = 0; s < NSEG - 1; ++s) { const int cnt = (seg[s].K / 64) * ((seg[s].ncols ? seg[s].ncols : seg[s].N) / 64); if (r < cnt) return wtile_of(seg[s], r); r -= cnt; }
    return wtile_of(seg[NSEG - 1], r);
}
template <int NSEG> __device__ __forceinline__ void wconv_run(const WSeg (&seg)[NSEG], int ntiles, int it0, int stride, LAS float* scr, int lane) {
    if (it0 >= ntiles) return;
    f32x4 ra[16], rb[16];
    WTile ta = wtile_decode(seg, it0), tb = ta; wtile_issue(ta, ra, lane);
    for (int it = it0; it < ntiles; it += 2 * stride) {
        const bool hb = it + stride < ntiles; if (hb) { tb = wtile_decode(seg, it + stride); wtile_issue(tb, rb, lane); }
        wtile_finish(ta, ra, scr, lane);
        if (!hb) break;
        const bool ha = it + 2 * stride < ntiles; if (ha) { ta = wtile_decode(seg, it + 2 * stride); wtile_issue(ta, ra, lane); }
        wtile_finish(tb, rb, scr, lane);
    }
}
__device__ __forceinline__ void rms_row_to_bf16(const float* xrow, const float* g, bf16_t* orow, int lane) {
    const f32x4* xr = (const f32x4*)xrow + lane; const f32x4* gr = (const f32x4*)g + lane;
    f32x4 v[8]; float s = 0.f;
#pragma unroll
    for (int j = 0; j < 8; ++j) { v[j] = __builtin_nontemporal_load((const __attribute__((address_space(1))) f32x4*)(xr + 64 * j)); s += (v[j].x * v[j].x + v[j].y * v[j].y) + (v[j].z * v[j].z + v[j].w * v[j].w); }
    const float rs = 1.0f / sqrtf(wave_sum(s) * (1.f / D) + EPS);
    u32x2* o8 = (u32x2*)orow + lane;
#pragma unroll
    for (int j = 0; j < 8; ++j) { const f32x4 gg = gr[64 * j]; u32x2 w; w.x = cvt_pk_bf16(v[j].x * rs * gg.x, v[j].y * rs * gg.y); w.y = cvt_pk_bf16(v[j].z * rs * gg.z, v[j].w * rs * gg.w); o8[64 * j] = w; }
}
__device__ __forceinline__ void phase0(const Ptrs& P, LAS unsigned char* lds, int vcu, int G, int tid, int lane, int wave) {
    unsigned char* ws = P.ws;
    LAS float* scr = (LAS float*)(lds + wave * 16384);
    const int gw = vcu * NWAVES + wave, NGW = G * NWAVES;
    { const WSeg seg[2] = {
          {P.in[4], (bf16_t*)(ws + WS_WIN), nullptr, D, IN_TOTAL, 0, MAP_WIN, 1.f},
          {P.in[15], (bf16_t*)(ws + WS_WIN), nullptr, D, 6144, 53 * 256, MAP_ID, 1.f, GATE_P0_COLS}};
      constexpr int NT0 = 32 * (IN_TOTAL / 64) + 32 * (GATE_P0_COLS / 64);
      wconv_run(seg, NT0, gw, NGW, scr, lane); }
    { u32x4* z = (u32x4*)((bf16_t*)(ws + WS_WIN) + (size_t)7232 * D); const int n16 = 192 * D * 2 / 16;
      for (int i = vcu * NTHREADS + tid; i < n16; i += G * NTHREADS) z[i] = (u32x4){0u, 0u, 0u, 0u}; }
    constexpr int NT0R = (32 * (IN_TOTAL / 64) + 32 * (GATE_P0_COLS / 64)) % (256 * NWAVES);
    const int gwr = gw >= NT0R ? gw - NT0R : gw + NGW - NT0R;
    for (int m = gwr; m < S + ML; m += NGW) {
        if (m < S) rms_row_to_bf16(P.in[0] + (size_t)m * D, P.in[3], (bf16_t*)(ws + WS_H) + (size_t)m * D, lane);
        else rms_row_to_bf16(P.in[1] + (size_t)(m - S) * D, P.in[13], (bf16_t*)(ws + WS_MEMN) + (size_t)(m - S) * D, lane);
    }
    { const int* pos = (const int*)P.in[2]; f32x2* CS = (f32x2*)(ws + WS_CS);
      for (int e = vcu * NTHREADS + tid; e < S * 32; e += G * NTHREADS) { const int row = e >> 5, i = e & 31;
          const double inv = exp2(-(double)i * (13.287712379549449 / 32.0));
          const float invf = (float)inv; const float angf = (float)pos[row] * invf;
          const double a = (double)angf; const double k = rint(a * 0.15915494309189535); const float r = (float)(a - k * 6.283185307179586);
          CS[e] = (f32x2){__cosf(r), __sinf(r)}; } }
    { const float* w = P.in[7]; bf16_t* o = (bf16_t*)(ws + WS_WSM);
      for (int e = vcu * NTHREADS + tid; e < 16 * 128 * 128 / 2; e += G * NTHREADS) { const int idx = e * 2, t = (idx >> 7) & 127, s = idx & 127;
          const float a = s <= t ? w[idx] : 0.f, b = (s + 1) <= t ? w[idx + 1] : 0.f; ((unsigned*)o)[e] = cvt_pk_bf16(a, b); } }
}
__device__ __forceinline__ void phase_wconv2(const Ptrs& P, LAS unsigned char* lds, int part, int wg0, int nwg, int lane, int wave, int t_lo = 0, int t_hi = 4 * 32 * 32) {
    unsigned char* ws = P.ws; LAS float* scr = (LAS float*)(lds + wave * 16384);
    const int gw = wg0 * NWAVES + wave, NGW = nwg * NWAVES;
    if (part == 0) {
        const WSeg seg[4] = {
            {P.in[15] + GATE_P0_COLS, (bf16_t*)(ws + WS_WIN), nullptr, D, 6144, 53 * 256 + GATE_P0_COLS, MAP_ID, 1.f, 6144 - GATE_P0_COLS},
            {P.in[14], (bf16_t*)(ws + WS_WMEM), nullptr, D, 4096, 0, MAP_ID, 1.f},
            {P.in[10], (bf16_t*)(ws + WS_WUQ), P.in[9], 512, 3072, 0, MAP_UQ, QSCALE},
            {P.in[12], (bf16_t*)(ws + WS_WUKV), P.in[11], 512, 4096, 0, MAP_ID, 1.f}};
        wconv_run(seg, 32 * ((6144 - GATE_P0_COLS) / 64) + 32 * 64 + 8 * 48 + 8 * 64, gw, NGW, scr, lane);
    } else {
        const WSeg seg[4] = {
            {P.in[17], (bf16_t*)(ws + WS_WBR), nullptr, D, D, 0, MAP_ID, 1.f},
            {P.in[17] + (size_t)D * D, (bf16_t*)(ws + WS_WBR), nullptr, D, D, D, MAP_ID, 1.f},
            {P.in[17] + (size_t)2 * D * D, (bf16_t*)(ws + WS_WBR), nullptr, D, D, 2 * D, MAP_ID, 1.f},
            {P.in[18], (bf16_t*)(ws + WS_WOUT), nullptr, D, D, 0, MAP_ID, 1.f}};
        wconv_run(seg, t_hi, t_lo + gw, NGW, scr, lane);
    }
}

namespace att {
constexpr int NW = 8, QBLK = 32, KVBLK = 64, QB = 256;
constexpr int SHM_V = KVBLK * DV * 2, SHM_K = KVBLK * DQK * 2;
constexpr float THR = 6.f;
#define SBAR() __builtin_amdgcn_sched_barrier(0)
#define KSWZ(row, colB) ((row) * 384 + ((colB) ^ ((((row) >> 1) & 7) << 4)))
__device__ __forceinline__ int v_st(int k, int c) { const int kk = (k & ~0xC) | ((k & 4) << 1) | ((k & 8) >> 1); return ((kk >> 3) * 4 + (c >> 5)) * 512 + ((kk & 7) * 32 + (c & 31)) * 2; }
__device__ __forceinline__ int v_rd_base(int lane) { return ((lane & 3) << 3) | (((lane >> 2) & 3) << 6) | (((lane >> 4) & 1) << 5) | (((lane >> 5) & 1) << 8); }
constexpr int v_rd_off(int d0, int ks, int half) { return d0 * 512 + ks * 4096 + half * 2048; }
__device__ __forceinline__ int crow(int r, int hi) { return (r & 3) + 8 * (r >> 2) + 4 * hi; }
__device__ __forceinline__ void mask_tile(f32x16& p0, f32x16& p1, int dq) {
    const float NEG = -__builtin_inff();
#pragma unroll
    for (int r = 0; r < 16; ++r) { const int c = (r & 3) + 8 * (r >> 2); if (dq - c < 0) p0[r] = NEG; if (dq - c - 32 < 0) p1[r] = NEG; }
}
__device__ __forceinline__ void partialSM(f32x16& p0, f32x16& p1, float& m_reg, float& mn, float& alpha) {
    float pmax = p0[0];
#pragma unroll
    for (int r = 1; r < 16; ++r) pmax = fmaxf(pmax, p0[r]);
#pragma unroll
    for (int r = 0; r < 16; ++r) pmax = fmaxf(pmax, p1[r]);
    { auto rr = __builtin_amdgcn_permlane32_swap(__float_as_uint(pmax), __float_as_uint(pmax), false, false); pmax = fmaxf(__uint_as_float(rr[0]), __uint_as_float(rr[1])); }
    if (__builtin_expect(__all((pmax - m_reg) <= THR), 1)) { mn = m_reg; alpha = 1.f; }
    else { mn = fmaxf(m_reg, pmax); alpha = fast_exp2(m_reg - mn); m_reg = mn; }
#pragma unroll
    for (int r = 0; r < 16; ++r) p0[r] = p0[r] - mn;
#pragma unroll
    for (int r = 0; r < 16; ++r) p1[r] = p1[r] - mn;
#pragma unroll
    for (int r = 0; r < 16; ++r) p0[r] = fast_exp2(p0[r]);
}
__device__ __forceinline__ void finishSM(f32x16& p0, f32x16& p1, float alpha, float& l_reg, bf16x8& pa0, bf16x8& pa1, bf16x8& pa2, bf16x8& pa3) {
#pragma unroll
    for (int r = 0; r < 16; ++r) p1[r] = fast_exp2(p1[r]);
    float ps = 0;
#pragma unroll
    for (int r = 0; r < 16; ++r) ps += p0[r];
#pragma unroll
    for (int r = 0; r < 16; ++r) ps += p1[r];
    { auto rr = __builtin_amdgcn_permlane32_swap(__float_as_uint(ps), __float_as_uint(ps), false, false); ps = __uint_as_float(rr[0]) + __uint_as_float(rr[1]); }
    l_reg = l_reg * alpha + ps;
#define PK4(P, B_, OUT) do { unsigned a0 = cvt_pk_bf16(P[B_+0], P[B_+1]), a1 = cvt_pk_bf16(P[B_+2], P[B_+3]); unsigned b0 = cvt_pk_bf16(P[B_+4], P[B_+5]), b1 = cvt_pk_bf16(P[B_+6], P[B_+7]); \
        auto r0 = __builtin_amdgcn_permlane32_swap(a0, b0, false, false); auto r1 = __builtin_amdgcn_permlane32_swap(a1, b1, false, false); \
        u32x4 w = {r0[0], r1[0], r0[1], r1[1]}; OUT = *reinterpret_cast<bf16x8*>(&w); } while (0)
    PK4(p0, 0, pa0); PK4(p0, 8, pa1); PK4(p1, 0, pa2); PK4(p1, 8, pa3);
#undef PK4
}
#define TRRD(dst, off) asm volatile("ds_read_b64_tr_b16 %0, %1 offset:%2" : "=&v"(dst) : "v"(vb0), "i"(off) : "memory")
#define PV_D0(OO, VBOFF, d0) do { s16x4 l0, l1, l2, l3, h0, h1, h2, h3; constexpr int b_ = (VBOFF) + v_rd_off(d0, 0, 0); \
        TRRD(l0, b_); TRRD(h0, b_ + 2048); TRRD(l1, b_ + 4096); TRRD(h1, b_ + 6144); TRRD(l2, b_ + 8192); TRRD(h2, b_ + 10240); TRRD(l3, b_ + 12288); TRRD(h3, b_ + 14336); \
        asm volatile("s_waitcnt lgkmcnt(0)" ::: "memory"); SBAR(); \
        OO = __builtin_amdgcn_mfma_f32_32x32x16_bf16(pa0, (bf16x8){l0[0], l0[1], l0[2], l0[3], h0[0], h0[1], h0[2], h0[3]}, OO, 0, 0, 0); \
        OO = __builtin_amdgcn_mfma_f32_32x32x16_bf16(pa1, (bf16x8){l1[0], l1[1], l1[2], l1[3], h1[0], h1[1], h1[2], h1[3]}, OO, 0, 0, 0); \
        OO = __builtin_amdgcn_mfma_f32_32x32x16_bf16(pa2, (bf16x8){l2[0], l2[1], l2[2], l2[3], h2[0], h2[1], h2[2], h2[3]}, OO, 0, 0, 0); \
        OO = __builtin_amdgcn_mfma_f32_32x32x16_bf16(pa3, (bf16x8){l3[0], l3[1], l3[2], l3[3], h3[0], h3[1], h3[2], h3[3]}, OO, 0, 0, 0); } while (0)
__device__ __forceinline__ void glds16(const void* gsrc, unsigned lds_dst) { unsigned keep;
    asm volatile("s_mov_b32 %0, m0\n\ts_mov_b32 m0, %2\n\ts_nop 0\n\tglobal_load_lds_dwordx4 %1, off\n\ts_mov_b32 m0, %0" : "=&s"(keep) : "v"(gsrc), "s"(lds_dst) : "memory"); }
typedef short v4i16_t __attribute__((ext_vector_type(4)));
__device__ __forceinline__ s16x4 vtr(const LAS char* p) { return __builtin_bit_cast(s16x4, __builtin_amdgcn_ds_read_tr16_b64_v4i16((LAS v4i16_t*)p)); }
__device__ __forceinline__ void pv_tile2(f32x16* o, const LAS char* vp, bf16x8 pa0, bf16x8 pa1, bf16x8 pa2, bf16x8 pa3) {
#pragma unroll
    for (int d0 = 0; d0 < 4; ++d0) {
        const s16x4 l0 = vtr(vp + d0 * 512), h0 = vtr(vp + d0 * 512 + 2048), l1 = vtr(vp + d0 * 512 + 4096), h1 = vtr(vp + d0 * 512 + 6144);
        const s16x4 l2 = vtr(vp + d0 * 512 + 8192), h2 = vtr(vp + d0 * 512 + 10240), l3 = vtr(vp + d0 * 512 + 12288), h3 = vtr(vp + d0 * 512 + 14336);
        o[d0] = __builtin_amdgcn_mfma_f32_32x32x16_bf16(pa0, (bf16x8){l0[0], l0[1], l0[2], l0[3], h0[0], h0[1], h0[2], h0[3]}, o[d0], 0, 0, 0);
        o[d0] = __builtin_amdgcn_mfma_f32_32x32x16_bf16(pa1, (bf16x8){l1[0], l1[1], l1[2], l1[3], h1[0], h1[1], h1[2], h1[3]}, o[d0], 0, 0, 0);
        o[d0] = __builtin_amdgcn_mfma_f32_32x32x16_bf16(pa2, (bf16x8){l2[0], l2[1], l2[2], l2[3], h2[0], h2[1], h2[2], h2[3]}, o[d0], 0, 0, 0);
        o[d0] = __builtin_amdgcn_mfma_f32_32x32x16_bf16(pa3, (bf16x8){l3[0], l3[1], l3[2], l3[3], h3[0], h3[1], h3[2], h3[3]}, o[d0], 0, 0, 0); }
}
constexpr int OFF3_V = 0, OFF3_K = 4 * SHM_V, OFF3_WS = OFF3_K + 3 * SHM_K + 256;
__device__ __forceinline__ void attn_block3(const bf16_t* Qh, const bf16_t* Kh, const bf16_t* Vh, bf16_t* ZY, int P0, char* lds, const int tid) {
    const int wid = __builtin_amdgcn_readfirstlane(tid >> 6), lane = tid & 63, r32 = lane & 31, hi = lane >> 5;
    const bool lag = wid >= 4;
    const int NT = (P0 + QB) / KVBLK;
    const int qlo = P0 + wid * QBLK, qm = qlo + r32 - 4 * hi;
    char* K_lds = lds + OFF3_K;
    float* wsf = (float*)(lds + OFF3_WS) + wid * 64; float* li_l = wsf, * al_l = wsf + 32;
    float m_reg = -1e30f, l_reg = 0; f32x16 o[4] = {};
    const unsigned lds0 = (unsigned)(uintptr_t)lds;
    int kso[3], vso[2];
#pragma unroll
    for (int j = 0; j < 3; ++j) { const int q = (wid * 3 + j) * 1024 + lane * 16, row = q / 384, pos = q - row * 384; kso[j] = row * 384 + (pos ^ (((row >> 1) & 7) << 4)); }
#pragma unroll
    for (int j = 0; j < 2; ++j) { const int q = (wid * 2 + j) * 1024 + lane * 16, sub = q >> 9, within = q & 511, kk = (sub >> 2) * 8 + (within >> 6), cc = (within & 63) >> 1;
        const int k = (kk & ~0xC) | ((kk & 4) << 1) | ((kk & 8) >> 1), c = (sub & 3) * 32 + cc; vso[j] = k * (DV * 2) + c * 2; }
    int kis = 0, vis = 0, kq = 0, vp = 0;
#define ROTK(x) ((x) == 2 * SHM_K ? 0 : (x) + SHM_K)
#define ROTV(x) ((x) == 3 * SHM_V ? 0 : (x) + SHM_V)
#define DMA_TILE(t) do { const char* kt_ = (const char*)Kh + (size_t)(t) * SHM_K; const char* vt_ = (const char*)Vh + (size_t)(t) * SHM_V; \
        _Pragma("unroll") for (int j_ = 0; j_ < 3; ++j_) glds16(kt_ + kso[j_], (unsigned)__builtin_amdgcn_readfirstlane(lds0 + OFF3_K + kis + (wid * 3 + j_) * 1024)); \
        _Pragma("unroll") for (int j_ = 0; j_ < 2; ++j_) glds16(vt_ + vso[j_], (unsigned)__builtin_amdgcn_readfirstlane(lds0 + OFF3_V + vis + (wid * 2 + j_) * 1024)); \
        kis = ROTK(kis); vis = ROTV(vis); } while (0)
#define END_M() asm volatile("s_waitcnt vmcnt(0) lgkmcnt(0)\n\ts_barrier" ::: "memory")
#define END_V() asm volatile("s_waitcnt lgkmcnt(0)\n\ts_barrier" ::: "memory")
    int ko[4];
#pragma unroll
    for (int dd = 0; dd < 4; ++dd) ko[dd] = KSWZ(r32, (dd * 16 + hi * 8) * 2);
    const LAS char* vbb = (const LAS char*)lds + OFF3_V + v_rd_base(lane);
    DMA_TILE(0); DMA_TILE(1);
    bf16x8 qr[12];
#pragma unroll
    for (int d0 = 0; d0 < 12; ++d0) qr[d0] = *reinterpret_cast<const bf16x8*>(Qh + (size_t)(P0 + wid * QBLK + r32) * DQK + d0 * 16 + hi * 8);
#define RESC(a) do { if (__any((a) < 1.f)) { if (hi == 0) al_l[r32] = (a); asm volatile("s_waitcnt lgkmcnt(0)" ::: "memory"); \
        _Pragma("unroll") for (int d_ = 0; d_ < 4; ++d_) _Pragma("unroll") for (int r = 0; r < 16; ++r) o[d_][r] *= al_l[crow(r, hi)]; } } while (0)
    f32x16 p0, p1; float mn, al; bf16x8 pa0, pa1, pa2, pa3;
    END_M();
    if (lag) END_V();
    for (int i = 0; i < NT; ++i) {
        const char* kb_ = K_lds + kq; bf16x8 ka[8], kb2[8];
#define KLOAD(dst, blk) do { _Pragma("unroll") for (int dd = 0; dd < 4; ++dd) { const char* a = kb_ + ko[dd] + (blk) * 128; dst[2 * dd] = *reinterpret_cast<const bf16x8*>(a); dst[2 * dd + 1] = *reinterpret_cast<const bf16x8*>(a + 32 * 384); } } while (0)
#define KMMA(srcf, blk) do { _Pragma("unroll") for (int dd = 0; dd < 4; ++dd) { p0 = __builtin_amdgcn_mfma_f32_32x32x16_bf16(srcf[2 * dd], qr[(blk) * 4 + dd], p0, 0, 0, 0); p1 = __builtin_amdgcn_mfma_f32_32x32x16_bf16(srcf[2 * dd + 1], qr[(blk) * 4 + dd], p1, 0, 0, 0); } } while (0)
        SBAR();
        { _Pragma("unroll") for (int dd = 0; dd < 2; ++dd) { const char* a = kb_ + ko[dd]; ka[2 * dd] = *reinterpret_cast<const bf16x8*>(a); ka[2 * dd + 1] = *reinterpret_cast<const bf16x8*>(a + 32 * 384); } }
        SBAR();
        if (i >= 1) { pv_tile2(o, vbb + vp, pa0, pa1, pa2, pa3); vp = ROTV(vp); }
        SBAR();
        { p0 = f32x16{}; p1 = f32x16{};
          { _Pragma("unroll") for (int dd = 2; dd < 4; ++dd) { const char* a = kb_ + ko[dd]; ka[2 * dd] = *reinterpret_cast<const bf16x8*>(a); ka[2 * dd + 1] = *reinterpret_cast<const bf16x8*>(a + 32 * 384); } }
          KLOAD(kb2, 1); SBAR(); KMMA(ka, 0); SBAR(); KLOAD(ka, 2); SBAR(); KMMA(kb2, 1); SBAR(); KMMA(ka, 2);
#undef KLOAD
#undef KMMA
          kq = ROTK(kq); }
        END_M();
        if (i + 2 < NT) DMA_TILE(i + 2);
        SBAR();
        { const int kb_ = i * KVBLK; if (kb_ + KVBLK - 1 > qlo) mask_tile(p0, p1, qm - kb_); }
        partialSM(p0, p1, m_reg, mn, al); RESC(al);
        finishSM(p0, p1, al, l_reg, pa0, pa1, pa2, pa3);
        END_V();
    }
    bf16_t* zy = ZY + (size_t)(P0 + wid * QBLK) * D; u32x4 zr[8];
#pragma unroll
    for (int i = 0; i < 8; ++i) { const int id = lane + 64 * i, row = id >> 4, ch = id & 15; zr[i] = *(const u32x4*)(zy + (size_t)row * D + ch * 8); }
    SBAR(); pv_tile2(o, vbb + vp, pa0, pa1, pa2, pa3);
    if (!lag) END_V();
    if (hi == 0) li_l[r32] = l_reg; asm volatile("s_waitcnt lgkmcnt(0)" ::: "memory");
    float rli[16];
#pragma unroll
    for (int r = 0; r < 16; ++r) rli[r] = fast_rcp(li_l[crow(r, hi)]);
    asm volatile("s_waitcnt lgkmcnt(0)\n\ts_barrier" ::: "memory");
    bf16_t* stg = (bf16_t*)lds + wid * 4096;
#pragma unroll
    for (int r = 0; r < 16; ++r) { const int orow = crow(r, hi);
#pragma unroll
        for (int d0 = 0; d0 < 4; ++d0) { const float v = o[d0][r] * rli[r]; const float vn = __uint_as_float((unsigned)__builtin_amdgcn_mov_dpp((int)__float_as_uint(v), 0xB1, 0xF, 0xF, true));
            if ((r32 & 1) == 0) *(unsigned*)(stg + orow * 128 + d0 * 32 + r32) = cvt_pk_bf16(v, vn); } }
    asm volatile("s_waitcnt lgkmcnt(0)" ::: "memory");
#pragma unroll
    for (int i = 0; i < 8; ++i) { const int id = lane + 64 * i, row = id >> 4, ch = id & 15; float a[8], z[8];
        unpack8(*(const u32x4*)(stg + row * 128 + ch * 8), a); bf16_t* p = zy + (size_t)row * D + ch * 8; unpack8(zr[i], z);
#pragma unroll
        for (int j = 0; j < 8; ++j) a[j] *= z[j];
        *(u32x4*)p = pack8(a); }
    asm volatile("s_waitcnt lgkmcnt(0)\n\ts_barrier" ::: "memory");
#undef ROTK
#undef ROTV
#undef DMA_TILE
#undef END_M
#undef END_V
#undef RESC
}

struct MixRegs { u32x4 vq[4]; f32x2 mrq[4]; u32x4 uq[4], zq[4]; };
__device__ __forceinline__ void mixer_issue(unsigned char* ws, int chunk, int g, const int tid, MixRegs& R) {
    const int wid = __builtin_amdgcn_readfirstlane(tid >> 6), lane = tid & 63; const int rb = wid & 3, dh = wid >> 2;
    const bf16_t* Vg = (const bf16_t*)(ws + WS_VG); const f32x2* VMR = (const f32x2*)(ws + WS_VMR); const bf16_t* Ug = (const bf16_t*)(ws + WS_UG); const bf16_t* Za = (const bf16_t*)(ws + WS_ZA);
    const int sr = tid >> 4, sc = (tid & 15) * 8; const int row0 = chunk * 128, col0 = g * 128;
#pragma unroll
    for (int q = 0; q < 4; ++q) { const int s = q * 32 + sr; R.vq[q] = *(const u32x4*)(Vg + (size_t)(row0 + s) * D + col0 + sc); R.mrq[q] = VMR[row0 + s]; }
#pragma unroll
    for (int i = 0; i < 4; ++i) { const int id = lane + 64 * i, tr = id >> 3, ch = id & 7, t = rb * 32 + tr; const size_t off = (size_t)(row0 + t) * D + col0 + dh * 64 + ch * 8;
        R.uq[i] = *(const u32x4*)(Ug + off); R.zq[i] = *(const u32x4*)(Za + off); }
}
struct MixInv { float bsq[4], lg[8], lb[8]; bf16x8 wa[2][4]; };
__device__ __forceinline__ void mixer_inv(unsigned char* ws, const float* ln_g, const float* ln_b, const float* b_s, int g, const int tid, MixInv& I) {
    const int wid = __builtin_amdgcn_readfirstlane(tid >> 6), lane = tid & 63, r32 = lane & 31, hi = lane >> 5; const int rb = wid & 3;
    const int sc = (tid & 15) * 8, col0 = g * 128;
#pragma unroll
    for (int i = 0; i < 4; ++i) { const int id = lane + 64 * i, tr = id >> 3; I.bsq[i] = b_s[g * 128 + rb * 32 + tr]; }
#pragma unroll
    for (int j = 0; j < 8; ++j) { I.lg[j] = ln_g[col0 + sc + j]; I.lb[j] = ln_b[col0 + sc + j]; }
    const bf16_t* Wm = (const bf16_t*)(ws + WS_WSM) + ((size_t)g * 128 + rb * 32 + r32) * 128;
#pragma unroll
    for (int kt = 0; kt < 2; ++kt)
#pragma unroll
        for (int ks = 0; ks < 4; ++ks) I.wa[kt][ks] = *(const bf16x8*)(Wm + kt * 64 + ks * 16 + hi * 8);
}
__device__ __forceinline__ void mixer_block(unsigned char* ws, int chunk, int g, char* lds, const int tid, const MixRegs& R, const MixInv& I) {
    const int wid = __builtin_amdgcn_readfirstlane(tid >> 6), lane = tid & 63, r32 = lane & 31, hi = lane >> 5;
    const int rb = wid & 3, dh = wid >> 2;
    const int sr = tid >> 4, sc = (tid & 15) * 8; const int row0 = chunk * 128, col0 = g * 128;
    bf16_t* Ug = (bf16_t*)(ws + WS_UG);
#pragma unroll
    for (int q = 0; q < 4; ++q) { const f32x2 mr = R.mrq[q]; float v[8];
        unpack8(R.vq[q], v);
#pragma unroll
        for (int j = 0; j < 8; ++j) v[j] = (v[j] - mr.x) * mr.y * I.lg[j] + I.lb[j];
        *(u32x4*)(lds + (q >> 1) * SHM_V + v_st((q & 1) * 32 + sr, sc)) = pack8(v); }
    asm volatile("s_waitcnt lgkmcnt(0)" ::: "memory"); __builtin_amdgcn_s_barrier();
    const int vb0 = (int)(uintptr_t)lds + v_rd_base(lane);
    f32x16 o0 = {}, o1 = {};
    if (dh == 0) {
        { bf16x8 pa0 = I.wa[0][0], pa1 = I.wa[0][1], pa2 = I.wa[0][2], pa3 = I.wa[0][3]; PV_D0(o0, 0, 0); PV_D0(o1, 0, 1); }
        if (rb >= 2) { bf16x8 pa0 = I.wa[1][0], pa1 = I.wa[1][1], pa2 = I.wa[1][2], pa3 = I.wa[1][3]; PV_D0(o0, SHM_V, 0); PV_D0(o1, SHM_V, 1); }
    } else {
        { bf16x8 pa0 = I.wa[0][0], pa1 = I.wa[0][1], pa2 = I.wa[0][2], pa3 = I.wa[0][3]; PV_D0(o0, 0, 2); PV_D0(o1, 0, 3); }
        if (rb >= 2) { bf16x8 pa0 = I.wa[1][0], pa1 = I.wa[1][1], pa2 = I.wa[1][2], pa3 = I.wa[1][3]; PV_D0(o0, SHM_V, 2); PV_D0(o1, SHM_V, 3); }
    }
    float* stg = (float*)(lds + 2 * SHM_V) + wid * 2048;
#pragma unroll
    for (int r = 0; r < 16; ++r) { const int tr = crow(r, hi); stg[tr * 64 + r32] = o0[r]; stg[tr * 64 + 32 + r32] = o1[r]; }
    asm volatile("s_waitcnt lgkmcnt(0)" ::: "memory");
#pragma unroll
    for (int i = 0; i < 4; ++i) { const int id = lane + 64 * i, tr = id >> 3, ch = id & 7, t = rb * 32 + tr; const float bs = I.bsq[i];
        const size_t off = (size_t)(row0 + t) * D + col0 + dh * 64 + ch * 8;
        const f32x4 s0 = *(const f32x4*)(stg + tr * 64 + ch * 8), s1 = *(const f32x4*)(stg + tr * 64 + ch * 8 + 4);
        float u[8], z[8], y[8]; unpack8(R.uq[i], u); unpack8(R.zq[i], z);
#pragma unroll
        for (int j = 0; j < 4; ++j) { y[j] = u[j] * (s0[j] + bs) * z[j]; y[4 + j] = u[4 + j] * (s1[j] + bs) * z[4 + j]; }
        *(u32x4*)(Ug + off) = pack8(y); }
    asm volatile("s_waitcnt lgkmcnt(0)" ::: "memory"); __builtin_amdgcn_s_barrier();
}
#undef SBAR
}


#define XB_TMO      128
#define XB_XCNT(j)  (256  + 64 * (j))
#define XB_XSUB(j)  (1280 + 64 * (j))
#define XB_XGEN(j)  (2304 + 64 * (j))
#define XB_TOP      3328
#define XB_TOPGEN   3392
#define XCD_BAR_WORDS 3456
#define XB_SPIN_CAP (1u << 22)
__device__ __forceinline__ unsigned xb_ld(unsigned* p)              { return __hip_atomic_load(p, __ATOMIC_RELAXED, __HIP_MEMORY_SCOPE_AGENT); }
__device__ __forceinline__ unsigned xb_add(unsigned* p, unsigned v) { return __hip_atomic_fetch_add(p, v, __ATOMIC_RELAXED, __HIP_MEMORY_SCOPE_AGENT); }
__device__ __forceinline__ unsigned xb_xcc_id() { return (unsigned)__builtin_amdgcn_s_getreg((3 << 11) | 20) & 0xFu; }
#define XB_SPIN(cond, bar) do { unsigned _sp = 0; while (cond) { __builtin_amdgcn_s_sleep(1); \
    if ((++_sp & 255u) == 0u) { if (xb_ld(&(bar)[XB_TMO])) break; if (_sp > XB_SPIN_CAP) { atomicAdd(&(bar)[XB_TMO], 1u); break; } } } } while (0)
__device__ __forceinline__ void xcd_barrier_complete(unsigned* bar, unsigned x, unsigned& nloc, unsigned& nx) {
    const unsigned G = gridDim.x;
    unsigned sum, cnt, mine, sp = 0u;
    for (;;) {
        sum = 0u; cnt = 0u; mine = 0u;
#pragma unroll
        for (unsigned j = 0; j < 16; ++j) { const unsigned c = xb_ld(&bar[XB_XCNT(j)]); sum += c; cnt += (c > 0u) ? 1u : 0u; mine = (j == x) ? c : mine; }
        if (sum == G) break;
        __builtin_amdgcn_s_sleep(1);
        if ((++sp & 255u) == 0u) { if (xb_ld(&bar[XB_TMO])) break; if (sp > XB_SPIN_CAP) { atomicAdd(&bar[XB_TMO], 1u); break; } }
    }
    nloc = mine > 0u ? mine : 1u; nx = cnt > 0u ? cnt : 1u;
}
__device__ __forceinline__ void xcd_barrier(unsigned* bar, volatile LAS unsigned* st, const int tid) {
    asm volatile("s_waitcnt vmcnt(0)" ::: "memory");
    __syncthreads();
    if (tid == 0) {
        const unsigned x = xb_xcc_id();
        __builtin_amdgcn_s_waitcnt(0);
        unsigned nloc = st[0], nx = st[1];
        if (nloc == 0u) { xcd_barrier_complete(bar, x, nloc, nx); st[0] = nloc; st[1] = nx; }
        const unsigned old = xb_add(&bar[XB_XSUB(x)], 1u);
        const unsigned gen = old / nloc;
        if (old + 1u == (gen + 1u) * nloc) {
            __builtin_amdgcn_fence(__ATOMIC_RELEASE, "agent");
            asm volatile("s_waitcnt vmcnt(0)" ::: "memory");
            const unsigned og = xb_add(&bar[XB_TOP], 1u);
            const unsigned tg = og / nx;
            __builtin_amdgcn_fence(__ATOMIC_ACQUIRE, "agent");
            if (og + 1u == (tg + 1u) * nx) xb_add(&bar[XB_TOPGEN], 1u);
            else XB_SPIN(xb_ld(&bar[XB_TOPGEN]) == tg, bar);
            xb_add(&bar[XB_XGEN(x)], 1u);
            asm volatile("s_waitcnt vmcnt(0)" ::: "memory");
        } else {
            __builtin_amdgcn_fence(__ATOMIC_ACQUIRE, "agent");
            XB_SPIN(xb_ld(&bar[XB_XGEN(x)]) == gen, bar);
            asm volatile("s_waitcnt vmcnt(0)" ::: "memory");
        }
    }
    __syncthreads();
}

typedef const __attribute__((address_space(4))) Ptrs* KargPtr;
#define PHASE_ENV() KargPtr kp_ = (KargPtr)__builtin_amdgcn_kernarg_segment_ptr(); asm volatile("" : "+s"(kp_)); \
    const int wave = wave0_; int lane = (int)__builtin_amdgcn_mbcnt_hi(~0u, __builtin_amdgcn_mbcnt_lo(~0u, 0u)); asm volatile("" : "+v"(lane)); const int tid = wave * 64 + lane; \
    int G = gridDim.x, c = blockIdx.x; asm volatile("" : "+s"(G), "+s"(c)); const int vcu = (G % 8 == 0) ? (c % 8) * (G / 8) + c / 8 : c; \
    unsigned char* ws = kp_->ws; unsigned char* dout = (unsigned char*)kp_->out; (void)lane; (void)wave; (void)vcu; (void)ws; (void)dout
__global__ void __launch_bounds__(NTHREADS, 2) hybrid_fwd(Ptrs Punused) {
    extern __shared__ __attribute__((aligned(16))) unsigned char lds_raw[];
    LAS unsigned char* lds = (LAS unsigned char*)lds_raw;
    const int wave0_ = __builtin_amdgcn_readfirstlane((int)threadIdx.x >> 6);
    int lo, hi; { KargPtr k0 = (KargPtr)__builtin_amdgcn_kernarg_segment_ptr(); lo = k0->ph_lo; hi = k0->ph_hi; }
#define IN(k) (lo <= (k) && (k) < hi)
#if MK_SINGLE
    volatile LAS unsigned* bst_ = (volatile LAS unsigned*)(lds + BARST_OFF);
    { if ((int)threadIdx.x == 0) { bst_[0] = 0u; bst_[1] = 0u; KargPtr k0 = (KargPtr)__builtin_amdgcn_kernarg_segment_ptr(); (void)xb_add(&((unsigned*)k0->ws)[XB_XCNT(xb_xcc_id())], 1u); } __syncthreads(); }
#define SEAM(k) do { if (IN(k) && IN((k) + 1)) { PHASE_ENV(); if ((k) == 0 && kp_->use_cg) cg::this_grid().sync(); else xcd_barrier((unsigned*)ws, bst_, tid); } } while (0)
#else
#define SEAM(k) do { } while (0)
#endif
    if (IN(0)) { PHASE_ENV(); Ptrs P; { const __attribute__((address_space(4))) unsigned long long* s_ = (const __attribute__((address_space(4))) unsigned long long*)kp_; unsigned long long* d_ = (unsigned long long*)&P; _Pragma("unroll") for (int i_ = 0; i_ < (int)(sizeof(Ptrs) / 8); ++i_) d_[i_] = s_[i_]; } phase0(P, lds, vcu, G, tid, lane, wave); }
    SEAM(0);
    if (IN(1)) {
        { PHASE_ENV(); const int nfull = (32 * NT_IN + 16) % G;
          if (nfull == 0 || c >= nfull) { Ptrs P; { const __attribute__((address_space(4))) unsigned long long* s_ = (const __attribute__((address_space(4))) unsigned long long*)kp_; unsigned long long* d_ = (unsigned long long*)&P; _Pragma("unroll") for (int i_ = 0; i_ < (int)(sizeof(Ptrs) / 8); ++i_) d_[i_] = s_[i_]; }
              phase_wconv2(P, lds, 0, c - nfull, G - nfull, lane, wave);
              asm volatile("s_waitcnt vmcnt(0)" ::: "memory"); __syncthreads();
              if (tid == 0) { __builtin_amdgcn_fence(__ATOMIC_RELEASE, "agent"); asm volatile("s_waitcnt vmcnt(0)" ::: "memory"); (void)__hip_atomic_fetch_add((unsigned*)ws + XB_WMEM, 1u, __ATOMIC_RELAXED, __HIP_MEMORY_SCOPE_AGENT); } } }
        { PHASE_ENV(); const int nfull = (32 * NT_IN + 16) % G; SchedP1 Sc{ws, G, c, nfull == 0 ? G : G - nfull}; EpiP1 E{ws, dout, kp_->in[16]}; pg8::gemm_phase<2048>(lds, Sc, E, tid); } }
    SEAM(1);
    if (IN(2)) { PHASE_ENV();
        { const f32x2* st = (const f32x2*)(ws + WS_VST); f32x2* mr = (f32x2*)(ws + WS_VMR);
          for (int row = c * 32 + (tid >> 4); row < S; row += G * 32) { const int sub = tid & 15;
              const f32x2 p0 = st[(size_t)sub * S + row], p1 = st[(size_t)(sub + 16) * S + row]; float s1 = p0.x + p1.x, s2 = p0.y + p1.y;
#pragma unroll
              for (int o = 1; o < 16; o <<= 1) { s1 += __shfl_xor(s1, o); s2 += __shfl_xor(s2, o); }
              const float mean = s1 * (1.f / D); const float var = fmaxf(s2 * (1.f / D) - mean * mean, 0.f); if (sub == 0) mr[row] = (f32x2){mean, 1.0f / sqrtf(var + EPS)}; } }
        SchedP2 Sc{ws, G, c}; EpiP2 E{ws, (LAS float*)(lds + XCH_OFF)}; pg8::gemm_phase<512>(lds, Sc, E, tid);
    }
    SEAM(2);
    if (IN(3)) {
        { PHASE_ENV();
          if (c < 224) { const int v2 = (c & 7) * 28 + (c >> 3), h = v2 / 14, b = v2 - h * 14;
            const bf16_t* Qh = (const bf16_t*)(ws + WS_QB) + (size_t)h * S * DQK; const bf16_t* Kh = (const bf16_t*)(ws + WS_KB) + (size_t)h * S * DQK; const bf16_t* Vh = (const bf16_t*)(ws + WS_VB) + (size_t)h * S * DV;
            bf16_t* ZY = (bf16_t*)dout + h * DV;
            const int qa = 31 - b, qc = 2 + (int)((0x7FEDCBA9826340ull >> (4 * b)) & 15ull), qd = b == 0 ? 1 : b == 2 ? 0 : b == 4 ? 3 : 7;
            const int nblk = (b == 0 || b == 2 || b == 4 || b == 13) ? 3 : 2;
#pragma unroll 1
            for (int r = 0; r < nblk; ++r) { const int qb = r == 0 ? qa : r == 1 ? qc : qd; int t2 = tid; asm volatile("" : "+v"(t2));
                att::attn_block3(Qh, Kh, Vh, ZY, qb * 256, (char*)lds_raw, t2); } } }
        { PHASE_ENV(); if (c >= 224) { SchedP3b Sc{ws, 32, c - 224}; EpiMulZ E{dout}; pg8::gemm_phase<256>(lds, Sc, E, tid); } }
        { PHASE_ENV(); if (c >= 224) { const int mw = c - 224; const float* lng = kp_->in[5]; const float* lnb = kp_->in[6]; const float* bs = kp_->in[8];
            att::MixRegs ra, rb; att::MixInv inv;
            att::mixer_issue(ws, mw >> 4, mw & 15, tid, ra); att::mixer_inv(ws, lng, lnb, bs, mw & 15, tid, inv);
            for (int it = mw; it < 1024; it += 64) {
                const int it1 = it + 32, it2 = it + 64;
                if (it1 < 1024) att::mixer_issue(ws, it1 >> 4, mw & 15, tid, rb);
                att::mixer_block(ws, it >> 4, mw & 15, (char*)lds_raw, tid, ra, inv);
                if (it1 >= 1024) break;
                if (it2 < 1024) att::mixer_issue(ws, it2 >> 4, mw & 15, tid, ra);
                att::mixer_block(ws, it1 >> 4, mw & 15, (char*)lds_raw, tid, rb, inv);
            } } }
        { PHASE_ENV(); Ptrs P; { const __attribute__((address_space(4))) unsigned long long* s_ = (const __attribute__((address_space(4))) unsigned long long*)kp_; unsigned long long* d_ = (unsigned long long*)&P; _Pragma("unroll") for (int i_ = 0; i_ < (int)(sizeof(Ptrs) / 8); ++i_) d_[i_] = s_[i_]; } __syncthreads();
          if (c < 224) phase_wconv2(P, lds, 1, c, 224, lane, wave, WC2_MEM_TILES, 4096); else phase_wconv2(P, lds, 1, c - 224, 32, lane, wave, 0, WC2_MEM_TILES); }
    }
    SEAM(3);
    if (IN(4)) { PHASE_ENV(); SchedP4 Sc{ws, dout, G, c}; EpiP4 E{ws}; pg8::gemm_phase<2048>(lds, Sc, E, tid); }
    SEAM(4);
    if (IN(5)) { PHASE_ENV(); SchedP5 Sc{ws, G, c}; EpiP5 E{ws, (float*)dout}; pg8::gemm_phase<2048>(lds, Sc, E, tid); }
    SEAM(5);
    if (IN(6)) { PHASE_ENV();
        const float* st = (const float*)(ws + WS_OST); const float* x = kp_->in[0]; const float* gp = kp_->in[19]; float* outp = (float*)dout;
        for (int row = vcu * NWAVES + wave; row < S; row += G * NWAVES) {
            float s = lane < 32 ? st[(size_t)lane * S + row] : 0.f; s = wave_sum(s);
            const float rs = 1.0f / sqrtf(s * (1.f / D) + EPS);
            const f32x4* xr = (const f32x4*)(x + (size_t)row * D); f32x4* orow = (f32x4*)(outp + (size_t)row * D); const f32x4* gr = (const f32x4*)gp; const u32x4* ob = (const u32x4*)((const bf16_t*)(ws + WS_MP) + (size_t)row * D);
#pragma unroll
            for (int j = 0; j < 4; ++j) { const int q = 64 * j + lane; float a[8]; unpack8(ob[q], a); const f32x4 x0 = xr[2 * q], x1 = xr[2 * q + 1], g0 = gr[2 * q], g1 = gr[2 * q + 1];
                orow[2 * q] = x0 + (f32x4){a[0], a[1], a[2], a[3]} * rs * g0; orow[2 * q + 1] = x1 + (f32x4){a[4], a[5], a[6], a[7]} * rs * g1; }
        }
    }
#undef IN
#undef SEAM
}

extern "C" void kernel_launch(void* const* d_in, const int* in_sizes, int n_in, void* d_out, int out_size, void* d_ws, size_t ws_size, hipStream_t stream) {
    static int grid = 0;
    if (grid == 0) {
        if (n_in != 20 || out_size != S * D || ws_size < WS_END) { fprintf(stderr, "kernel_launch: unexpected shapes (n_in %d out %d ws %zu)\n", n_in, out_size, ws_size); grid = -1; return; }
        int dev = 0, cus = 0, per_cu = 0;
        (void)hipGetDevice(&dev); (void)hipDeviceGetAttribute(&cus, hipDeviceAttributeMultiprocessorCount, dev);
        (void)hipFuncSetAttribute((const void*)hybrid_fwd, hipFuncAttributeMaxDynamicSharedMemorySize, LDS_BYTES);
        (void)hipOccupancyMaxActiveBlocksPerMultiprocessor(&per_cu, (const void*)hybrid_fwd, NTHREADS, LDS_BYTES);
        if (per_cu < 1) { fprintf(stderr, "kernel_launch: occupancy query reports %d blocks per CU\n", per_cu); }
        grid = cus;
        (void)hipGetLastError();
    }
    if (grid < 0) return;
    Ptrs p{};
    for (int i = 0; i < 20; ++i) p.in[i] = (const float*)d_in[i];
    p.out = (float*)d_out; p.ws = (unsigned char*)d_ws;
#if MK_SINGLE
    (void)hipMemsetAsync(d_ws, 0, CTL_ZERO_BYTES, stream);
    p.ph_lo = 0; p.ph_hi = 7;
    void* args[] = {&p};
    hipError_t e = hipLaunchCooperativeKernel((const void*)hybrid_fwd, dim3(grid), dim3(NTHREADS), args, LDS_BYTES, stream);
    if (e != hipSuccess) fprintf(stderr, "cooperative launch failed: %s (grid %d)\n", hipGetErrorString(e), grid);
#else
    for (int k = 0; k < 7; ++k) { p.ph_lo = k; p.ph_hi = k + 1; hipLaunchKernelGGL(hybrid_fwd, dim3(grid), dim3(NTHREADS), LDS_BYTES, stream, p); }
#endif
}
```
